# Optimizing an MI355X kernel written in HIP

```python
import math
import jax, jax.numpy as jnp
from jax import lax
import numpy as np

D_MODEL = 1024
BATCH = 2
SEQ = 8192
DEPTH = 1
DEC_BATCH = 4
DEC_SEQ = 8192
PAST_LEN = 128

ATT_HEADS = 8
HEAD_DIM = 64
ATT_WIDTH = ATT_HEADS * HEAD_DIM
SSM_WIDTH = D_MODEL - ATT_WIDTH
SSM_GROUP_CH = 16
SSM_GROUPS = SSM_WIDTH // SSM_GROUP_CH
SSM_STATE = 64
MIX_WIDTH = ATT_WIDTH + SSM_WIDTH
IN_COLS = 3 * ATT_WIDTH + SSM_WIDTH
D_FF = 4 * D_MODEL
PLE_DIM = 256
NUM_BUCKETS = 32
REL_MAX_DISTANCE = 1024
DIL_WINDOWS = (128, 512, 2048)
DIL_RATES = (1, 4, 16)
DT_MIN = 0.001
DT_MAX = 0.1
RMS_EPS = 1e-6
NEG_INF = -1e30

kernel_name = 'hybrid_s5_dilated_attention_encoder'


def rms_norm(x, g):
    x32 = x.astype(jnp.float32)
    y = x32 * lax.rsqrt(jnp.mean(x32 * x32, axis=-1, keepdims=True) + RMS_EPS)
    return (y * g.astype(jnp.float32)).astype(x.dtype)


def t5_bucket(rel):
    half = NUM_BUCKETS // 2
    n = -rel
    ret = jnp.where(n < 0, half, 0)
    n = jnp.abs(n)
    max_exact = half // 2
    nf = jnp.maximum(n, 1).astype(jnp.float32)
    large = max_exact + (jnp.log(nf / max_exact) / math.log(REL_MAX_DISTANCE / max_exact)
                         * (half - max_exact)).astype(jnp.int32)
    large = jnp.minimum(large, half - 1)
    return ret + jnp.where(n < max_exact, n, large)


def dilated_branch(q, k, v, rel_bias, window, dilation):
    Bn, S, H, E = q.shape
    radius = window // (2 * dilation)
    blk = radius
    L = S // dilation
    nb = -(-L // blk)
    Lp = nb * blk

    def split(t):
        return t.reshape(Bn, L, dilation, H, E)

    qb = jnp.pad(split(q), ((0, 0), (0, Lp - L), (0, 0), (0, 0), (0, 0))).reshape(Bn, nb, blk, dilation, H, E)

    def windows(t):
        tp = jnp.pad(split(t), ((0, 0), (blk, Lp - L + blk), (0, 0), (0, 0), (0, 0)))
        tp = tp.reshape(Bn, nb + 2, blk, dilation, H, E)
        return jnp.concatenate([tp[:, :-2], tp[:, 1:-1], tp[:, 2:]], axis=2)

    kw = windows(k)
    vw = windows(v)
    offset = jnp.arange(3 * blk)[None, :] - blk - jnp.arange(blk)[:, None]
    key_m = (jnp.arange(nb)[:, None] - 1) * blk + jnp.arange(3 * blk)[None, :]
    mask = (jnp.abs(offset) <= radius)[None] & ((key_m >= 0) & (key_m < L))[:, None, :]
    bias = rel_bias[t5_bucket(offset * dilation)].astype(jnp.float32).transpose(2, 0, 1)
    s = jnp.einsum('bnqrhe,bnkrhe->bnrhqk', qb, kw) * (HEAD_DIM ** -0.5) + bias
    s = jnp.where(mask[None, :, None, None], s, NEG_INF)
    m = jnp.max(s, axis=-1, keepdims=True)
    pr = jnp.exp(s - m)
    den = jnp.sum(pr, axis=-1)
    o = jnp.einsum('bnrhqk,bnkrhe->bnqrhe', pr, vw) / den.transpose(0, 1, 4, 2, 3)[..., None]
    lse = (m[..., 0] + jnp.log(den)).transpose(0, 1, 4, 2, 3)
    o = o.reshape(Bn, Lp, dilation, H, E)[:, :L].reshape(Bn, S, H, E)
    lse = lse.reshape(Bn, Lp, dilation, H)[:, :L].reshape(Bn, S, H)
    return o, lse


def attention_mixer(q, k, v, rel_bias):
    Bn, S, _ = q.shape
    q = q.astype(jnp.float32).reshape(Bn, S, ATT_HEADS, HEAD_DIM)
    k = k.astype(jnp.float32).reshape(Bn, S, ATT_HEADS, HEAD_DIM)
    v = v.astype(jnp.float32).reshape(Bn, S, ATT_HEADS, HEAD_DIM)
    outs, lses = [], []
    for w, d in zip(DIL_WINDOWS, DIL_RATES):
        o, l = dilated_branch(q, k, v, rel_bias, w, d)
        outs.append(o)
        lses.append(l)
    wts = jax.nn.softmax(jnp.stack(lses, axis=0), axis=0)
    o = jnp.sum(wts[..., None] * jnp.stack(outs, axis=0), axis=0)
    return o.reshape(Bn, S, ATT_WIDTH)


def _complex_affine_combine(e1, e2):
    a1r, a1i, b1r, b1i = e1
    a2r, a2i, b2r, b2i = e2
    return (a2r * a1r - a2i * a1i,
            a2r * a1i + a2i * a1r,
            a2r * b1r - a2i * b1i + b2r,
            a2r * b1i + a2i * b1r + b2i)


def ssm_direction(u, a_re, a_im, log_dt, b_re, b_im, c_re, c_im, reverse):
    f32 = jnp.float32
    a_re = a_re.astype(f32)
    a_im = a_im.astype(f32)
    dt = jnp.exp(log_dt.astype(f32))[:, None]
    mag = jnp.exp(a_re * dt)
    ab_re = mag * jnp.cos(a_im * dt)
    ab_im = mag * jnp.sin(a_im * dt)
    inv = 1.0 / (a_re * a_re + a_im * a_im)
    f_re = ((ab_re - 1.0) * a_re + ab_im * a_im) * inv
    f_im = (ab_im * a_re - (ab_re - 1.0) * a_im) * inv
    b_re = b_re.astype(f32)
    b_im = b_im.astype(f32)
    bb_re = f_re[..., None] * b_re - f_im[..., None] * b_im
    bb_im = f_re[..., None] * b_im + f_im[..., None] * b_re
    bu_re = jnp.einsum('bsgh,gnh->bsgn', u, bb_re)
    bu_im = jnp.einsum('bsgh,gnh->bsgn', u, bb_im)
    elems = (jnp.broadcast_to(ab_re, bu_re.shape), jnp.broadcast_to(ab_im, bu_re.shape), bu_re, bu_im)
    _, _, h_re, h_im = lax.associative_scan(_complex_affine_combine, elems, reverse=reverse, axis=1)
    return (jnp.einsum('bsgn,ghn->bsgh', h_re, c_re.astype(f32))
            - jnp.einsum('bsgn,ghn->bsgh', h_im, c_im.astype(f32)))


def ssm_mixer(u, a_re, a_im, log_dt, b_re, b_im, c_re, c_im, d, w_glu, b_glu):
    Bn, S, _ = u.shape
    u32 = u.astype(jnp.float32).reshape(Bn, S, SSM_GROUPS, SSM_GROUP_CH)
    y = d.astype(jnp.float32) * u32
    for direction in range(2):
        y = y + ssm_direction(u32, a_re[direction], a_im[direction], log_dt[direction],
                              b_re[direction], b_im[direction], c_re[direction], c_im[direction],
                              reverse=(direction == 1))
    g = jax.nn.gelu(y.reshape(Bn, S, SSM_WIDTH))
    out = g * jax.nn.sigmoid(g @ w_glu.astype(jnp.float32) + b_glu.astype(jnp.float32))
    return out


def encoder_layer(h, p_i, rel_bias, g_mix, w_in, a_re, a_im, log_dt, b_re, b_im, c_re, c_im, d,
                  w_glu, b_glu, g_att_out, g_ssm_out, w_out, g_mlp, w_mlp1, w_mlp2,
                  g_ple, w_ple_gate, w_ple_proj):
    a = rms_norm(h, g_mix)
    z = a @ w_in
    q = z[..., :ATT_WIDTH]
    k = z[..., ATT_WIDTH:2 * ATT_WIDTH]
    v = z[..., 2 * ATT_WIDTH:3 * ATT_WIDTH]
    u = z[..., 3 * ATT_WIDTH:]
    att = attention_mixer(q, k, v, rel_bias).astype(h.dtype)
    ssm = ssm_mixer(u, a_re, a_im, log_dt, b_re, b_im, c_re, c_im, d, w_glu, b_glu).astype(h.dtype)
    mix = jnp.concatenate([rms_norm(att, g_att_out), rms_norm(ssm, g_ssm_out)], axis=-1)
    h = h + mix @ w_out
    f = rms_norm(h, g_mlp)
    h = h + jnp.square(jax.nn.relu(f @ w_mlp1)) @ w_mlp2
    e = rms_norm(h, g_ple)
    h = h + jax.nn.sigmoid(e @ w_ple_gate) * (p_i @ w_ple_proj)
    return h


def encoder_trunk(x, p, weights):
    (rel_bias, g_mix, w_in, ssm_a_re, ssm_a_im, ssm_log_dt, ssm_b_re, ssm_b_im, ssm_c_re, ssm_c_im,
     ssm_d, w_glu, b_glu, g_att_out, g_ssm_out, w_out, g_mlp, w_mlp1, w_mlp2, g_ple, w_ple_gate,
     w_ple_proj, g_final) = weights
    h = x
    for i in range(DEPTH):
        h = encoder_layer(h, p[i], rel_bias, g_mix[i], w_in[i], ssm_a_re[i], ssm_a_im[i], ssm_log_dt[i],
                          ssm_b_re[i], ssm_b_im[i], ssm_c_re[i], ssm_c_im[i], ssm_d[i], w_glu[i], b_glu[i],
                          g_att_out[i], g_ssm_out[i], w_out[i], g_mlp[i], w_mlp1[i], w_mlp2[i],
                          g_ple[i], w_ple_gate[i], w_ple_proj[i])
    return rms_norm(h, g_final)


def setup_inputs(seed: int = 0) -> dict:
    key = jax.random.key(seed)
    ks = jax.random.split(key, 32)
    f32 = jnp.float32

    def nrm(k, shape, s):
        return jax.random.normal(k, shape, f32) * s

    G, N, HC = SSM_GROUPS, SSM_STATE, SSM_GROUP_CH
    n_idx = jnp.arange(N, dtype=f32)
    return {
        'x_prompt': nrm(ks[0], (BATCH, SEQ, D_MODEL), 1.0),
        'x_sample': nrm(ks[1], (DEC_BATCH, DEC_SEQ, D_MODEL), 1.0),
        'p_prompt': nrm(ks[2], (DEPTH, BATCH, SEQ, PLE_DIM), 1.0),
        'p_sample': nrm(ks[3], (DEPTH, DEC_BATCH, DEC_SEQ, PLE_DIM), 1.0),
        'rel_bias': nrm(ks[4], (NUM_BUCKETS, ATT_HEADS), 0.5),
        'g_mix': 1.0 + nrm(ks[5], (DEPTH, D_MODEL), 0.02),
        'w_in': nrm(ks[6], (DEPTH, D_MODEL, IN_COLS), D_MODEL ** -0.5),
        'ssm_a_re': -0.5 + nrm(ks[7], (DEPTH, 2, G, N), 0.01),
        'ssm_a_im': math.pi * n_idx + nrm(ks[8], (DEPTH, 2, G, N), 0.01),
        'ssm_log_dt': jax.random.uniform(ks[9], (DEPTH, 2, G), f32, math.log(DT_MIN), math.log(DT_MAX)),
        'ssm_b_re': nrm(ks[10], (DEPTH, 2, G, N, HC), (2 * HC) ** -0.5),
        'ssm_b_im': nrm(ks[11], (DEPTH, 2, G, N, HC), (2 * HC) ** -0.5),
        'ssm_c_re': nrm(ks[12], (DEPTH, 2, G, HC, N), N ** -0.5),
        'ssm_c_im': nrm(ks[13], (DEPTH, 2, G, HC, N), N ** -0.5),
        'ssm_d': nrm(ks[14], (DEPTH, G, HC), 0.5),
        'w_glu': nrm(ks[15], (DEPTH, SSM_WIDTH, SSM_WIDTH), SSM_WIDTH ** -0.5),
        'b_glu': nrm(ks[16], (DEPTH, SSM_WIDTH), 0.02),
        'g_att_out': 1.0 + nrm(ks[17], (DEPTH, ATT_WIDTH), 0.02),
        'g_ssm_out': 1.0 + nrm(ks[18], (DEPTH, SSM_WIDTH), 0.02),
        'w_out': nrm(ks[19], (DEPTH, MIX_WIDTH, D_MODEL), MIX_WIDTH ** -0.5),
        'g_mlp': 1.0 + nrm(ks[20], (DEPTH, D_MODEL), 0.02),
        'w_mlp1': nrm(ks[21], (DEPTH, D_MODEL, D_FF), D_MODEL ** -0.5),
        'w_mlp2': nrm(ks[22], (DEPTH, D_FF, D_MODEL), D_FF ** -0.5),
        'g_ple': 1.0 + nrm(ks[23], (DEPTH, D_MODEL), 0.02),
        'w_ple_gate': nrm(ks[24], (DEPTH, D_MODEL, D_MODEL), D_MODEL ** -0.5),
        'w_ple_proj': nrm(ks[25], (DEPTH, PLE_DIM, D_MODEL), PLE_DIM ** -0.5),
        'g_final': 1.0 + nrm(ks[26], (D_MODEL,), 0.02),
    }


def reference(x_prompt, x_sample, p_prompt, p_sample, rel_bias, g_mix, w_in, ssm_a_re, ssm_a_im, ssm_log_dt,
              ssm_b_re, ssm_b_im, ssm_c_re, ssm_c_im, ssm_d, w_glu, b_glu, g_att_out, g_ssm_out, w_out,
              g_mlp, w_mlp1, w_mlp2, g_ple, w_ple_gate, w_ple_proj, g_final):
    weights = (rel_bias, g_mix, w_in, ssm_a_re, ssm_a_im, ssm_log_dt, ssm_b_re, ssm_b_im, ssm_c_re, ssm_c_im,
               ssm_d, w_glu, b_glu, g_att_out, g_ssm_out, w_out, g_mlp, w_mlp1, w_mlp2, g_ple, w_ple_gate,
               w_ple_proj, g_final)
    y_prompt = encoder_trunk(x_prompt, p_prompt, weights)
    y_sample = encoder_trunk(x_sample, p_sample, weights)
    return (y_prompt, y_sample)
```

```cpp
#include <hip/hip_runtime.h>
#include <cstdio>
#include <cstdint>
#include <cmath>

typedef unsigned short bf16_t;
typedef short bf16x8 __attribute__((ext_vector_type(8)));
typedef float f32x4 __attribute__((ext_vector_type(4)));
typedef unsigned u32x2 __attribute__((ext_vector_type(2)));
typedef unsigned u32x4 __attribute__((ext_vector_type(4)));

constexpr int NT = 49152, SEQ = 8192, NSEQ = 6, NPROMPT = 16384;
constexpr int D = 1024, DFF = 4096, PLE = 256, INC = 2048, AW = 512, SW = 512;
constexpr int NH = 8, HD = 64, NG = 32, GC = 16, NS = 64;
constexpr int TCH = 16, NCHT = NT / TCH  , NCHS = SEQ / TCH  ;
constexpr float EPS = 1e-6f;
constexpr float LOG2E = 1.4426950408889634f;
constexpr float C2 = 0.125f * LOG2E;

constexpr size_t MiB = 1u << 20;
constexpr size_t WS_BIAS = 0;
constexpr size_t WS_PW = 64 * 1024;
constexpr size_t WS_BB = 1 * MiB;
constexpr size_t WS_RS0 = 2 * MiB;
constexpr size_t WS_RSA = WS_RS0 + 256 * 1024;
constexpr size_t WS_RSS = WS_RSA + 256 * 1024;
constexpr size_t WS_RS1 = WS_RSS + 256 * 1024;
constexpr size_t WS_RS2 = WS_RS1 + 256 * 1024;
constexpr size_t WS_W1T = 18 * MiB, WS_W2T = 26 * MiB, WS_WGT = 34 * MiB, WS_WPT = 36 * MiB;
constexpr size_t WS_PB = 37 * MiB;
constexpr size_t WS_WINT = 61 * MiB, WS_WOUTT = 65 * MiB, WS_WGLUT = 67 * MiB, WS_WST = 68 * MiB, WS_WYT = 72 * MiB;
constexpr size_t WS_SB = 80 * MiB;
constexpr size_t WS_QB = 128 * MiB, WS_KB = 176 * MiB, WS_VB = 224 * MiB;
constexpr size_t WS_UH = 272 * MiB;
constexpr size_t WS_MIX = 368 * MiB;
constexpr size_t WS_GB = 464 * MiB;
constexpr size_t WS_HID = 128 * MiB;
constexpr size_t WS_PP = 128 * MiB;
constexpr size_t WS_H3F = 224 * MiB;
constexpr size_t WS_END = 512 * MiB;
constexpr size_t DO_XB = 0, DO_H1B = 0, DO_H2B = 96 * MiB;

__device__ __forceinline__ unsigned f2bf(float f) { unsigned u = __builtin_bit_cast(unsigned, f); return (u + 0x7fffu + ((u >> 16) & 1u)) >> 16; }
__device__ __forceinline__ unsigned pk2(float lo, float hi) { return f2bf(lo) | (f2bf(hi) << 16); }
__device__ __forceinline__ float bf2f(unsigned short b) { return __builtin_bit_cast(float, (unsigned)b << 16); }
__device__ __forceinline__ float bflo(unsigned w) { return __builtin_bit_cast(float, w << 16); }
__device__ __forceinline__ float bfhi(unsigned w) { return __builtin_bit_cast(float, w & 0xffff0000u); }
__device__ __forceinline__ float wave_sum(float v) {
#pragma unroll
    for (int o = 1; o < 64; o <<= 1) v += __shfl_xor(v, o);
    return v;
}
__device__ __forceinline__ const float* xrow(const float* xp, const float* xs, int tok, int width) {
    return tok < NPROMPT ? xp + (size_t)tok * width : xs + (size_t)(tok - NPROMPT) * width;
}

__global__ void k_prep_wt(const float* __restrict__ W, int K, int N, const float* __restrict__ g, bf16_t* __restrict__ out, int ldo, int nscale, float sc) {
    const size_t i = (size_t)blockIdx.x * blockDim.x + threadIdx.x;
    if (i >= (size_t)K * N) return;
    const int k = (int)(i / N), n = (int)(i % N);
    float v = W[i]; if (g) v *= g[k]; if (n < nscale) v *= sc;
    out[(size_t)n * ldo + k] = (bf16_t)f2bf(v);
}
__global__ void k_prep_wout(const float* __restrict__ W, const float* __restrict__ ga, const float* __restrict__ gs, bf16_t* __restrict__ out) {
    const size_t i = (size_t)blockIdx.x * blockDim.x + threadIdx.x;
    if (i >= (size_t)D * D) return;
    const int k = (int)(i / D), n = (int)(i % D);
    const float v = W[i] * (k < AW ? ga[k] : gs[k - AW]);
    out[(size_t)n * D + k] = (bf16_t)f2bf(v);
}
__device__ __forceinline__ int t5_bucket(int rel) {
    int n = -rel; int ret = n < 0 ? 16 : 0; n = n < 0 ? -n : n;
    if (n < 8) return ret + n;
    int large = 8 + (int)(log((double)n / 8.0) / log(128.0) * 8.0);
    large = large < 15 ? large : 15;
    return ret + large;
}
__global__ void k_prep_bias(const float* __restrict__ rel_bias, float* __restrict__ bias) {
    const int i = blockIdx.x * blockDim.x + threadIdx.x;
    if (i >= 3 * 8 * 129) return;
    const int o = i % 129, h = (i / 129) % 8, b = i / (129 * 8);
    const int dil = b == 0 ? 1 : (b == 1 ? 4 : 16);
    bias[i] = rel_bias[t5_bucket((o - 64) * dil) * NH + h] * LOG2E;
}
__global__ void k_rows_x(const float* __restrict__ xp, const float* __restrict__ xs, bf16_t* __restrict__ XB, float* __restrict__ RS0) {
    const int row = blockIdx.x * 4 + (threadIdx.x >> 6), lane = threadIdx.x & 63;
    const f32x4* xr = (const f32x4*)xrow(xp, xs, row, D) + lane;
    float s = 0.f; f32x4 v[4];
#pragma unroll
    for (int j = 0; j < 4; ++j) { v[j] = xr[64 * j]; s += v[j].x * v[j].x + v[j].y * v[j].y + v[j].z * v[j].z + v[j].w * v[j].w; }
    s = wave_sum(s);
    u32x2* o = (u32x2*)(XB + (size_t)row * D) + lane;
#pragma unroll
    for (int j = 0; j < 4; ++j) { u32x2 w; w.x = pk2(v[j].x, v[j].y); w.y = pk2(v[j].z, v[j].w); o[64 * j] = w; }
    if (lane == 0) RS0[row] = 1.0f / sqrtf(s * (1.0f / D) + EPS);
}
__global__ void k_cvt_p(const float* __restrict__ pp, const float* __restrict__ ps, bf16_t* __restrict__ PB) {
    const size_t i = (size_t)blockIdx.x * blockDim.x + threadIdx.x;
    if (i >= (size_t)NT * PLE / 4) return;
    const int tok = (int)(i / (PLE / 4)), c4 = (int)(i % (PLE / 4));
    const f32x4 v = *((const f32x4*)xrow(pp, ps, tok, PLE) + c4);
    u32x2 w; w.x = pk2(v.x, v.y); w.y = pk2(v.z, v.w);
    *((u32x2*)(PB + (size_t)tok * PLE) + c4) = w;
}
__global__ void k_ssm_tab(const float* __restrict__ a_re, const float* __restrict__ a_im, const float* __restrict__ log_dt,
                          const float* __restrict__ b_re, const float* __restrict__ b_im, float* __restrict__ PW, float* __restrict__ BB) {
    const int i = blockIdx.x * blockDim.x + threadIdx.x;
    if (i >= NG * 2 * NS) return;
    const int n = i % NS, dir = (i / NS) % 2, g = i / (2 * NS);
    const int pi = (dir * NG + g) * NS + n;
    const double ar = a_re[pi], ai = a_im[pi], dt = exp((double)log_dt[dir * NG + g]);
    float* pw = PW + (size_t)((g * 2 + dir) * NS + n) * 17 * 2;
    for (int e = 0; e <= 16; ++e) { const double mag = exp(ar * dt * e), ang = ai * dt * e; pw[2 * e] = (float)(mag * cos(ang)); pw[2 * e + 1] = (float)(mag * sin(ang)); }
    const double abr = exp(ar * dt) * cos(ai * dt), abi = exp(ar * dt) * sin(ai * dt), inv = 1.0 / (ar * ar + ai * ai);
    const double fr = ((abr - 1.0) * ar + abi * ai) * inv, fi = (abi * ar - (abr - 1.0) * ai) * inv;
    float* bb = BB + (size_t)((g * 2 + dir) * NS + n) * GC * 2;
    for (int h = 0; h < GC; ++h) { const double br = b_re[(size_t)pi * GC + h], bi = b_im[(size_t)pi * GC + h]; bb[2 * h] = (float)(fr * br - fi * bi); bb[2 * h + 1] = (float)(fr * bi + fi * br); }
}
__global__ void k_ssm_ws(const float* __restrict__ PW, const float* __restrict__ BB, bf16_t* __restrict__ WST) {
    const int i = blockIdx.x * blockDim.x + threadIdx.x;
    if (i >= NG * 256 * 256) return;
    const int k = i % 256, col = (i / 256) % 256, g = i / 65536;
    const int j = k / 16, hp = k % 16, dir = col / 128, n = (col % 128) / 2, ri = col & 1;
    const int e = dir == 0 ? 15 - j : j;
    const float* pw = PW + ((size_t)((g * 2 + dir) * NS + n) * 17 + e) * 2; const float* bb = BB + ((size_t)((g * 2 + dir) * NS + n) * GC + hp) * 2;
    const float vr = pw[0] * bb[0] - pw[1] * bb[1], vi = pw[0] * bb[1] + pw[1] * bb[0];
    WST[i] = (bf16_t)f2bf(ri ? vi : vr);
}
__global__ void k_ssm_wy(const float* __restrict__ PW, const float* __restrict__ BB, const float* __restrict__ c_re, const float* __restrict__ c_im,
                         const float* __restrict__ dd, bf16_t* __restrict__ WYT) {
    const int i = blockIdx.x * blockDim.x + threadIdx.x;
    if (i >= NG * 256 * 512) return;
    const int k = i % 512, jh = (i / 512) % 256, g = i / (512 * 256);
    const int j = jh / 16, h = jh % 16;
    float v = 0.f;
    if (k < 256) {
        const int jp = k / 16, hp = k % 16;
        for (int dir = 0; dir < 2; ++dir) {
            const int e = dir == 0 ? j - jp : jp - j;
            if (e < 0) continue;
            for (int n = 0; n < NS; ++n) {
                const float* pw = PW + ((size_t)((g * 2 + dir) * NS + n) * 17 + e) * 2; const float* bb = BB + ((size_t)((g * 2 + dir) * NS + n) * GC + hp) * 2;
                const size_t ci = ((size_t)(dir * NG + g) * GC + h) * NS + n;
                const float cr = c_re[ci], cim = c_im[ci];
                const float tr = pw[0] * bb[0] - pw[1] * bb[1], ti = pw[0] * bb[1] + pw[1] * bb[0];
                v += cr * tr - cim * ti;
            }
        }
        if (jp == j && hp == h) v += dd[g * GC + h];
    } else {
        const int kk = k - 256, dir = kk / 128, n = (kk % 128) / 2, ri = kk & 1;
        const int e = dir == 0 ? j + 1 : 16 - j;
        const float* pw = PW + ((size_t)((g * 2 + dir) * NS + n) * 17 + e) * 2;
        const size_t ci = ((size_t)(dir * NG + g) * GC + h) * NS + n;
        const float cr = c_re[ci], cim = c_im[ci];
        const float pr = cr * pw[0] - cim * pw[1], pim = cr * pw[1] + cim * pw[0];
        v = ri ? -pim : pr;
    }
    WYT[i] = (bf16_t)f2bf(v);
}

struct GemmP { const bf16_t* A; const bf16_t* Bt; const float* midnum; const float* midden; size_t strideA, strideB; int lda, ldb, K, midK; };
template <class Epi>
__global__ void __launch_bounds__(256) k_gemm(GemmP p, Epi E) {
    const int lane = threadIdx.x & 63, wid = threadIdx.x >> 6, fr = lane & 15, fq = lane >> 4;
    const int m0 = blockIdx.x * 128 + (wid >> 1) * 64, n0 = blockIdx.y * 128 + (wid & 1) * 64, bz = blockIdx.z;
    const bf16_t* A = p.A + (size_t)bz * p.strideA + (size_t)(m0 + fr) * p.lda + fq * 8;
    const bf16_t* B = p.Bt + (size_t)bz * p.strideB + (size_t)(n0 + fr) * p.ldb + fq * 8;
    f32x4 acc[4][4];
#pragma unroll
    for (int m = 0; m < 4; ++m)
#pragma unroll
        for (int n = 0; n < 4; ++n) acc[m][n] = (f32x4){0.f, 0.f, 0.f, 0.f};
    for (int k0 = 0; k0 < p.K; k0 += 32) {
        if (p.midK && k0 == p.midK) {
#pragma unroll
            for (int m = 0; m < 4; ++m) { const float r = p.midnum[m0 + m * 16 + fr] / p.midden[m0 + m * 16 + fr];
#pragma unroll
                for (int n = 0; n < 4; ++n) acc[m][n] = acc[m][n] * r; }
        }
        bf16x8 a[4], b[4];
#pragma unroll
        for (int m = 0; m < 4; ++m) a[m] = *(const bf16x8*)(A + (size_t)m * 16 * p.lda + k0);
#pragma unroll
        for (int n = 0; n < 4; ++n) b[n] = *(const bf16x8*)(B + (size_t)n * 16 * p.ldb + k0);
#pragma unroll
        for (int m = 0; m < 4; ++m)
#pragma unroll
            for (int n = 0; n < 4; ++n) acc[m][n] = __builtin_amdgcn_mfma_f32_16x16x32_bf16(b[n], a[m], acc[m][n], 0, 0, 0);
    }
#pragma unroll
    for (int m = 0; m < 4; ++m)
#pragma unroll
        for (int n = 0; n < 4; ++n) E(bz, m0 + m * 16 + fr, n0 + n * 16 + fq * 4, acc[m][n]);
}
__device__ __forceinline__ void st_bf4(bf16_t* p, f32x4 v) { u32x2 w; w.x = pk2(v.x, v.y); w.y = pk2(v.z, v.w); *(u32x2*)p = w; }
__device__ __forceinline__ f32x4 ld_bf4(const bf16_t* p) { const u32x2 w = *(const u32x2*)p; return (f32x4){bflo(w.x), bfhi(w.x), bflo(w.y), bfhi(w.y)}; }
__device__ __forceinline__ float sigm(float x) { return 1.0f / (1.0f + __expf(-x)); }
__device__ __forceinline__ float gelu_tanh(float x) { const float u = 0.7978845608028654f * (x + 0.044715f * x * x * x); return 0.5f * x * (1.0f + tanhf(u)); }

struct EpiIn {
    const float* RS0; bf16_t *QB, *KB, *VB, *UH;
    __device__ void operator()(int, int row, int col, f32x4 v) const {
        v = v * RS0[row];
        if (col < 3 * AW) { bf16_t* dst = col < AW ? QB : (col < 2 * AW ? KB : VB); st_bf4(dst + (size_t)row * AW + (col & (AW - 1)), v); }
        else { const int c = col - 3 * AW, g = c >> 4, ch = c & 15, chunk = row >> 4, j = row & 15; st_bf4(UH + ((size_t)(g * NCHT + chunk)) * 512 + j * 16 + ch, v); }
    }
};
struct EpiS {
    bf16_t* SB;
    __device__ void operator()(int g, int row, int col, f32x4 v) const { st_bf4(SB + ((size_t)(g * NCHT + row)) * 256 + col, v); }
};
struct EpiY {
    bf16_t* GB;
    __device__ void operator()(int g, int row, int col, f32x4 v) const {
        const int j = col >> 4, h = col & 15; const size_t tok = (size_t)row * 16 + j;
        st_bf4(GB + tok * SW + g * 16 + h, (f32x4){gelu_tanh(v.x), gelu_tanh(v.y), gelu_tanh(v.z), gelu_tanh(v.w)});
    }
};
struct EpiGlu {
    const bf16_t* GB; const float* bglu; bf16_t* MIX;
    __device__ void operator()(int, int row, int col, f32x4 v) const {
        const f32x4 gv = ld_bf4(GB + (size_t)row * SW + col); const f32x4 b = *(const f32x4*)(bglu + col);
        st_bf4(MIX + (size_t)row * D + AW + col, (f32x4){gv.x * sigm(v.x + b.x), gv.y * sigm(v.y + b.y), gv.z * sigm(v.z + b.z), gv.w * sigm(v.w + b.w)});
    }
};
struct EpiOut {
    const float *xp, *xs; const float* RSS; bf16_t* H1B;
    __device__ void operator()(int, int row, int col, f32x4 v) const {
        const f32x4 xv = *(const f32x4*)(xrow(xp, xs, row, D) + col);
        st_bf4(H1B + (size_t)row * D + col, xv + v * RSS[row]);
    }
};
struct EpiMlp1 {
    const float* RS1; bf16_t* HID;
    __device__ void operator()(int, int row, int col, f32x4 v) const {
        v = v * RS1[row]; f32x4 r; r.x = fmaxf(v.x, 0.f); r.y = fmaxf(v.y, 0.f); r.z = fmaxf(v.z, 0.f); r.w = fmaxf(v.w, 0.f);
        st_bf4(HID + (size_t)row * DFF + col, r * r);
    }
};
struct EpiMlp2 {
    const bf16_t* H1B; bf16_t* H2B;
    __device__ void operator()(int, int row, int col, f32x4 v) const { st_bf4(H2B + (size_t)row * D + col, ld_bf4(H1B + (size_t)row * D + col) + v); }
};
struct EpiPP {
    bf16_t* PP;
    __device__ void operator()(int, int row, int col, f32x4 v) const { st_bf4(PP + (size_t)row * D + col, v); }
};
struct EpiGate {
    const float* RS2; const bf16_t* H2B; const bf16_t* PP; float* H3F;
    __device__ void operator()(int, int row, int col, f32x4 v) const {
        v = v * RS2[row]; const f32x4 h = ld_bf4(H2B + (size_t)row * D + col), pp = ld_bf4(PP + (size_t)row * D + col);
        *(f32x4*)(H3F + (size_t)row * D + col) = (f32x4){h.x + sigm(v.x) * pp.x, h.y + sigm(v.y) * pp.y, h.z + sigm(v.z) * pp.z, h.w + sigm(v.w) * pp.w};
    }
};

__global__ void k_rowrs(const bf16_t* __restrict__ X, int ld, int off, int width, float* __restrict__ RS) {
    const int row = blockIdx.x * 4 + (threadIdx.x >> 6), lane = threadIdx.x & 63;
    const bf16_t* p = X + (size_t)row * ld + off; float s = 0.f;
    for (int c = lane * 4; c < width; c += 256) { const f32x4 v = ld_bf4(p + c); s += v.x * v.x + v.y * v.y + v.z * v.z + v.w * v.w; }
    s = wave_sum(s);
    if (lane == 0) RS[row] = 1.0f / sqrtf(s / (float)width + EPS);
}
__global__ void k_final(const float* __restrict__ H3F, const float* __restrict__ gf, float* __restrict__ out) {
    const int row = blockIdx.x * 4 + (threadIdx.x >> 6), lane = threadIdx.x & 63;
    const f32x4* xr = (const f32x4*)(H3F + (size_t)row * D) + lane;
    float s = 0.f; f32x4 v[4];
#pragma unroll
    for (int j = 0; j < 4; ++j) { v[j] = xr[64 * j]; s += v[j].x * v[j].x + v[j].y * v[j].y + v[j].z * v[j].z + v[j].w * v[j].w; }
    s = wave_sum(s); const float rs = 1.0f / sqrtf(s * (1.0f / D) + EPS);
    f32x4* o = (f32x4*)(out + (size_t)row * D) + lane; const f32x4* g4 = (const f32x4*)gf + lane;
#pragma unroll
    for (int j = 0; j < 4; ++j) o[64 * j] = v[j] * rs * g4[64 * j];
}

__global__ void __launch_bounds__(256) k_attn_naive(const bf16_t* __restrict__ QB, const bf16_t* __restrict__ KB, const bf16_t* __restrict__ VB, const float* __restrict__ bias, bf16_t* __restrict__ MIX) {
    const int i = blockIdx.x * blockDim.x + threadIdx.x;
    const int h = i % NH, tok = i / NH; if (tok >= NT) return;
    const int s = tok / SEQ, pos = tok % SEQ;
    float q[HD];
    { const u32x4* qp = (const u32x4*)(QB + (size_t)tok * AW + h * HD);
#pragma unroll
      for (int c = 0; c < 8; ++c) { const u32x4 w = qp[c]; q[8 * c] = bflo(w.x); q[8 * c + 1] = bfhi(w.x); q[8 * c + 2] = bflo(w.y); q[8 * c + 3] = bfhi(w.y); q[8 * c + 4] = bflo(w.z); q[8 * c + 5] = bfhi(w.z); q[8 * c + 6] = bflo(w.w); q[8 * c + 7] = bfhi(w.w); } }
    float o[HD];
#pragma unroll
    for (int c = 0; c < HD; ++c) o[c] = 0.f;
    float m = -1e30f, l = 0.f;
    for (int b = 0; b < 3; ++b) {
        const int dil = b == 0 ? 1 : (b == 1 ? 4 : 16);
        const float* bt = bias + (b * NH + h) * 129;
        for (int off = -64; off <= 64; ++off) {
            const int kp = pos + off * dil; if (kp < 0 || kp >= SEQ) continue;
            const size_t kt = (size_t)s * SEQ + kp;
            const u32x4* kr = (const u32x4*)(KB + kt * AW + h * HD);
            float sc = 0.f;
#pragma unroll
            for (int c = 0; c < 8; ++c) { const u32x4 w = kr[c]; sc += q[8 * c] * bflo(w.x) + q[8 * c + 1] * bfhi(w.x) + q[8 * c + 2] * bflo(w.y) + q[8 * c + 3] * bfhi(w.y) + q[8 * c + 4] * bflo(w.z) + q[8 * c + 5] * bfhi(w.z) + q[8 * c + 6] * bflo(w.w) + q[8 * c + 7] * bfhi(w.w); }
            sc += bt[off + 64];
            const float mn = fmaxf(m, sc), f = exp2f(m - mn), pe = exp2f(sc - mn);
            l = l * f + pe; m = mn;
            const u32x4* vr = (const u32x4*)(VB + kt * AW + h * HD);
#pragma unroll
            for (int c = 0; c < 8; ++c) { const u32x4 w = vr[c];
                o[8 * c] = o[8 * c] * f + pe * bflo(w.x); o[8 * c + 1] = o[8 * c + 1] * f + pe * bfhi(w.x); o[8 * c + 2] = o[8 * c + 2] * f + pe * bflo(w.y); o[8 * c + 3] = o[8 * c + 3] * f + pe * bfhi(w.y);
                o[8 * c + 4] = o[8 * c + 4] * f + pe * bflo(w.z); o[8 * c + 5] = o[8 * c + 5] * f + pe * bfhi(w.z); o[8 * c + 6] = o[8 * c + 6] * f + pe * bflo(w.w); o[8 * c + 7] = o[8 * c + 7] * f + pe * bfhi(w.w); }
        }
    }
    const float il = 1.0f / l;
    u32x4* op = (u32x4*)(MIX + (size_t)tok * D + h * HD);
#pragma unroll
    for (int c = 0; c < 8; ++c) { u32x4 w; w.x = pk2(o[8 * c] * il, o[8 * c + 1] * il); w.y = pk2(o[8 * c + 2] * il, o[8 * c + 3] * il); w.z = pk2(o[8 * c + 4] * il, o[8 * c + 5] * il); w.w = pk2(o[8 * c + 6] * il, o[8 * c + 7] * il); op[c] = w; }
}

__global__ void k_scan(const bf16_t* __restrict__ SB, const float* __restrict__ PW, bf16_t* __restrict__ UH) {
    const int i = blockIdx.x * blockDim.x + threadIdx.x;
    if (i >= NSEQ * NG * 2 * NS) return;
    const int n = i % NS, dir = (i / NS) % 2, g = (i / (2 * NS)) % NG, s = i / (2 * NS * NG);
    const float* pw = PW + ((size_t)((g * 2 + dir) * NS + n) * 17 + 16) * 2;
    const float ar = pw[0], ai = pw[1];
    float hr = 0.f, hi = 0.f;
    const size_t base = (size_t)g * NCHT + (size_t)s * NCHS; const int colo = dir * 128 + 2 * n;
    for (int t = 0; t < NCHS; ++t) {
        const int c = dir == 0 ? t : NCHS - 1 - t;
        *(unsigned*)(UH + (base + c) * 512 + 256 + colo) = pk2(hr, hi);
        const unsigned w = *(const unsigned*)(SB + (base + c) * 256 + colo);
        const float sr = bflo(w), si = bfhi(w);
        const float nr = ar * hr - ai * hi + sr, ni = ar * hi + ai * hr + si;
        hr = nr; hi = ni;
    }
}

template <class Epi>
static void launch_gemm(hipStream_t st, const bf16_t* A, int lda, const bf16_t* Bt, int ldb, int M, int N, int K, int batch, size_t sA, size_t sB, Epi E, const float* midnum = nullptr, const float* midden = nullptr, int midK = 0) {
    GemmP p{A, Bt, midnum, midden, sA, sB, lda, ldb, K, midK};
    hipLaunchKernelGGL(k_gemm<Epi>, dim3(M / 128, N / 128, batch), dim3(256), 0, st, p, E);
}

extern "C" void kernel_launch(void* const* d_in, const int* in_sizes, int n_in, void* d_out, int out_size, void* d_ws, size_t ws_size, hipStream_t stream) {
    if (n_in != 27 || ws_size < WS_END || out_size != NT * D) { fprintf(stderr, "kernel_launch: unexpected sizes n_in %d ws %zu out %d\n", n_in, ws_size, out_size); return; }
    const float* const* in = (const float* const*)d_in;
    const float *xp = in[0], *xs = in[1], *pp = in[2], *ps = in[3], *rel_bias = in[4], *g_mix = in[5], *w_in = in[6];
    const float *a_re = in[7], *a_im = in[8], *log_dt = in[9], *b_re = in[10], *b_im = in[11], *c_re = in[12], *c_im = in[13], *ssm_d = in[14];
    const float *w_glu = in[15], *b_glu = in[16], *g_att = in[17], *g_ssm = in[18], *w_out = in[19], *g_mlp = in[20], *w_mlp1 = in[21], *w_mlp2 = in[22];
    const float *g_ple = in[23], *w_gate = in[24], *w_proj = in[25], *g_final = in[26];
    unsigned char* ws = (unsigned char*)d_ws; unsigned char* dob = (unsigned char*)d_out;
    float* BIAS = (float*)(ws + WS_BIAS); float* PW = (float*)(ws + WS_PW); float* BBt = (float*)(ws + WS_BB);
    float *RS0 = (float*)(ws + WS_RS0), *RSA = (float*)(ws + WS_RSA), *RSS = (float*)(ws + WS_RSS), *RS1 = (float*)(ws + WS_RS1), *RS2 = (float*)(ws + WS_RS2);
    bf16_t *W1T = (bf16_t*)(ws + WS_W1T), *W2T = (bf16_t*)(ws + WS_W2T), *WGT = (bf16_t*)(ws + WS_WGT), *WPT = (bf16_t*)(ws + WS_WPT), *PB = (bf16_t*)(ws + WS_PB);
    bf16_t *WINT = (bf16_t*)(ws + WS_WINT), *WOUTT = (bf16_t*)(ws + WS_WOUTT), *WGLUT = (bf16_t*)(ws + WS_WGLUT), *WST = (bf16_t*)(ws + WS_WST), *WYT = (bf16_t*)(ws + WS_WYT);
    bf16_t *SB = (bf16_t*)(ws + WS_SB), *QB = (bf16_t*)(ws + WS_QB), *KB = (bf16_t*)(ws + WS_KB), *VB = (bf16_t*)(ws + WS_VB), *UH = (bf16_t*)(ws + WS_UH);
    bf16_t *MIX = (bf16_t*)(ws + WS_MIX), *GB = (bf16_t*)(ws + WS_GB), *HID = (bf16_t*)(ws + WS_HID), *PP = (bf16_t*)(ws + WS_PP);
    float* H3F = (float*)(ws + WS_H3F);
    bf16_t *XB = (bf16_t*)(dob + DO_XB), *H1B = (bf16_t*)(dob + DO_H1B), *H2B = (bf16_t*)(dob + DO_H2B);
    auto nb = [](size_t n) { return dim3((unsigned)((n + 255) / 256)); };
    hipLaunchKernelGGL(k_prep_wt, nb((size_t)D * INC), dim3(256), 0, stream, w_in, D, INC, g_mix, WINT, D, AW, C2);
    hipLaunchKernelGGL(k_prep_wt, nb((size_t)SW * SW), dim3(256), 0, stream, w_glu, SW, SW, (const float*)nullptr, WGLUT, SW, 0, 1.f);
    hipLaunchKernelGGL(k_prep_wout, nb((size_t)D * D), dim3(256), 0, stream, w_out, g_att, g_ssm, WOUTT);
    hipLaunchKernelGGL(k_prep_wt, nb((size_t)D * DFF), dim3(256), 0, stream, w_mlp1, D, DFF, g_mlp, W1T, D, 0, 1.f);
    hipLaunchKernelGGL(k_prep_wt, nb((size_t)DFF * D), dim3(256), 0, stream, w_mlp2, DFF, D, (const float*)nullptr, W2T, DFF, 0, 1.f);
    hipLaunchKernelGGL(k_prep_wt, nb((size_t)D * D), dim3(256), 0, stream, w_gate, D, D, g_ple, WGT, D, 0, 1.f);
    hipLaunchKernelGGL(k_prep_wt, nb((size_t)PLE * D), dim3(256), 0, stream, w_proj, PLE, D, (const float*)nullptr, WPT, PLE, 0, 1.f);
    hipLaunchKernelGGL(k_prep_bias, nb(3 * 8 * 129), dim3(256), 0, stream, rel_bias, BIAS);
    hipLaunchKernelGGL(k_ssm_tab, nb(NG * 2 * NS), dim3(256), 0, stream, a_re, a_im, log_dt, b_re, b_im, PW, BBt);
    hipLaunchKernelGGL(k_ssm_ws, nb((size_t)NG * 256 * 256), dim3(256), 0, stream, (const float*)PW, (const float*)BBt, WST);
    hipLaunchKernelGGL(k_ssm_wy, nb((size_t)NG * 256 * 512), dim3(256), 0, stream, (const float*)PW, (const float*)BBt, c_re, c_im, ssm_d, WYT);
    hipLaunchKernelGGL(k_rows_x, dim3(NT / 4), dim3(256), 0, stream, xp, xs, XB, RS0);
    hipLaunchKernelGGL(k_cvt_p, nb((size_t)NT * PLE / 4), dim3(256), 0, stream, pp, ps, PB);
    launch_gemm(stream, XB, D, WINT, D, NT, INC, D, 1, 0, 0, EpiIn{RS0, QB, KB, VB, UH});
    hipLaunchKernelGGL(k_attn_naive, nb((size_t)NT * NH), dim3(256), 0, stream, (const bf16_t*)QB, (const bf16_t*)KB, (const bf16_t*)VB, (const float*)BIAS, MIX);
    launch_gemm(stream, UH, 512, WST, 256, NCHT, 256, 256, NG, (size_t)NCHT * 512, (size_t)256 * 256, EpiS{SB});
    hipLaunchKernelGGL(k_scan, nb(NSEQ * NG * 2 * NS), dim3(256), 0, stream, (const bf16_t*)SB, (const float*)PW, UH);
    launch_gemm(stream, UH, 512, WYT, 512, NCHT, 256, 512, NG, (size_t)NCHT * 512, (size_t)256 * 512, EpiY{GB});
    launch_gemm(stream, GB, SW, WGLUT, SW, NT, SW, SW, 1, 0, 0, EpiGlu{GB, b_glu, MIX});
    hipLaunchKernelGGL(k_rowrs, dim3(NT / 4), dim3(256), 0, stream, (const bf16_t*)MIX, D, 0, AW, RSA);
    hipLaunchKernelGGL(k_rowrs, dim3(NT / 4), dim3(256), 0, stream, (const bf16_t*)MIX, D, AW, SW, RSS);
    launch_gemm(stream, MIX, D, WOUTT, D, NT, D, D, 1, 0, 0, EpiOut{xp, xs, RSS, H1B}, RSA, RSS, AW);
    hipLaunchKernelGGL(k_rowrs, dim3(NT / 4), dim3(256), 0, stream, (const bf16_t*)H1B, D, 0, D, RS1);
    launch_gemm(stream, H1B, D, W1T, D, NT, DFF, D, 1, 0, 0, EpiMlp1{RS1, HID});
    launch_gemm(stream, HID, DFF, W2T, DFF, NT, D, DFF, 1, 0, 0, EpiMlp2{H1B, H2B});
    hipLaunchKernelGGL(k_rowrs, dim3(NT / 4), dim3(256), 0, stream, (const bf16_t*)H2B, D, 0, D, RS2);
    launch_gemm(stream, PB, PLE, WPT, PLE, NT, D, PLE, 1, 0, 0, EpiPP{PP});
    launch_gemm(stream, H2B, D, WGT, D, NT, D, D, 1, 0, 0, EpiGate{RS2, H2B, PP, H3F});
    hipLaunchKernelGGL(k_final, dim3(NT / 4), dim3(256), 0, stream, (const float*)H3F, g_final, (float*)d_out);
}
```

```cpp
#include <hip/hip_runtime.h>
#include <hip/hip_cooperative_groups.h>
namespace cg = cooperative_groups;
#include <cstdio>
#include <cstdint>
#include <cmath>

typedef unsigned short bf16_t;
typedef short bf16x8 __attribute__((ext_vector_type(8)));
typedef float f32x4 __attribute__((ext_vector_type(4)));
typedef unsigned u32x2 __attribute__((ext_vector_type(2)));
typedef unsigned u32x4 __attribute__((ext_vector_type(4)));

constexpr int NT = 49152, SEQ = 8192, NSEQ = 6, NPROMPT = 16384;
constexpr int D = 1024, DFF = 4096, PLE = 256, INC = 2048, AW = 512, SW = 512;
constexpr int NH = 8, HD = 64, NG = 32, GC = 16, NS = 64;
constexpr int TCH = 16, NCHT = NT / TCH  , NCHS = SEQ / TCH  ;
constexpr float EPS = 1e-6f;
constexpr float LOG2E = 1.4426950408889634f;
constexpr float C2 = 0.125f * LOG2E;

constexpr size_t MiB = 1u << 20;
constexpr size_t WS_BIAS = 0;
constexpr size_t WS_PW = 64 * 1024;
constexpr size_t WS_BB = 1 * MiB;
constexpr size_t WS_RS0 = 2 * MiB;
constexpr size_t WS_RSA = WS_RS0 + 256 * 1024;
constexpr size_t WS_RSS = WS_RSA + 256 * 1024;
constexpr size_t WS_RS1 = WS_RSS + 256 * 1024;
constexpr size_t WS_RS2 = WS_RS1 + 256 * 1024;
constexpr size_t WS_W1T = 18 * MiB, WS_W2T = 26 * MiB, WS_WGT = 34 * MiB, WS_WPT = 36 * MiB;
constexpr size_t WS_PB = 37 * MiB;
constexpr size_t WS_WINT = 61 * MiB, WS_WOUTT = 65 * MiB, WS_WGLUT = 67 * MiB, WS_WST = 68 * MiB, WS_WYT = 72 * MiB;
constexpr size_t WS_SB = 80 * MiB;
constexpr size_t WS_QB = 128 * MiB, WS_KB = 176 * MiB, WS_VB = 224 * MiB;
constexpr size_t WS_UH = 272 * MiB;
constexpr size_t WS_MIX = 368 * MiB;
constexpr size_t WS_GB = 464 * MiB;
constexpr size_t WS_HID = 128 * MiB;
constexpr size_t WS_PP = 128 * MiB;
constexpr size_t WS_H3F = 224 * MiB;
constexpr size_t WS_END = 512 * MiB;
constexpr size_t DO_XB = 0, DO_H1B = 0, DO_H2B = 96 * MiB;

__device__ __forceinline__ unsigned f2bf(float f) { unsigned u = __builtin_bit_cast(unsigned, f); return (u + 0x7fffu + ((u >> 16) & 1u)) >> 16; }
__device__ __forceinline__ unsigned pk2(float lo, float hi) { return f2bf(lo) | (f2bf(hi) << 16); }
__device__ __forceinline__ float bf2f(unsigned short b) { return __builtin_bit_cast(float, (unsigned)b << 16); }
__device__ __forceinline__ float bflo(unsigned w) { return __builtin_bit_cast(float, w << 16); }
__device__ __forceinline__ float bfhi(unsigned w) { return __builtin_bit_cast(float, w & 0xffff0000u); }
__device__ __forceinline__ float wave_sum(float v) {
#pragma unroll
    for (int o = 1; o < 64; o <<= 1) v += __shfl_xor(v, o);
    return v;
}
__device__ __forceinline__ const float* xrow(const float* xp, const float* xs, int tok, int width) {
    return tok < NPROMPT ? xp + (size_t)tok * width : xs + (size_t)(tok - NPROMPT) * width;
}


constexpr int NTHR = 512;
#define GTID ((size_t)blockIdx.x * NTHR + threadIdx.x)
#define GSIZE ((size_t)gridDim.x * NTHR)

__device__ __forceinline__ void ph_prep_wt(const float* __restrict__ W, int K, int N, const float* __restrict__ g, bf16_t* __restrict__ out, int ldo, int nscale, float sc) {
    for (size_t i = GTID; i < (size_t)K * N; i += GSIZE) {
        const int k = (int)(i / N), n = (int)(i % N);
        float v = W[i]; if (g) v *= g[k]; if (n < nscale) v *= sc;
        out[(size_t)n * ldo + k] = (bf16_t)f2bf(v);
    }
}
__device__ __forceinline__ void ph_prep_wout(const float* __restrict__ W, const float* __restrict__ ga, const float* __restrict__ gs, bf16_t* __restrict__ out) {
    for (size_t i = GTID; i < (size_t)D * D; i += GSIZE) {
        const int k = (int)(i / D), n = (int)(i % D);
        const float v = W[i] * (k < AW ? ga[k] : gs[k - AW]);
        out[(size_t)n * D + k] = (bf16_t)f2bf(v);
    }
}
__device__ __forceinline__ int t5_bucket(int rel) {
    int n = -rel; int ret = n < 0 ? 16 : 0; n = n < 0 ? -n : n;
    if (n < 8) return ret + n;
    int large = 8 + (int)(log((double)n / 8.0) / log(128.0) * 8.0);
    large = large < 15 ? large : 15;
    return ret + large;
}
__device__ __forceinline__ void ph_prep_bias(const float* __restrict__ rel_bias, float* __restrict__ bias) {
    for (size_t i = GTID; i < 3 * 8 * 129; i += GSIZE) {
        const int o = (int)(i % 129), h = (int)((i / 129) % 8), b = (int)(i / (129 * 8));
        const int dil = b == 0 ? 1 : (b == 1 ? 4 : 16);
        bias[i] = rel_bias[t5_bucket((o - 64) * dil) * NH + h] * LOG2E;
    }
}
__device__ __forceinline__ void ph_rows_x(const float* __restrict__ xp, const float* __restrict__ xs, bf16_t* __restrict__ XB, float* __restrict__ RS0) {
    const int lane = threadIdx.x & 63;
    for (int row = blockIdx.x * 8 + (threadIdx.x >> 6); row < NT; row += gridDim.x * 8) {
        const f32x4* xr = (const f32x4*)xrow(xp, xs, row, D) + lane;
        float s = 0.f; f32x4 v[4];
#pragma unroll
        for (int j = 0; j < 4; ++j) { v[j] = xr[64 * j]; s += v[j].x * v[j].x + v[j].y * v[j].y + v[j].z * v[j].z + v[j].w * v[j].w; }
        s = wave_sum(s);
        u32x2* o = (u32x2*)(XB + (size_t)row * D) + lane;
#pragma unroll
        for (int j = 0; j < 4; ++j) { u32x2 w; w.x = pk2(v[j].x, v[j].y); w.y = pk2(v[j].z, v[j].w); o[64 * j] = w; }
        if (lane == 0) RS0[row] = 1.0f / sqrtf(s * (1.0f / D) + EPS);
    }
}
__device__ __forceinline__ void ph_cvt_p(const float* __restrict__ pp, const float* __restrict__ ps, bf16_t* __restrict__ PB) {
    for (size_t i = GTID; i < (size_t)NT * PLE / 4; i += GSIZE) {
        const int tok = (int)(i / (PLE / 4)), c4 = (int)(i % (PLE / 4));
        const f32x4 v = *((const f32x4*)xrow(pp, ps, tok, PLE) + c4);
        u32x2 w; w.x = pk2(v.x, v.y); w.y = pk2(v.z, v.w);
        *((u32x2*)(PB + (size_t)tok * PLE) + c4) = w;
    }
}
__device__ __forceinline__ void ph_ssm_tab(const float* __restrict__ a_re, const float* __restrict__ a_im, const float* __restrict__ log_dt,
                          const float* __restrict__ b_re, const float* __restrict__ b_im, float* __restrict__ PW, float* __restrict__ BB) {
    for (size_t ii = GTID; ii < NG * 2 * NS; ii += GSIZE) {
        const int i = (int)ii;
        const int n = i % NS, dir = (i / NS) % 2, g = i / (2 * NS);
        const int pi = (dir * NG + g) * NS + n;
        const double ar = a_re[pi], ai = a_im[pi], dt = exp((double)log_dt[dir * NG + g]);
        float* pw = PW + (size_t)((g * 2 + dir) * NS + n) * 17 * 2;
        for (int e = 0; e <= 16; ++e) { const double mag = exp(ar * dt * e), ang = ai * dt * e; pw[2 * e] = (float)(mag * cos(ang)); pw[2 * e + 1] = (float)(mag * sin(ang)); }
        const double abr = exp(ar * dt) * cos(ai * dt), abi = exp(ar * dt) * sin(ai * dt), inv = 1.0 / (ar * ar + ai * ai);
        const double fr = ((abr - 1.0) * ar + abi * ai) * inv, fi = (abi * ar - (abr - 1.0) * ai) * inv;
        float* bb = BB + (size_t)((g * 2 + dir) * NS + n) * GC * 2;
        for (int h = 0; h < GC; ++h) { const double br = b_re[(size_t)pi * GC + h], bi = b_im[(size_t)pi * GC + h]; bb[2 * h] = (float)(fr * br - fi * bi); bb[2 * h + 1] = (float)(fr * bi + fi * br); }
    }
}
__device__ __forceinline__ void ph_ssm_ws(const float* __restrict__ PW, const float* __restrict__ BB, bf16_t* __restrict__ WST) {
    for (size_t ii = GTID; ii < (size_t)NG * 256 * 256; ii += GSIZE) {
        const int i = (int)ii;
        const int k = i % 256, col = (i / 256) % 256, g = i / 65536;
        const int j = k / 16, hp = k % 16, dir = col / 128, n = (col % 128) / 2, ri = col & 1;
        const int e = dir == 0 ? 15 - j : j;
        const float* pw = PW + ((size_t)((g * 2 + dir) * NS + n) * 17 + e) * 2; const float* bb = BB + ((size_t)((g * 2 + dir) * NS + n) * GC + hp) * 2;
        const float vr = pw[0] * bb[0] - pw[1] * bb[1], vi = pw[0] * bb[1] + pw[1] * bb[0];
        WST[i] = (bf16_t)f2bf(ri ? vi : vr);
    }
}
__device__ __forceinline__ void ph_ssm_wy(const float* __restrict__ PW, const float* __restrict__ BB, const float* __restrict__ c_re, const float* __restrict__ c_im,
                         const float* __restrict__ dd, bf16_t* __restrict__ WYT) {
    for (size_t ii = GTID; ii < (size_t)NG * 256 * 512; ii += GSIZE) {
        const int i = (int)ii;
        const int k = i % 512, jh = (i / 512) % 256, g = i / (512 * 256);
        const int j = jh / 16, h = jh % 16;
        float v = 0.f;
        if (k < 256) {
            const int jp = k / 16, hp = k % 16;
            for (int dir = 0; dir < 2; ++dir) {
                const int e = dir == 0 ? j - jp : jp - j;
                if (e < 0) continue;
                for (int n = 0; n < NS; ++n) {
                    const float* pw = PW + ((size_t)((g * 2 + dir) * NS + n) * 17 + e) * 2; const float* bb = BB + ((size_t)((g * 2 + dir) * NS + n) * GC + hp) * 2;
                    const size_t ci = ((size_t)(dir * NG + g) * GC + h) * NS + n;
                    const float cr = c_re[ci], cim = c_im[ci];
                    const float tr = pw[0] * bb[0] - pw[1] * bb[1], ti = pw[0] * bb[1] + pw[1] * bb[0];
                    v += cr * tr - cim * ti;
                }
            }
            if (jp == j && hp == h) v += dd[g * GC + h];
        } else {
            const int kk = k - 256, dir = kk / 128, n = (kk % 128) / 2, ri = kk & 1;
            const int e = dir == 0 ? j + 1 : 16 - j;
            const float* pw = PW + ((size_t)((g * 2 + dir) * NS + n) * 17 + e) * 2;
            const size_t ci = ((size_t)(dir * NG + g) * GC + h) * NS + n;
            const float cr = c_re[ci], cim = c_im[ci];
            const float pr = cr * pw[0] - cim * pw[1], pim = cr * pw[1] + cim * pw[0];
            v = ri ? -pim : pr;
        }
        WYT[i] = (bf16_t)f2bf(v);
    }
}

struct GemmP { const bf16_t* A; const bf16_t* Bt; const float* midnum; const float* midden; size_t strideA, strideB; int lda, ldb, K, midK; };
template <class Epi>
__device__ __forceinline__ void ph_gemm(const GemmP p, int M, int N, int batch, const Epi E) {
    const int lane = threadIdx.x & 63, wid = threadIdx.x >> 6, fr = lane & 15, fq = lane >> 4;
    const int tm = M / 128, tn = N / 256, ntile = tm * tn * batch;
    for (int t = blockIdx.x; t < ntile; t += gridDim.x) {
        const int bz = t / (tm * tn), r = t % (tm * tn), bm = r / tn, bn = r % tn;
        const int m0 = bm * 128 + (wid >> 2) * 64, n0 = bn * 256 + (wid & 3) * 64;
        const bf16_t* A = p.A + (size_t)bz * p.strideA + (size_t)(m0 + fr) * p.lda + fq * 8;
        const bf16_t* B = p.Bt + (size_t)bz * p.strideB + (size_t)(n0 + fr) * p.ldb + fq * 8;
        f32x4 acc[4][4];
#pragma unroll
        for (int m = 0; m < 4; ++m)
#pragma unroll
            for (int n = 0; n < 4; ++n) acc[m][n] = (f32x4){0.f, 0.f, 0.f, 0.f};
        for (int k0 = 0; k0 < p.K; k0 += 32) {
            if (p.midK && k0 == p.midK) {
#pragma unroll
                for (int m = 0; m < 4; ++m) { const float rr = p.midnum[m0 + m * 16 + fr] / p.midden[m0 + m * 16 + fr];
#pragma unroll
                    for (int n = 0; n < 4; ++n) acc[m][n] = acc[m][n] * rr; }
            }
            bf16x8 a[4], b[4];
#pragma unroll
            for (int m = 0; m < 4; ++m) a[m] = *(const bf16x8*)(A + (size_t)m * 16 * p.lda + k0);
#pragma unroll
            for (int n = 0; n < 4; ++n) b[n] = *(const bf16x8*)(B + (size_t)n * 16 * p.ldb + k0);
#pragma unroll
            for (int m = 0; m < 4; ++m)
#pragma unroll
                for (int n = 0; n < 4; ++n) acc[m][n] = __builtin_amdgcn_mfma_f32_16x16x32_bf16(b[n], a[m], acc[m][n], 0, 0, 0);
        }
#pragma unroll
        for (int m = 0; m < 4; ++m)
#pragma unroll
            for (int n = 0; n < 4; ++n) E(bz, m0 + m * 16 + fr, n0 + n * 16 + fq * 4, acc[m][n]);
    }
}
__device__ __forceinline__ void st_bf4(bf16_t* p, f32x4 v) { u32x2 w; w.x = pk2(v.x, v.y); w.y = pk2(v.z, v.w); *(u32x2*)p = w; }
__device__ __forceinline__ f32x4 ld_bf4(const bf16_t* p) { const u32x2 w = *(const u32x2*)p; return (f32x4){bflo(w.x), bfhi(w.x), bflo(w.y), bfhi(w.y)}; }
__device__ __forceinline__ float sigm(float x) { return 1.0f / (1.0f + __expf(-x)); }
__device__ __forceinline__ float gelu_tanh(float x) { const float u = 0.7978845608028654f * (x + 0.044715f * x * x * x); return 0.5f * x * (1.0f + tanhf(u)); }

struct EpiIn {
    const float* RS0; bf16_t *QB, *KB, *VB, *UH;
    __device__ void operator()(int, int row, int col, f32x4 v) const {
        v = v * RS0[row];
        if (col < 3 * AW) { bf16_t* dst = col < AW ? QB : (col < 2 * AW ? KB : VB); st_bf4(dst + (size_t)row * AW + (col & (AW - 1)), v); }
        else { const int c = col - 3 * AW, g = c >> 4, ch = c & 15, chunk = row >> 4, j = row & 15; st_bf4(UH + ((size_t)(g * NCHT + chunk)) * 512 + j * 16 + ch, v); }
    }
};
struct EpiS {
    bf16_t* SB;
    __device__ void operator()(int g, int row, int col, f32x4 v) const { st_bf4(SB + ((size_t)(g * NCHT + row)) * 256 + col, v); }
};
struct EpiY {
    bf16_t* GB;
    __device__ void operator()(int g, int row, int col, f32x4 v) const {
        const int j = col >> 4, h = col & 15; const size_t tok = (size_t)row * 16 + j;
        st_bf4(GB + tok * SW + g * 16 + h, (f32x4){gelu_tanh(v.x), gelu_tanh(v.y), gelu_tanh(v.z), gelu_tanh(v.w)});
    }
};
struct EpiGlu {
    const bf16_t* GB; const float* bglu; bf16_t* MIX;
    __device__ void operator()(int, int row, int col, f32x4 v) const {
        const f32x4 gv = ld_bf4(GB + (size_t)row * SW + col); const f32x4 b = *(const f32x4*)(bglu + col);
        st_bf4(MIX + (size_t)row * D + AW + col, (f32x4){gv.x * sigm(v.x + b.x), gv.y * sigm(v.y + b.y), gv.z * sigm(v.z + b.z), gv.w * sigm(v.w + b.w)});
    }
};
struct EpiOut {
    const float *xp, *xs; const float* RSS; bf16_t* H1B;
    __device__ void operator()(int, int row, int col, f32x4 v) const {
        const f32x4 xv = *(const f32x4*)(xrow(xp, xs, row, D) + col);
        st_bf4(H1B + (size_t)row * D + col, xv + v * RSS[row]);
    }
};
struct EpiMlp1 {
    const float* RS1; bf16_t* HID;
    __device__ void operator()(int, int row, int col, f32x4 v) const {
        v = v * RS1[row]; f32x4 r; r.x = fmaxf(v.x, 0.f); r.y = fmaxf(v.y, 0.f); r.z = fmaxf(v.z, 0.f); r.w = fmaxf(v.w, 0.f);
        st_bf4(HID + (size_t)row * DFF + col, r * r);
    }
};
struct EpiMlp2 {
    const bf16_t* H1B; bf16_t* H2B;
    __device__ void operator()(int, int row, int col, f32x4 v) const { st_bf4(H2B + (size_t)row * D + col, ld_bf4(H1B + (size_t)row * D + col) + v); }
};
struct EpiPP {
    bf16_t* PP;
    __device__ void operator()(int, int row, int col, f32x4 v) const { st_bf4(PP + (size_t)row * D + col, v); }
};
struct EpiGate {
    const float* RS2; const bf16_t* H2B; const bf16_t* PP; float* H3F;
    __device__ void operator()(int, int row, int col, f32x4 v) const {
        v = v * RS2[row]; const f32x4 h = ld_bf4(H2B + (size_t)row * D + col), pp = ld_bf4(PP + (size_t)row * D + col);
        *(f32x4*)(H3F + (size_t)row * D + col) = (f32x4){h.x + sigm(v.x) * pp.x, h.y + sigm(v.y) * pp.y, h.z + sigm(v.z) * pp.z, h.w + sigm(v.w) * pp.w};
    }
};


__device__ __forceinline__ void ph_rowrs(const bf16_t* __restrict__ X, int ld, int off, int width, float* __restrict__ RS) {
    const int lane = threadIdx.x & 63;
    for (int row = blockIdx.x * 8 + (threadIdx.x >> 6); row < NT; row += gridDim.x * 8) {
        const bf16_t* p = X + (size_t)row * ld + off; float s = 0.f;
        for (int c = lane * 4; c < width; c += 256) { const f32x4 v = ld_bf4(p + c); s += v.x * v.x + v.y * v.y + v.z * v.z + v.w * v.w; }
        s = wave_sum(s);
        if (lane == 0) RS[row] = 1.0f / sqrtf(s / (float)width + EPS);
    }
}
__device__ __forceinline__ void ph_final(const float* __restrict__ H3F, const float* __restrict__ gf, float* __restrict__ out) {
    const int lane = threadIdx.x & 63;
    for (int row = blockIdx.x * 8 + (threadIdx.x >> 6); row < NT; row += gridDim.x * 8) {
        const f32x4* xr = (const f32x4*)(H3F + (size_t)row * D) + lane;
        float s = 0.f; f32x4 v[4];
#pragma unroll
        for (int j = 0; j < 4; ++j) { v[j] = xr[64 * j]; s += v[j].x * v[j].x + v[j].y * v[j].y + v[j].z * v[j].z + v[j].w * v[j].w; }
        s = wave_sum(s); const float rs = 1.0f / sqrtf(s * (1.0f / D) + EPS);
        f32x4* o = (f32x4*)(out + (size_t)row * D) + lane; const f32x4* g4 = (const f32x4*)gf + lane;
#pragma unroll
        for (int j = 0; j < 4; ++j) o[64 * j] = v[j] * rs * g4[64 * j];
    }
}

__device__ __forceinline__ void ph_attn_naive(const bf16_t* __restrict__ QB, const bf16_t* __restrict__ KB, const bf16_t* __restrict__ VB, const float* __restrict__ bias, bf16_t* __restrict__ MIX) {
    for (size_t ii = GTID; ii < (size_t)NT * NH; ii += GSIZE) {
        const int i = (int)ii;
        const int h = i % NH, tok = i / NH;
        const int s = tok / SEQ, pos = tok % SEQ;
        float q[HD];
        { const u32x4* qp = (const u32x4*)(QB + (size_t)tok * AW + h * HD);
#pragma unroll
          for (int c = 0; c < 8; ++c) { const u32x4 w = qp[c]; q[8 * c] = bflo(w.x); q[8 * c + 1] = bfhi(w.x); q[8 * c + 2] = bflo(w.y); q[8 * c + 3] = bfhi(w.y); q[8 * c + 4] = bflo(w.z); q[8 * c + 5] = bfhi(w.z); q[8 * c + 6] = bflo(w.w); q[8 * c + 7] = bfhi(w.w); } }
        float o[HD];
#pragma unroll
        for (int c = 0; c < HD; ++c) o[c] = 0.f;
        float m = -1e30f, l = 0.f;
        for (int b = 0; b < 3; ++b) {
            const int dil = b == 0 ? 1 : (b == 1 ? 4 : 16);
            const float* bt = bias + (b * NH + h) * 129;
            for (int off = -64; off <= 64; ++off) {
                const int kp = pos + off * dil; if (kp < 0 || kp >= SEQ) continue;
                const size_t kt = (size_t)s * SEQ + kp;
                const u32x4* kr = (const u32x4*)(KB + kt * AW + h * HD);
                float sc = 0.f;
#pragma unroll
                for (int c = 0; c < 8; ++c) { const u32x4 w = kr[c]; sc += q[8 * c] * bflo(w.x) + q[8 * c + 1] * bfhi(w.x) + q[8 * c + 2] * bflo(w.y) + q[8 * c + 3] * bfhi(w.y) + q[8 * c + 4] * bflo(w.z) + q[8 * c + 5] * bfhi(w.z) + q[8 * c + 6] * bflo(w.w) + q[8 * c + 7] * bfhi(w.w); }
                sc += bt[off + 64];
                const float mn = fmaxf(m, sc), f = exp2f(m - mn), pe = exp2f(sc - mn);
                l = l * f + pe; m = mn;
                const u32x4* vr = (const u32x4*)(VB + kt * AW + h * HD);
#pragma unroll
                for (int c = 0; c < 8; ++c) { const u32x4 w = vr[c];
                    o[8 * c] = o[8 * c] * f + pe * bflo(w.x); o[8 * c + 1] = o[8 * c + 1] * f + pe * bfhi(w.x); o[8 * c + 2] = o[8 * c + 2] * f + pe * bflo(w.y); o[8 * c + 3] = o[8 * c + 3] * f + pe * bfhi(w.y);
                    o[8 * c + 4] = o[8 * c + 4] * f + pe * bflo(w.z); o[8 * c + 5] = o[8 * c + 5] * f + pe * bfhi(w.z); o[8 * c + 6] = o[8 * c + 6] * f + pe * bflo(w.w); o[8 * c + 7] = o[8 * c + 7] * f + pe * bfhi(w.w); }
            }
        }
        const float il = 1.0f / l;
        u32x4* op = (u32x4*)(MIX + (size_t)tok * D + h * HD);
#pragma unroll
        for (int c = 0; c < 8; ++c) { u32x4 w; w.x = pk2(o[8 * c] * il, o[8 * c + 1] * il); w.y = pk2(o[8 * c + 2] * il, o[8 * c + 3] * il); w.z = pk2(o[8 * c + 4] * il, o[8 * c + 5] * il); w.w = pk2(o[8 * c + 6] * il, o[8 * c + 7] * il); op[c] = w; }
    }
}

__device__ __forceinline__ void ph_scan(const bf16_t* __restrict__ SB, const float* __restrict__ PW, bf16_t* __restrict__ UH) {
    for (size_t ii = GTID; ii < (size_t)NSEQ * NG * 2 * NS; ii += GSIZE) {
        const int i = (int)ii;
        const int n = i % NS, dir = (i / NS) % 2, g = (i / (2 * NS)) % NG, s = i / (2 * NS * NG);
        const float* pw = PW + ((size_t)((g * 2 + dir) * NS + n) * 17 + 16) * 2;
        const float ar = pw[0], ai = pw[1];
        float hr = 0.f, hi = 0.f;
        const size_t base = (size_t)g * NCHT + (size_t)s * NCHS; const int colo = dir * 128 + 2 * n;
        for (int t = 0; t < NCHS; ++t) {
            const int c = dir == 0 ? t : NCHS - 1 - t;
            *(unsigned*)(UH + (base + c) * 512 + 256 + colo) = pk2(hr, hi);
            const unsigned w = *(const unsigned*)(SB + (base + c) * 256 + colo);
            const float sr = bflo(w), si = bfhi(w);
            const float nr = ar * hr - ai * hi + sr, ni = ar * hi + ai * hr + si;
            hr = nr; hi = ni;
        }
    }
}

struct Args { const float* in[27]; float* out; unsigned char* ws; };
__global__ void __launch_bounds__(NTHR, 2) mega(Args a) {
    cg::grid_group grid = cg::this_grid();
    const float *xp = a.in[0], *xs = a.in[1], *pp = a.in[2], *ps = a.in[3], *rel_bias = a.in[4], *g_mix = a.in[5], *w_in = a.in[6];
    const float *a_re = a.in[7], *a_im = a.in[8], *log_dt = a.in[9], *b_re = a.in[10], *b_im = a.in[11], *c_re = a.in[12], *c_im = a.in[13], *ssm_d = a.in[14];
    const float *w_glu = a.in[15], *b_glu = a.in[16], *g_att = a.in[17], *g_ssm = a.in[18], *w_out = a.in[19], *g_mlp = a.in[20], *w_mlp1 = a.in[21], *w_mlp2 = a.in[22];
    const float *g_ple = a.in[23], *w_gate = a.in[24], *w_proj = a.in[25], *g_final = a.in[26];
    unsigned char* ws = a.ws; unsigned char* dob = (unsigned char*)a.out;
    float* BIAS = (float*)(ws + WS_BIAS); float* PW = (float*)(ws + WS_PW); float* BBt = (float*)(ws + WS_BB);
    float *RS0 = (float*)(ws + WS_RS0), *RSA = (float*)(ws + WS_RSA), *RSS = (float*)(ws + WS_RSS), *RS1 = (float*)(ws + WS_RS1), *RS2 = (float*)(ws + WS_RS2);
    bf16_t *W1T = (bf16_t*)(ws + WS_W1T), *W2T = (bf16_t*)(ws + WS_W2T), *WGT = (bf16_t*)(ws + WS_WGT), *WPT = (bf16_t*)(ws + WS_WPT), *PB = (bf16_t*)(ws + WS_PB);
    bf16_t *WINT = (bf16_t*)(ws + WS_WINT), *WOUTT = (bf16_t*)(ws + WS_WOUTT), *WGLUT = (bf16_t*)(ws + WS_WGLUT), *WST = (bf16_t*)(ws + WS_WST), *WYT = (bf16_t*)(ws + WS_WYT);
    bf16_t *SB = (bf16_t*)(ws + WS_SB), *QB = (bf16_t*)(ws + WS_QB), *KB = (bf16_t*)(ws + WS_KB), *VB = (bf16_t*)(ws + WS_VB), *UH = (bf16_t*)(ws + WS_UH);
    bf16_t *MIX = (bf16_t*)(ws + WS_MIX), *GB = (bf16_t*)(ws + WS_GB), *HID = (bf16_t*)(ws + WS_HID), *PP = (bf16_t*)(ws + WS_PP);
    float* H3F = (float*)(ws + WS_H3F);
    bf16_t *XB = (bf16_t*)(dob + DO_XB), *H1B = (bf16_t*)(dob + DO_H1B), *H2B = (bf16_t*)(dob + DO_H2B);
    ph_prep_wt(w_in, D, INC, g_mix, WINT, D, AW, C2);
    ph_prep_wt(w_glu, SW, SW, nullptr, WGLUT, SW, 0, 1.f);
    ph_prep_wout(w_out, g_att, g_ssm, WOUTT);
    ph_prep_wt(w_mlp1, D, DFF, g_mlp, W1T, D, 0, 1.f);
    ph_prep_wt(w_mlp2, DFF, D, nullptr, W2T, DFF, 0, 1.f);
    ph_prep_wt(w_gate, D, D, g_ple, WGT, D, 0, 1.f);
    ph_prep_wt(w_proj, PLE, D, nullptr, WPT, PLE, 0, 1.f);
    ph_prep_bias(rel_bias, BIAS);
    ph_ssm_tab(a_re, a_im, log_dt, b_re, b_im, PW, BBt);
    ph_rows_x(xp, xs, XB, RS0);
    ph_cvt_p(pp, ps, PB);
    grid.sync();
    ph_ssm_ws(PW, BBt, WST);
    ph_ssm_wy(PW, BBt, c_re, c_im, ssm_d, WYT);
    ph_gemm(GemmP{XB, WINT, nullptr, nullptr, 0, 0, D, D, D, 0}, NT, INC, 1, EpiIn{RS0, QB, KB, VB, UH});
    grid.sync();
    ph_attn_naive(QB, KB, VB, BIAS, MIX);
    ph_gemm(GemmP{UH, WST, nullptr, nullptr, (size_t)NCHT * 512, (size_t)256 * 256, 512, 256, 256, 0}, NCHT, 256, NG, EpiS{SB});
    grid.sync();
    ph_scan(SB, PW, UH);
    grid.sync();
    ph_gemm(GemmP{UH, WYT, nullptr, nullptr, (size_t)NCHT * 512, (size_t)256 * 512, 512, 512, 512, 0}, NCHT, 256, NG, EpiY{GB});
    grid.sync();
    ph_gemm(GemmP{GB, WGLUT, nullptr, nullptr, 0, 0, SW, SW, SW, 0}, NT, SW, 1, EpiGlu{GB, b_glu, MIX});
    grid.sync();
    ph_rowrs(MIX, D, 0, AW, RSA);
    ph_rowrs(MIX, D, AW, SW, RSS);
    grid.sync();
    ph_gemm(GemmP{MIX, WOUTT, RSA, RSS, 0, 0, D, D, D, AW}, NT, D, 1, EpiOut{xp, xs, RSS, H1B});
    grid.sync();
    ph_rowrs(H1B, D, 0, D, RS1);
    grid.sync();
    ph_gemm(GemmP{H1B, W1T, nullptr, nullptr, 0, 0, D, D, D, 0}, NT, DFF, 1, EpiMlp1{RS1, HID});
    grid.sync();
    ph_gemm(GemmP{HID, W2T, nullptr, nullptr, 0, 0, DFF, DFF, DFF, 0}, NT, D, 1, EpiMlp2{H1B, H2B});
    grid.sync();
    ph_rowrs(H2B, D, 0, D, RS2);
    ph_gemm(GemmP{PB, WPT, nullptr, nullptr, 0, 0, PLE, PLE, PLE, 0}, NT, D, 1, EpiPP{PP});
    grid.sync();
    ph_gemm(GemmP{H2B, WGT, nullptr, nullptr, 0, 0, D, D, D, 0}, NT, D, 1, EpiGate{RS2, H2B, PP, H3F});
    grid.sync();
    ph_final(H3F, g_final, a.out);
}

extern "C" void kernel_launch(void* const* d_in, const int* in_sizes, int n_in, void* d_out, int out_size, void* d_ws, size_t ws_size, hipStream_t stream) {
    static int grid_blocks = 0;
    if (n_in != 27 || ws_size < WS_END || out_size != NT * D) { fprintf(stderr, "kernel_launch: unexpected sizes n_in %d ws %zu out %d\n", n_in, ws_size, out_size); return; }
    if (!grid_blocks) {
        int dev = 0, cus = 0, per_cu = 0;
        hipGetDevice(&dev);
        hipDeviceGetAttribute(&cus, hipDeviceAttributeMultiprocessorCount, dev);
        hipOccupancyMaxActiveBlocksPerMultiprocessor(&per_cu, mega, NTHR, 0);
        if (per_cu < 1) { fprintf(stderr, "kernel_launch: occupancy query says %d blocks per CU\n", per_cu); per_cu = 1; }
        if (per_cu > 1) per_cu = 1;
        grid_blocks = cus * per_cu;
    }
    Args a{};
    for (int i = 0; i < 27; ++i) a.in[i] = (const float*)d_in[i];
    a.out = (float*)d_out; a.ws = (unsigned char*)d_ws;
    void* args[] = {&a};
    hipError_t e = hipLaunchCooperativeKernel((void*)mega, dim3(grid_blocks), dim3(NTHR), args, 0, stream);
    if (e != hipSuccess) fprintf(stderr, "cooperative launch failed: %s (grid %d)\n", hipGetErrorString(e), grid_blocks);
}
```

```cpp
#include <hip/hip_runtime.h>
#include <hip/hip_cooperative_groups.h>
namespace cg = cooperative_groups;
#include <cstdio>
#include <cstdint>
#include <cmath>

typedef unsigned short bf16_t;
typedef short bf16x8 __attribute__((ext_vector_type(8)));
typedef float f32x4 __attribute__((ext_vector_type(4)));
typedef unsigned u32x2 __attribute__((ext_vector_type(2)));
typedef unsigned u32x4 __attribute__((ext_vector_type(4)));

constexpr int NT = 49152, SEQ = 8192, NSEQ = 6, NPROMPT = 16384;
constexpr int D = 1024, DFF = 4096, PLE = 256, INC = 2048, AW = 512, SW = 512;
constexpr int NH = 8, HD = 64, NG = 32, GC = 16, NS = 64;
constexpr int TCH = 16, NCHT = NT / TCH  , NCHS = SEQ / TCH  ;
constexpr float EPS = 1e-6f;
constexpr float LOG2E = 1.4426950408889634f;
constexpr float C2 = 0.125f * LOG2E;

constexpr size_t MiB = 1u << 20;
constexpr size_t WS_BIAS = 0;
constexpr size_t WS_PW = 64 * 1024;
constexpr size_t WS_BB = 1 * MiB;
constexpr size_t WS_RS0 = 2 * MiB;
constexpr size_t WS_SSQA = 3 * MiB;
constexpr size_t WS_SSQS = 5 * MiB;
constexpr size_t WS_SSQ1 = 7 * MiB;
constexpr size_t WS_SSQ2 = 11 * MiB;
constexpr size_t WS_W1T = 18 * MiB, WS_W2T = 26 * MiB, WS_WGT = 34 * MiB, WS_WPT = 36 * MiB;
constexpr size_t WS_PB = 37 * MiB;
constexpr size_t WS_WINT = 61 * MiB, WS_WOUTT = 65 * MiB, WS_WGLUT = 67 * MiB, WS_WST = 68 * MiB, WS_WYT = 72 * MiB;
constexpr size_t WS_SB = 80 * MiB;
constexpr size_t WS_QB = 128 * MiB, WS_KB = 176 * MiB, WS_VB = 224 * MiB;
constexpr size_t WS_UH = 272 * MiB;
constexpr size_t WS_MIX = 368 * MiB;
constexpr size_t WS_GB = 464 * MiB;
constexpr size_t WS_HID = 128 * MiB;
constexpr size_t WS_PP = 128 * MiB;
constexpr size_t WS_H3F = 224 * MiB;
constexpr size_t WS_END = 512 * MiB;
static_assert(WS_KB - WS_QB == (size_t)NT * AW * 2 && WS_VB - WS_KB == (size_t)NT * AW * 2, "QB | KB | VB contiguous");
constexpr size_t DO_XB = 0, DO_H1B = 0, DO_H2B = 96 * MiB;

__device__ __forceinline__ unsigned f2bf(float f) { unsigned u = __builtin_bit_cast(unsigned, f); return (u + 0x7fffu + ((u >> 16) & 1u)) >> 16; }
__device__ __forceinline__ unsigned pk2(float lo, float hi) { return f2bf(lo) | (f2bf(hi) << 16); }
__device__ __forceinline__ float bf2f(unsigned short b) { return __builtin_bit_cast(float, (unsigned)b << 16); }
__device__ __forceinline__ float bflo(unsigned w) { return __builtin_bit_cast(float, w << 16); }
__device__ __forceinline__ float bfhi(unsigned w) { return __builtin_bit_cast(float, w & 0xffff0000u); }
__device__ __forceinline__ float wave_sum(float v) {
#pragma unroll
    for (int o = 1; o < 64; o <<= 1) v += __shfl_xor(v, o);
    return v;
}
__device__ __forceinline__ const float* xrow(const float* xp, const float* xs, int tok, int width) {
    return tok < NPROMPT ? xp + (size_t)tok * width : xs + (size_t)(tok - NPROMPT) * width;
}


constexpr int NTHR = 512;
__device__ __forceinline__ int tid_fresh() { int t = threadIdx.x; asm volatile("" : "+v"(t)); return t; }
__device__ __forceinline__ size_t gtid_fresh() { return (size_t)blockIdx.x * NTHR + tid_fresh(); }
#define GTID gtid_fresh()
#define GSIZE ((size_t)gridDim.x * NTHR)

__device__ __forceinline__ void ph_prep_wt(const float* __restrict__ W, int K, int N, const float* __restrict__ g, bf16_t* __restrict__ out, int ldo, int nscale, float sc) {
    for (size_t i = GTID; i < (size_t)K * N; i += GSIZE) {
        const int k = (int)(i / N), n = (int)(i % N);
        float v = W[i]; if (g) v *= g[k]; if (n < nscale) v *= sc;
        out[(size_t)n * ldo + k] = (bf16_t)f2bf(v);
    }
}
__device__ __forceinline__ void ph_prep_wout(const float* __restrict__ W, const float* __restrict__ ga, const float* __restrict__ gs, bf16_t* __restrict__ out) {
    for (size_t i = GTID; i < (size_t)D * D; i += GSIZE) {
        const int k = (int)(i / D), n = (int)(i % D);
        const float v = W[i] * (k < AW ? ga[k] : gs[k - AW]);
        out[(size_t)n * D + k] = (bf16_t)f2bf(v);
    }
}
__device__ __forceinline__ int t5_bucket(int rel) {
    int n = -rel; int ret = n < 0 ? 16 : 0; n = n < 0 ? -n : n;
    if (n < 8) return ret + n;
    int large = 8 + (int)(log((double)n / 8.0) / log(128.0) * 8.0);
    large = large < 15 ? large : 15;
    return ret + large;
}
__device__ __forceinline__ void ph_prep_bias(const float* __restrict__ rel_bias, float* __restrict__ bias) {
    for (size_t i = GTID; i < 3 * 8 * 129; i += GSIZE) {
        const int o = (int)(i % 129), h = (int)((i / 129) % 8), b = (int)(i / (129 * 8));
        const int dil = b == 0 ? 1 : (b == 1 ? 4 : 16);
        bias[i] = rel_bias[t5_bucket((o - 64) * dil) * NH + h] * LOG2E;
    }
}
__device__ __forceinline__ void ph_rows_x(const float* __restrict__ xp, const float* __restrict__ xs, bf16_t* __restrict__ XB, float* __restrict__ RS0) {
    const int tidf = tid_fresh(), lane = tidf & 63;
    for (int row = blockIdx.x * 8 + (tidf >> 6); row < NT; row += gridDim.x * 8) {
        const f32x4* xr = (const f32x4*)xrow(xp, xs, row, D) + lane;
        float s = 0.f; f32x4 v[4];
#pragma unroll
        for (int j = 0; j < 4; ++j) { v[j] = xr[64 * j]; s += v[j].x * v[j].x + v[j].y * v[j].y + v[j].z * v[j].z + v[j].w * v[j].w; }
        s = wave_sum(s);
        u32x2* o = (u32x2*)(XB + (size_t)row * D) + lane;
#pragma unroll
        for (int j = 0; j < 4; ++j) { u32x2 w; w.x = pk2(v[j].x, v[j].y); w.y = pk2(v[j].z, v[j].w); o[64 * j] = w; }
        if (lane == 0) RS0[row] = 1.0f / sqrtf(s * (1.0f / D) + EPS);
    }
}
__device__ __forceinline__ void ph_cvt_p(const float* __restrict__ pp, const float* __restrict__ ps, bf16_t* __restrict__ PB) {
    for (size_t i = GTID; i < (size_t)NT * PLE / 4; i += GSIZE) {
        const int tok = (int)(i / (PLE / 4)), c4 = (int)(i % (PLE / 4));
        const f32x4 v = *((const f32x4*)xrow(pp, ps, tok, PLE) + c4);
        u32x2 w; w.x = pk2(v.x, v.y); w.y = pk2(v.z, v.w);
        *((u32x2*)(PB + (size_t)tok * PLE) + c4) = w;
    }
}
__device__ __forceinline__ void ph_ssm_tab(const float* __restrict__ a_re, const float* __restrict__ a_im, const float* __restrict__ log_dt,
                          const float* __restrict__ b_re, const float* __restrict__ b_im, float* __restrict__ PW, float* __restrict__ BB) {
    for (size_t ii = GTID; ii < NG * 2 * NS; ii += GSIZE) {
        const int i = (int)ii;
        const int n = i % NS, dir = (i / NS) % 2, g = i / (2 * NS);
        const int pi = (dir * NG + g) * NS + n;
        const double ar = a_re[pi], ai = a_im[pi], dt = exp((double)log_dt[dir * NG + g]);
        float* pw = PW + (size_t)((g * 2 + dir) * NS + n) * 17 * 2;
        for (int e = 0; e <= 16; ++e) { const double mag = exp(ar * dt * e), ang = ai * dt * e; pw[2 * e] = (float)(mag * cos(ang)); pw[2 * e + 1] = (float)(mag * sin(ang)); }
        const double abr = exp(ar * dt) * cos(ai * dt), abi = exp(ar * dt) * sin(ai * dt), inv = 1.0 / (ar * ar + ai * ai);
        const double fr = ((abr - 1.0) * ar + abi * ai) * inv, fi = (abi * ar - (abr - 1.0) * ai) * inv;
        float* bb = BB + (size_t)((g * 2 + dir) * NS + n) * GC * 2;
        for (int h = 0; h < GC; ++h) { const double br = b_re[(size_t)pi * GC + h], bi = b_im[(size_t)pi * GC + h]; bb[2 * h] = (float)(fr * br - fi * bi); bb[2 * h + 1] = (float)(fr * bi + fi * br); }
    }
}
__device__ __forceinline__ void ph_ssm_ws(const float* __restrict__ PW, const float* __restrict__ BB, bf16_t* __restrict__ WST) {
    for (size_t ii = GTID; ii < (size_t)NG * 256 * 256; ii += GSIZE) {
        const int i = (int)ii;
        const int k = i % 256, col = (i / 256) % 256, g = i / 65536;
        const int j = k / 16, hp = k % 16, dir = col / 128, n = (col % 128) / 2, ri = col & 1;
        const int e = dir == 0 ? 15 - j : j;
        const float* pw = PW + ((size_t)((g * 2 + dir) * NS + n) * 17 + e) * 2; const float* bb = BB + ((size_t)((g * 2 + dir) * NS + n) * GC + hp) * 2;
        const float vr = pw[0] * bb[0] - pw[1] * bb[1], vi = pw[0] * bb[1] + pw[1] * bb[0];
        WST[i] = (bf16_t)f2bf(ri ? vi : vr);
    }
}
__device__ __forceinline__ void ph_ssm_wy(const float* __restrict__ PW, const float* __restrict__ BB, const float* __restrict__ c_re, const float* __restrict__ c_im,
                         const float* __restrict__ dd, bf16_t* __restrict__ WYT) {
    for (size_t ii = GTID; ii < (size_t)NG * 256 * 512; ii += GSIZE) {
        const int i = (int)ii;
        const int k = i % 512, jh = (i / 512) % 256, g = i / (512 * 256);
        const int j = jh / 16, h = jh % 16;
        float v = 0.f;
        if (k < 256) {
            const int jp = k / 16, hp = k % 16;
            for (int dir = 0; dir < 2; ++dir) {
                const int e = dir == 0 ? j - jp : jp - j;
                if (e < 0) continue;
                for (int n = 0; n < NS; ++n) {
                    const float* pw = PW + ((size_t)((g * 2 + dir) * NS + n) * 17 + e) * 2; const float* bb = BB + ((size_t)((g * 2 + dir) * NS + n) * GC + hp) * 2;
                    const size_t ci = ((size_t)(dir * NG + g) * GC + h) * NS + n;
                    const float cr = c_re[ci], cim = c_im[ci];
                    const float tr = pw[0] * bb[0] - pw[1] * bb[1], ti = pw[0] * bb[1] + pw[1] * bb[0];
                    v += cr * tr - cim * ti;
                }
            }
            if (jp == j && hp == h) v += dd[g * GC + h];
        } else {
            const int kk = k - 256, dir = kk / 128, n = (kk % 128) / 2, ri = kk & 1;
            const int e = dir == 0 ? j + 1 : 16 - j;
            const float* pw = PW + ((size_t)((g * 2 + dir) * NS + n) * 17 + e) * 2;
            const size_t ci = ((size_t)(dir * NG + g) * GC + h) * NS + n;
            const float cr = c_re[ci], cim = c_im[ci];
            const float pr = cr * pw[0] - cim * pw[1], pim = cr * pw[1] + cim * pw[0];
            v = ri ? -pim : pr;
        }
        WYT[i] = (bf16_t)f2bf(v);
    }
}


__device__ __forceinline__ void st_bf4(bf16_t* p, f32x4 v) { u32x2 w; w.x = pk2(v.x, v.y); w.y = pk2(v.z, v.w); *(u32x2*)p = w; }
__device__ __forceinline__ f32x4 ld_bf4(const bf16_t* p) { const u32x2 w = *(const u32x2*)p; return (f32x4){bflo(w.x), bfhi(w.x), bflo(w.y), bfhi(w.y)}; }
namespace pg8 {
#define PG8_LAS __attribute__((address_space(3)))
constexpr int BM = 256, BK = 64, HALF = 128, HTB = HALF * BK * 2  , STAGE_BYTES = 8 * HTB, NXCD = 8, WGM = 8;

__host__ __device__ __forceinline__ int lds_byte(int r, int c) { const int st = (r >> 4) * 2 + (c >> 5), rr = r & 15, cc = c & 31, ob = rr * 64 + cc * 2; return st * 1024 + (ob ^ (((ob >> 9) & 1) << 5)); }
__host__ __device__ __forceinline__ void stage_rc(int b, int& R, int& C) { const int st = b / 1024, sb = b % 1024, swz = sb ^ (((sb >> 9) & 1) << 5); R = (st >> 1) * 16 + swz / 64; C = (st & 1) * 32 + (swz % 64) / 2; }
__host__ __device__ __forceinline__ int perm32(int rho) { const int n = rho >> 4, i = rho & 15; return 8 * (i >> 2) + 4 * n + (i & 3); }
struct Unit { int pm, pn, kh; };
struct Gemm { const bf16_t* A; const bf16_t* Bt; int lda, ldb, K, khb; };
struct Order {
    int nM, nN, nwg, G, c, split, bdiv;
    __device__ void init(int M, int N, int G_, int c_, int split_ = 0, int bdiv_ = 0) { nM = M / BM; nN = N / BM; nwg = nM * nN; G = G_; c = c_; split = split_; bdiv = bdiv_; }
    __device__ bool next(int i, Unit& u) const {
        const int ti = split ? (i >> 1) : i;
        const long L = (long)ti * G + c; if (L >= nwg) return false;
        int wgid = (int)L; { const int q = nwg / NXCD, r = nwg % NXCD, xcd = wgid % NXCD, off = wgid / NXCD; wgid = (xcd < r ? xcd * (q + 1) : r * (q + 1) + (xcd - r) * q) + off; }
        const int nig = WGM * nN, gid = wgid / nig, fm = gid * WGM, gsz = (nM - fm) < WGM ? (nM - fm) : WGM;
        u.pm = fm + ((wgid % nig) % gsz); u.pn = (wgid % nig) / gsz; u.kh = split ? (i & 1) : 0;
        if (bdiv) u.pn = u.pm / bdiv;
        return true;
    }
    __device__ __forceinline__ void a_ready(const Unit&) const {}
    __device__ __forceinline__ void done(const Unit&) const {}
};
__device__ __forceinline__ unsigned cvt_pk_bf16(float lo, float hi) { unsigned r; asm volatile("v_cvt_pk_bf16_f32 %0, %1, %2" : "=v"(r) : "v"(lo), "v"(hi)); return r; }
template <class Epi, class Sched, bool ALIGN_EPI = false, bool SP2 = false>
__device__ __forceinline__ void gemm_phase(PG8_LAS unsigned char* lds, const Gemm g, const Sched& S, const Epi& E) {
    const int tid = tid_fresh(), wid = __builtin_amdgcn_readfirstlane(tid >> 6), lane = tid & 63, wr = wid >> 2, wc = wid & 3, fr = lane & 15, fq = lane >> 4;
    const int K = g.K, nt = K / BK;
    unsigned voffA[2], voffB[2];
#pragma unroll
    for (int i = 0; i < 2; ++i) { int R, C; stage_rc(tid * 16 + i * 8192, R, C); const int Rb = Epi::PERM ? ((R & ~31) + perm32(R & 31)) : R;
        voffA[i] = (unsigned)(R * g.lda + C) * 2u; voffB[i] = (unsigned)(Rb * g.ldb + C) * 2u; }
    const size_t kstep = (size_t)(BK * 2);
    const size_t hstepA = (size_t)HALF * g.lda * 2, hstepB = (size_t)HALF * g.ldb * 2;
    const size_t tstepA = 2 * hstepA, tstepB = 2 * hstepB;
    const unsigned ldsw = (unsigned)wid * 1024u;
    const int aoff = lds_byte(wr * 64 + fr, fq * 8), boff = lds_byte(wc * 32 + fr, fq * 8);
#define PG8_SA(b, h) (((b) * 2 + (h)) * HTB)
#define PG8_SB(b, h) ((4 + (b) * 2 + (h)) * HTB)
#define PG8_STAGE(bufoff, gbase, voff) do { _Pragma("unroll") for (int _i = 0; _i < 2; ++_i) \
        __builtin_amdgcn_global_load_lds((const unsigned*)((const char*)(gbase) + (voff)[_i]), (PG8_LAS unsigned*)(lds + (bufoff) + ldsw + _i * 8192), 16, 0, 0); } while (0)
#define PG8_LDA(dst, b, h) do { _Pragma("unroll") for (int m = 0; m < 4; ++m) _Pragma("unroll") for (int k = 0; k < 2; ++k) dst[m][k] = *(const PG8_LAS bf16x8*)(lds + PG8_SA(b, h) + aoff + m * 2048 + k * 1024); } while (0)
#define PG8_LDB(dst, b, h) do { _Pragma("unroll") for (int n = 0; n < 2; ++n) _Pragma("unroll") for (int k = 0; k < 2; ++k) dst[n][k] = *(const PG8_LAS bf16x8*)(lds + PG8_SB(b, h) + boff + n * 2048 + k * 1024); } while (0)
#define PG8_MMA(ai, bj, At, Bt) do { __builtin_amdgcn_s_setprio(1); _Pragma("unroll") for (int m = 0; m < 4; ++m) _Pragma("unroll") for (int n = 0; n < 2; ++n) _Pragma("unroll") for (int k = 0; k < 2; ++k) \
        acc[ai][bj][m][n] = __builtin_amdgcn_mfma_f32_16x16x32_bf16(Bt[n][k], At[m][k], acc[ai][bj][m][n], 0, 0, 0); __builtin_amdgcn_s_setprio(0); } while (0)
#define PG8_WAIT_V(n) asm volatile("s_waitcnt vmcnt(" #n ")" ::: "memory")
#define PG8_WAIT_L(n) asm volatile("s_waitcnt lgkmcnt(" #n ")" ::: "memory")
#define PG8_BAR __builtin_amdgcn_s_barrier()
#define PG8_SCHED __builtin_amdgcn_sched_barrier(0)
    Unit cur, nxt; int ui = 0;
    if (!S.next(0, cur)) return;
    f32x4 acc[2][2][4][2];
#pragma unroll
    for (int a = 0; a < 2; ++a)
#pragma unroll
        for (int b = 0; b < 2; ++b)
#pragma unroll
            for (int m = 0; m < 4; ++m)
#pragma unroll
                for (int n = 0; n < 2; ++n) acc[a][b][m][n] = (f32x4){0.f, 0.f, 0.f, 0.f};
    bf16x8 At[4][2], B0[2][2], B1[2][2];
    const char* cA = (const char*)g.A + (size_t)cur.pm * tstepA + (size_t)cur.kh * g.khb; const char* cB = (const char*)g.Bt + (size_t)cur.pn * tstepB + (size_t)cur.kh * g.khb;
    S.a_ready(cur);
    if constexpr (SP2) {
        PG8_STAGE(PG8_SB(0, 0), cB, voffB); PG8_STAGE(PG8_SB(0, 1), cB + hstepB, voffB); PG8_STAGE(PG8_SA(0, 0), cA, voffA); PG8_STAGE(PG8_SA(0, 1), cA + hstepA, voffA);
        if (wr == 1) PG8_BAR;
        PG8_WAIT_V(2); PG8_BAR;
        PG8_STAGE(PG8_SB(1, 0), cB + kstep, voffB); PG8_STAGE(PG8_SA(1, 0), cA + kstep, voffA); PG8_STAGE(PG8_SB(1, 1), cB + hstepB + kstep, voffB);
        PG8_WAIT_V(6); PG8_BAR;
    } else {
        PG8_STAGE(PG8_SB(0, 0), cB, voffB); PG8_STAGE(PG8_SA(0, 0), cA, voffA); PG8_STAGE(PG8_SB(0, 1), cB + hstepB, voffB); PG8_STAGE(PG8_SA(0, 1), cA + hstepA, voffA);
        if (wr == 1) PG8_BAR;
        PG8_WAIT_V(4); PG8_BAR;
        PG8_STAGE(PG8_SB(1, 0), cB + kstep, voffB); PG8_STAGE(PG8_SA(1, 0), cA + kstep, voffA); PG8_STAGE(PG8_SB(1, 1), cB + hstepB + kstep, voffB);
        PG8_WAIT_V(6); PG8_BAR;
    }
    for (;;) {
        const bool has_next = S.next(ui + 1, nxt);
        const char* nA = has_next ? (const char*)g.A + (size_t)nxt.pm * tstepA + (size_t)nxt.kh * g.khb : cA; const char* nB = has_next ? (const char*)g.Bt + (size_t)nxt.pn * tstepB + (size_t)nxt.kh * g.khb : cB;
#pragma nounroll
        for (int t = 0; t < nt; t += 2) {
            const bool last = (t == nt - 2);
            const char* a1 = cA + (size_t)(t + 1) * kstep;
            const char* a2 = last ? nA : cA + (size_t)(t + 2) * kstep; const char* b2 = last ? nB : cB + (size_t)(t + 2) * kstep;
            const char* a3 = a2 + kstep; const char* b3 = b2 + kstep;
            if (last && has_next) S.a_ready(nxt);
            if constexpr (SP2) {
            PG8_LDB(B0, 0, 0); PG8_LDB(B1, 0, 1); PG8_SCHED; PG8_LDA(At, 0, 0); PG8_STAGE(PG8_SA(1, 1), a1 + hstepA, voffA);
            PG8_WAIT_V(8); PG8_WAIT_L(0); PG8_BAR; PG8_MMA(0, 0, At, B0); PG8_MMA(0, 1, At, B1); PG8_BAR; PG8_SCHED;
            PG8_LDA(At, 0, 1); PG8_STAGE(PG8_SB(0, 0), b2, voffB); PG8_STAGE(PG8_SB(0, 1), b2 + hstepB, voffB); PG8_STAGE(PG8_SA(0, 0), a2, voffA);
            PG8_WAIT_V(8); PG8_WAIT_L(0); PG8_BAR; PG8_MMA(1, 0, At, B0); PG8_MMA(1, 1, At, B1); PG8_BAR; PG8_SCHED;
            PG8_LDB(B0, 1, 0); PG8_LDB(B1, 1, 1); PG8_SCHED; PG8_LDA(At, 1, 0); PG8_STAGE(PG8_SA(0, 1), a2 + hstepA, voffA);
            PG8_WAIT_V(8); PG8_WAIT_L(0); PG8_BAR; PG8_MMA(0, 0, At, B0); PG8_MMA(0, 1, At, B1); PG8_BAR; PG8_SCHED;
            PG8_LDA(At, 1, 1); PG8_STAGE(PG8_SB(1, 0), b3, voffB); PG8_STAGE(PG8_SB(1, 1), b3 + hstepB, voffB); PG8_STAGE(PG8_SA(1, 0), a3, voffA);
            PG8_WAIT_V(8); PG8_WAIT_L(0); PG8_BAR; PG8_MMA(1, 0, At, B0); PG8_MMA(1, 1, At, B1); PG8_BAR; PG8_SCHED;
            } else {
            PG8_LDB(B0, 0, 0); PG8_SCHED; PG8_LDA(At, 0, 0); PG8_STAGE(PG8_SA(1, 1), a1 + hstepA, voffA);
            PG8_WAIT_L(8); PG8_BAR; PG8_WAIT_L(0); PG8_MMA(0, 0, At, B0); PG8_BAR; PG8_SCHED;
            PG8_LDB(B1, 0, 1); PG8_STAGE(PG8_SB(0, 0), b2, voffB);
            PG8_BAR; PG8_WAIT_L(0); PG8_MMA(0, 1, At, B1); PG8_BAR;
            PG8_LDA(At, 0, 1); PG8_STAGE(PG8_SA(0, 0), a2, voffA);
            PG8_BAR; PG8_WAIT_L(0); PG8_MMA(1, 0, At, B0); PG8_BAR; PG8_SCHED;
            PG8_STAGE(PG8_SB(0, 1), b2 + hstepB, voffB);
            PG8_WAIT_V(6); PG8_BAR; PG8_MMA(1, 1, At, B1); PG8_BAR;
            PG8_LDB(B0, 1, 0); PG8_SCHED; PG8_LDA(At, 1, 0); PG8_STAGE(PG8_SA(0, 1), a2 + hstepA, voffA);
            PG8_WAIT_L(8); PG8_BAR; PG8_WAIT_L(0); PG8_MMA(0, 0, At, B0); PG8_BAR; PG8_SCHED;
            PG8_LDB(B1, 1, 1); PG8_STAGE(PG8_SB(1, 0), b3, voffB);
            PG8_BAR; PG8_WAIT_L(0); PG8_MMA(0, 1, At, B1); PG8_BAR;
            PG8_LDA(At, 1, 1); PG8_STAGE(PG8_SA(1, 0), a3, voffA);
            PG8_BAR; PG8_WAIT_L(0); PG8_MMA(1, 0, At, B0); PG8_BAR; PG8_SCHED;
            PG8_STAGE(PG8_SB(1, 1), b3 + hstepB, voffB);
            PG8_WAIT_V(6); PG8_BAR; PG8_MMA(1, 1, At, B1); PG8_BAR;
            }
        }
        if constexpr (ALIGN_EPI) { if (wr == 0) PG8_BAR; }
        if constexpr (!Epi::AFTER_DRAIN) { E(acc, cur, wr, wc, fr, fq); S.done(cur); }
        if (!has_next) break;
        if (Epi::zero_after(cur)) {
#pragma unroll
        for (int a = 0; a < 2; ++a)
#pragma unroll
            for (int b = 0; b < 2; ++b)
#pragma unroll
                for (int m = 0; m < 4; ++m)
#pragma unroll
                    for (int n = 0; n < 2; ++n) acc[a][b][m][n] = (f32x4){0.f, 0.f, 0.f, 0.f};
        }
        cur = nxt; cA = nA; cB = nB; ++ui;
        if constexpr (ALIGN_EPI) { if (wr == 1) PG8_BAR; }
    }
    PG8_WAIT_V(0);
    if constexpr (!ALIGN_EPI) { if (wr == 0) PG8_BAR; }
    PG8_BAR;
    if constexpr (Epi::AFTER_DRAIN) { E.fused(acc, cur, wr, wc, fr, fq, lds, wid, lane); S.done(cur); }
#undef PG8_SA
#undef PG8_SB
#undef PG8_STAGE
#undef PG8_LDA
#undef PG8_LDB
#undef PG8_MMA
#undef PG8_WAIT_V
#undef PG8_WAIT_L
#undef PG8_BAR
#undef PG8_SCHED
}
}

typedef f32x4 AccT[2][2][4][2];
__device__ __forceinline__ float sigm(float x) { return 1.0f / (1.0f + __expf(-x)); }
__device__ __forceinline__ float gelu_tanh(float x) { const float u = 0.7978845608028654f * (x + 0.044715f * x * x * x); return 0.5f * x * (1.0f + tanhf(u)); }
__device__ __forceinline__ u32x4 pack8(f32x4 a, f32x4 b) { u32x4 w; w.x = pg8::cvt_pk_bf16(a.x, a.y); w.y = pg8::cvt_pk_bf16(a.z, a.w); w.z = pg8::cvt_pk_bf16(b.x, b.y); w.w = pg8::cvt_pk_bf16(b.z, b.w); return w; }
__device__ __forceinline__ void unpack8(u32x4 w, f32x4& a, f32x4& b) { a = (f32x4){bflo(w.x), bfhi(w.x), bflo(w.y), bfhi(w.y)}; b = (f32x4){bflo(w.z), bfhi(w.z), bflo(w.w), bfhi(w.w)}; }
__device__ __forceinline__ float sumsq4(f32x4 v) { return (v.x * v.x + v.y * v.y) + (v.z * v.z + v.w * v.w); }
__device__ __forceinline__ float sum8f(const float* p) { const f32x4 a = *(const f32x4*)p, b = *(const f32x4*)(p + 4); return ((a.x + a.y) + (a.z + a.w)) + ((b.x + b.y) + (b.z + b.w)); }
__device__ __forceinline__ float sum16f(const float* p) { return sum8f(p) + sum8f(p + 8); }
__device__ __forceinline__ float red_fq(float s) { s += __shfl_xor(s, 16); s += __shfl_xor(s, 32); return s; }
#define EPI_ROWS(...) _Pragma("unroll") for (int ai = 0; ai < 2; ++ai) _Pragma("unroll") for (int m = 0; m < 4; ++m) { const int row = u.pm * 256 + ai * 128 + wr * 64 + m * 16 + fr; __VA_ARGS__ }
#define EPI_COLS(...) _Pragma("unroll") for (int bj = 0; bj < 2; ++bj) { const int col = u.pn * 256 + bj * 128 + wc * 32 + 8 * fq; f32x4& v0 = acc[ai][bj][m][0]; f32x4& v1 = acc[ai][bj][m][1]; __VA_ARGS__ }

struct EpiIn {
    static constexpr bool PERM = true, AFTER_DRAIN = false; __device__ static bool zero_after(const pg8::Unit&) { return true; }
    const float* RS0; bf16_t *QB, *KB, *VB, *UH;
    __device__ __forceinline__ void operator()(AccT& acc, const pg8::Unit& u, int wr, int wc, int fr, int fq) const {
        EPI_ROWS( const float rs = RS0[row];
            EPI_COLS( const u32x4 w = pack8(v0 * rs, v1 * rs);
                if (u.pn < 6) { bf16_t* dst = QB + (size_t)(u.pn >> 1) * ((size_t)NT * AW); *(u32x4*)(dst + (size_t)row * AW + (col & (AW - 1))) = w; }
                else { const int c = col - 3 * AW, g = c >> 4, ch = c & 15; *(u32x4*)(UH + ((size_t)(g * NCHT + (row >> 4))) * 512 + (row & 15) * 16 + ch) = w; } ) )
    }
};
struct EpiS {
    static constexpr bool PERM = true, AFTER_DRAIN = false; __device__ static bool zero_after(const pg8::Unit&) { return true; }
    bf16_t* SB;
    __device__ __forceinline__ void operator()(AccT& acc, const pg8::Unit& u, int wr, int wc, int fr, int fq) const {
        EPI_ROWS( EPI_COLS( *(u32x4*)(SB + (size_t)row * 256 + (col - u.pn * 256)) = pack8(v0, v1); ) )
    }
};
struct EpiY {
    static constexpr bool PERM = true, AFTER_DRAIN = false; __device__ static bool zero_after(const pg8::Unit&) { return true; }
    bf16_t* GB;
    __device__ __forceinline__ void operator()(AccT& acc, const pg8::Unit& u, int wr, int wc, int fr, int fq) const {
        const int g = u.pn;
        EPI_ROWS( const int chunk = row - g * NCHT;
            EPI_COLS( const int cl = col - u.pn * 256, j = cl >> 4, h = cl & 15; const size_t tok = (size_t)chunk * 16 + j;
                f32x4 a, b; a.x = gelu_tanh(v0.x); a.y = gelu_tanh(v0.y); a.z = gelu_tanh(v0.z); a.w = gelu_tanh(v0.w); b.x = gelu_tanh(v1.x); b.y = gelu_tanh(v1.y); b.z = gelu_tanh(v1.z); b.w = gelu_tanh(v1.w);
                *(u32x4*)(GB + tok * SW + g * 16 + h) = pack8(a, b); ) )
    }
};
struct EpiGlu {
    static constexpr bool PERM = true, AFTER_DRAIN = false; __device__ static bool zero_after(const pg8::Unit&) { return true; }
    const bf16_t* GB; const float* bglu; bf16_t* MIX; float* SSQS;
    __device__ __forceinline__ void operator()(AccT& acc, const pg8::Unit& u, int wr, int wc, int fr, int fq) const {
        EPI_ROWS( float sq = 0.f;
            EPI_COLS( f32x4 g0, g1; unpack8(*(const u32x4*)(GB + (size_t)row * SW + col), g0, g1); const f32x4 b0 = *(const f32x4*)(bglu + col), b1 = *(const f32x4*)(bglu + col + 4);
                f32x4 o0, o1; o0.x = g0.x * sigm(v0.x + b0.x); o0.y = g0.y * sigm(v0.y + b0.y); o0.z = g0.z * sigm(v0.z + b0.z); o0.w = g0.w * sigm(v0.w + b0.w);
                o1.x = g1.x * sigm(v1.x + b1.x); o1.y = g1.y * sigm(v1.y + b1.y); o1.z = g1.z * sigm(v1.z + b1.z); o1.w = g1.w * sigm(v1.w + b1.w);
                sq += sumsq4(o0) + sumsq4(o1); *(u32x4*)(MIX + (size_t)row * D + AW + col) = pack8(o0, o1); )
            sq = red_fq(sq); if (fq == 0) SSQS[(size_t)row * 8 + u.pn * 4 + wc] = sq; )
    }
};
struct EpiOut {
    static constexpr bool PERM = true, AFTER_DRAIN = false; __device__ static bool zero_after(const pg8::Unit& u) { return u.kh != 0; }
    const float *xp, *xs; const float *SSQA, *SSQS; bf16_t* H1B; float* SSQ1;
    __device__ __forceinline__ void operator()(AccT& acc, const pg8::Unit& u, int wr, int wc, int fr, int fq) const {
        if (u.kh == 0) {
            EPI_ROWS( const float rsa = 1.0f / sqrtf(sum8f(SSQA + (size_t)row * 8) * (1.0f / AW) + EPS), rss = 1.0f / sqrtf(sum8f(SSQS + (size_t)row * 8) * (1.0f / SW) + EPS); const float r = rsa / rss;
                EPI_COLS( v0 = v0 * r; v1 = v1 * r; ) )
        } else {
            EPI_ROWS( const float rss = 1.0f / sqrtf(sum8f(SSQS + (size_t)row * 8) * (1.0f / SW) + EPS); float sq = 0.f; const float* xr = xrow(xp, xs, row, D);
                EPI_COLS( const f32x4 o0 = *(const f32x4*)(xr + col) + v0 * rss, o1 = *(const f32x4*)(xr + col + 4) + v1 * rss;
                    sq += sumsq4(o0) + sumsq4(o1); *(u32x4*)(H1B + (size_t)row * D + col) = pack8(o0, o1); )
                sq = red_fq(sq); if (fq == 0) SSQ1[(size_t)row * 16 + u.pn * 4 + wc] = sq; )
        }
    }
};
struct EpiMlp1 {
    static constexpr bool PERM = true, AFTER_DRAIN = false; __device__ static bool zero_after(const pg8::Unit&) { return true; }
    const float* SSQ1; bf16_t* HID;
    __device__ __forceinline__ void operator()(AccT& acc, const pg8::Unit& u, int wr, int wc, int fr, int fq) const {
        EPI_ROWS( const float rs = 1.0f / sqrtf(sum16f(SSQ1 + (size_t)row * 16) * (1.0f / D) + EPS);
            EPI_COLS( f32x4 a = v0 * rs, b = v1 * rs; a.x = fmaxf(a.x, 0.f); a.y = fmaxf(a.y, 0.f); a.z = fmaxf(a.z, 0.f); a.w = fmaxf(a.w, 0.f); b.x = fmaxf(b.x, 0.f); b.y = fmaxf(b.y, 0.f); b.z = fmaxf(b.z, 0.f); b.w = fmaxf(b.w, 0.f);
                *(u32x4*)(HID + (size_t)row * DFF + col) = pack8(a * a, b * b); ) )
    }
};
struct EpiMlp2 {
    static constexpr bool PERM = true, AFTER_DRAIN = false; __device__ static bool zero_after(const pg8::Unit&) { return true; }
    const bf16_t* H1B; bf16_t* H2B; float* SSQ2;
    __device__ __forceinline__ void operator()(AccT& acc, const pg8::Unit& u, int wr, int wc, int fr, int fq) const {
        EPI_ROWS( float sq = 0.f;
            EPI_COLS( f32x4 h0, h1; unpack8(*(const u32x4*)(H1B + (size_t)row * D + col), h0, h1); const f32x4 o0 = h0 + v0, o1 = h1 + v1;
                sq += sumsq4(o0) + sumsq4(o1); *(u32x4*)(H2B + (size_t)row * D + col) = pack8(o0, o1); )
            sq = red_fq(sq); if (fq == 0) SSQ2[(size_t)row * 16 + u.pn * 4 + wc] = sq; )
    }
};
struct EpiPP {
    static constexpr bool PERM = true, AFTER_DRAIN = false; __device__ static bool zero_after(const pg8::Unit&) { return true; }
    bf16_t* PP;
    __device__ __forceinline__ void operator()(AccT& acc, const pg8::Unit& u, int wr, int wc, int fr, int fq) const {
        EPI_ROWS( EPI_COLS( *(u32x4*)(PP + (size_t)row * D + col) = pack8(v0, v1); ) )
    }
};
struct EpiGate {
    static constexpr bool PERM = true, AFTER_DRAIN = false; __device__ static bool zero_after(const pg8::Unit&) { return true; }
    const float* SSQ2; const bf16_t* H2B; const bf16_t* PP; float* H3F;
    __device__ __forceinline__ void operator()(AccT& acc, const pg8::Unit& u, int wr, int wc, int fr, int fq) const {
        EPI_ROWS( const float rs = 1.0f / sqrtf(sum16f(SSQ2 + (size_t)row * 16) * (1.0f / D) + EPS);
            EPI_COLS( f32x4 h0, h1, p0, p1; unpack8(*(const u32x4*)(H2B + (size_t)row * D + col), h0, h1); unpack8(*(const u32x4*)(PP + (size_t)row * D + col), p0, p1);
                f32x4 o0, o1; o0.x = h0.x + sigm(v0.x * rs) * p0.x; o0.y = h0.y + sigm(v0.y * rs) * p0.y; o0.z = h0.z + sigm(v0.z * rs) * p0.z; o0.w = h0.w + sigm(v0.w * rs) * p0.w;
                o1.x = h1.x + sigm(v1.x * rs) * p1.x; o1.y = h1.y + sigm(v1.y * rs) * p1.y; o1.z = h1.z + sigm(v1.z * rs) * p1.z; o1.w = h1.w + sigm(v1.w * rs) * p1.w;
                *(f32x4*)(H3F + (size_t)row * D + col) = o0; *(f32x4*)(H3F + (size_t)row * D + col + 4) = o1; ) )
    }
};

__device__ __forceinline__ void ph_final(const float* __restrict__ H3F, const float* __restrict__ gf, float* __restrict__ out) {
    const int tidf = tid_fresh(), lane = tidf & 63;
    for (int row = blockIdx.x * 8 + (tidf >> 6); row < NT; row += gridDim.x * 8) {
        const f32x4* xr = (const f32x4*)(H3F + (size_t)row * D) + lane;
        float s = 0.f; f32x4 v[4];
#pragma unroll
        for (int j = 0; j < 4; ++j) { v[j] = xr[64 * j]; s += v[j].x * v[j].x + v[j].y * v[j].y + v[j].z * v[j].z + v[j].w * v[j].w; }
        s = wave_sum(s); const float rs = 1.0f / sqrtf(s * (1.0f / D) + EPS);
        f32x4* o = (f32x4*)(out + (size_t)row * D) + lane; const f32x4* g4 = (const f32x4*)gf + lane;
#pragma unroll
        for (int j = 0; j < 4; ++j) o[64 * j] = v[j] * rs * g4[64 * j];
    }
}

__device__ __forceinline__ void ph_attn_naive(const bf16_t* __restrict__ QB, const bf16_t* __restrict__ KB, const bf16_t* __restrict__ VB, const float* __restrict__ bias, bf16_t* __restrict__ MIX, float* __restrict__ SSQA) {
    for (size_t ii = GTID; ii < (size_t)NT * NH * 2; ii += GSIZE) {
        const int i = (int)(ii >> 1), hf = (int)(ii & 1);
        const int h = i % NH, tok = i / NH;
        const int s = tok / SEQ, pos = tok % SEQ;
        u32x4 qw[8];
        { const u32x4* qp = (const u32x4*)(QB + (size_t)tok * AW + h * HD);
#pragma unroll
          for (int c = 0; c < 8; ++c) qw[c] = qp[c]; }
        float o[32];
#pragma unroll
        for (int c = 0; c < 32; ++c) o[c] = 0.f;
        float m = -1e30f, l = 0.f;
        for (int b = 0; b < 3; ++b) {
            const int dil = b == 0 ? 1 : (b == 1 ? 4 : 16);
            const float* bt = bias + (b * NH + h) * 129;
            for (int off = -64; off <= 64; ++off) {
                const int kp = pos + off * dil; if (kp < 0 || kp >= SEQ) continue;
                const size_t kt = (size_t)s * SEQ + kp;
                const u32x4* kr = (const u32x4*)(KB + kt * AW + h * HD);
                float sc = 0.f;
#pragma unroll
                for (int c = 0; c < 8; ++c) { const u32x4 w = kr[c]; const u32x4 qq = qw[c]; sc += bflo(qq.x) * bflo(w.x) + bfhi(qq.x) * bfhi(w.x) + bflo(qq.y) * bflo(w.y) + bfhi(qq.y) * bfhi(w.y) + bflo(qq.z) * bflo(w.z) + bfhi(qq.z) * bfhi(w.z) + bflo(qq.w) * bflo(w.w) + bfhi(qq.w) * bfhi(w.w); }
                sc += bt[off + 64];
                const float mn = fmaxf(m, sc), f = exp2f(m - mn), pe = exp2f(sc - mn);
                l = l * f + pe; m = mn;
                const u32x4* vr = (const u32x4*)(VB + kt * AW + h * HD + hf * 32);
#pragma unroll
                for (int c = 0; c < 4; ++c) { const u32x4 w = vr[c];
                    o[8 * c] = o[8 * c] * f + pe * bflo(w.x); o[8 * c + 1] = o[8 * c + 1] * f + pe * bfhi(w.x); o[8 * c + 2] = o[8 * c + 2] * f + pe * bflo(w.y); o[8 * c + 3] = o[8 * c + 3] * f + pe * bfhi(w.y);
                    o[8 * c + 4] = o[8 * c + 4] * f + pe * bflo(w.z); o[8 * c + 5] = o[8 * c + 5] * f + pe * bfhi(w.z); o[8 * c + 6] = o[8 * c + 6] * f + pe * bflo(w.w); o[8 * c + 7] = o[8 * c + 7] * f + pe * bfhi(w.w); }
            }
        }
        const float il = 1.0f / l;
        { float sq = 0.f;
#pragma unroll
          for (int c = 0; c < 32; ++c) sq += (o[c] * il) * (o[c] * il);
          sq += __shfl_xor(sq, 1);
          if (hf == 0) SSQA[(size_t)tok * NH + h] = sq; }
        u32x4* op = (u32x4*)(MIX + (size_t)tok * D + h * HD + hf * 32);
#pragma unroll
        for (int c = 0; c < 4; ++c) { u32x4 w; w.x = pk2(o[8 * c] * il, o[8 * c + 1] * il); w.y = pk2(o[8 * c + 2] * il, o[8 * c + 3] * il); w.z = pk2(o[8 * c + 4] * il, o[8 * c + 5] * il); w.w = pk2(o[8 * c + 6] * il, o[8 * c + 7] * il); op[c] = w; }
    }
}

__device__ __forceinline__ void ph_scan(const bf16_t* __restrict__ SB, const float* __restrict__ PW, bf16_t* __restrict__ UH) {
    for (size_t ii = GTID; ii < (size_t)NSEQ * NG * 2 * NS; ii += GSIZE) {
        const int i = (int)ii;
        const int n = i % NS, dir = (i / NS) % 2, g = (i / (2 * NS)) % NG, s = i / (2 * NS * NG);
        const float* pw = PW + ((size_t)((g * 2 + dir) * NS + n) * 17 + 16) * 2;
        const float ar = pw[0], ai = pw[1];
        float hr = 0.f, hi = 0.f;
        const size_t base = (size_t)g * NCHT + (size_t)s * NCHS; const int colo = dir * 128 + 2 * n;
        for (int t = 0; t < NCHS; ++t) {
            const int c = dir == 0 ? t : NCHS - 1 - t;
            *(unsigned*)(UH + (base + c) * 512 + 256 + colo) = pk2(hr, hi);
            const unsigned w = *(const unsigned*)(SB + (base + c) * 256 + colo);
            const float sr = bflo(w), si = bfhi(w);
            const float nr = ar * hr - ai * hi + sr, ni = ar * hi + ai * hr + si;
            hr = nr; hi = ni;
        }
    }
}


constexpr int LDS_BYTES = 147456;
struct Args { const float* in[27]; float* out; unsigned char* ws; };
template <class Epi>
__device__ __forceinline__ void run_gemm(PG8_LAS unsigned char* lds, const bf16_t* A, int lda, const bf16_t* Bt, int ldb, int M, int N, int K, int khb, int split, int bdiv, const Epi& E) {
    pg8::Gemm g{A, Bt, lda, ldb, K, khb}; pg8::Order S; S.init(M, N, (int)gridDim.x, (int)blockIdx.x, split, bdiv);
    pg8::gemm_phase<Epi, pg8::Order, true, true>(lds, g, S, E);
}
__global__ void __launch_bounds__(NTHR, 2) mega(Args a) {
    extern __shared__ __attribute__((aligned(16))) unsigned char lds_raw[];
    PG8_LAS unsigned char* lds = (PG8_LAS unsigned char*)lds_raw;
    cg::grid_group grid = cg::this_grid();
    const float *xp = a.in[0], *xs = a.in[1], *pp = a.in[2], *ps = a.in[3], *rel_bias = a.in[4], *g_mix = a.in[5], *w_in = a.in[6];
    const float *a_re = a.in[7], *a_im = a.in[8], *log_dt = a.in[9], *b_re = a.in[10], *b_im = a.in[11], *c_re = a.in[12], *c_im = a.in[13], *ssm_d = a.in[14];
    const float *w_glu = a.in[15], *b_glu = a.in[16], *g_att = a.in[17], *g_ssm = a.in[18], *w_out = a.in[19], *g_mlp = a.in[20], *w_mlp1 = a.in[21], *w_mlp2 = a.in[22];
    const float *g_ple = a.in[23], *w_gate = a.in[24], *w_proj = a.in[25], *g_final = a.in[26];
    unsigned char* ws = a.ws; unsigned char* dob = (unsigned char*)a.out;
    float* BIAS = (float*)(ws + WS_BIAS); float* PW = (float*)(ws + WS_PW); float* BBt = (float*)(ws + WS_BB);
    float *RS0 = (float*)(ws + WS_RS0), *SSQA = (float*)(ws + WS_SSQA), *SSQS = (float*)(ws + WS_SSQS), *SSQ1 = (float*)(ws + WS_SSQ1), *SSQ2 = (float*)(ws + WS_SSQ2);
    bf16_t *W1T = (bf16_t*)(ws + WS_W1T), *W2T = (bf16_t*)(ws + WS_W2T), *WGT = (bf16_t*)(ws + WS_WGT), *WPT = (bf16_t*)(ws + WS_WPT), *PB = (bf16_t*)(ws + WS_PB);
    bf16_t *WINT = (bf16_t*)(ws + WS_WINT), *WOUTT = (bf16_t*)(ws + WS_WOUTT), *WGLUT = (bf16_t*)(ws + WS_WGLUT), *WST = (bf16_t*)(ws + WS_WST), *WYT = (bf16_t*)(ws + WS_WYT);
    bf16_t *SB = (bf16_t*)(ws + WS_SB), *QB = (bf16_t*)(ws + WS_QB), *KB = (bf16_t*)(ws + WS_KB), *VB = (bf16_t*)(ws + WS_VB), *UH = (bf16_t*)(ws + WS_UH);
    bf16_t *MIX = (bf16_t*)(ws + WS_MIX), *GB = (bf16_t*)(ws + WS_GB), *HID = (bf16_t*)(ws + WS_HID), *PP = (bf16_t*)(ws + WS_PP);
    float* H3F = (float*)(ws + WS_H3F);
    bf16_t *XB = (bf16_t*)(dob + DO_XB), *H1B = (bf16_t*)(dob + DO_H1B), *H2B = (bf16_t*)(dob + DO_H2B);
    ph_prep_wt(w_in, D, INC, g_mix, WINT, D, AW, C2);
    ph_prep_wt(w_glu, SW, SW, nullptr, WGLUT, SW, 0, 1.f);
    ph_prep_wout(w_out, g_att, g_ssm, WOUTT);
    ph_prep_wt(w_mlp1, D, DFF, g_mlp, W1T, D, 0, 1.f);
    ph_prep_wt(w_mlp2, DFF, D, nullptr, W2T, DFF, 0, 1.f);
    ph_prep_wt(w_gate, D, D, g_ple, WGT, D, 0, 1.f);
    ph_prep_wt(w_proj, PLE, D, nullptr, WPT, PLE, 0, 1.f);
    ph_prep_bias(rel_bias, BIAS);
    ph_ssm_tab(a_re, a_im, log_dt, b_re, b_im, PW, BBt);
    ph_rows_x(xp, xs, XB, RS0);
    ph_cvt_p(pp, ps, PB);
    grid.sync();
    ph_ssm_ws(PW, BBt, WST);
    ph_ssm_wy(PW, BBt, c_re, c_im, ssm_d, WYT);
#if !defined(ONLY) || ONLY == 0
    run_gemm(lds, XB, D, WINT, D, NT, INC, D, 0, 0, 0, EpiIn{RS0, QB, KB, VB, UH});
#endif
    grid.sync();
#ifndef NO_ATTN
    ph_attn_naive(QB, KB, VB, BIAS, MIX, SSQA);
#endif
#if !defined(ONLY) || ONLY == 1
    run_gemm(lds, UH, 512, WST, 256, NG * NCHT, 256, 256, 0, 0, NCHT / 256, EpiS{SB});
#endif
    grid.sync();
    ph_scan(SB, PW, UH);
    grid.sync();
#if !defined(ONLY) || ONLY == 2
    run_gemm(lds, UH, 512, WYT, 512, NG * NCHT, 256, 512, 0, 0, NCHT / 256, EpiY{GB});
#endif
    grid.sync();
#if !defined(ONLY) || ONLY == 3
    run_gemm(lds, GB, SW, WGLUT, SW, NT, SW, SW, 0, 0, 0, EpiGlu{GB, b_glu, MIX, SSQS});
#endif
    grid.sync();
#if !defined(ONLY) || ONLY == 4
    run_gemm(lds, MIX, D, WOUTT, D, NT, D, AW, AW * 2, 1, 0, EpiOut{xp, xs, SSQA, SSQS, H1B, SSQ1});
#endif
    grid.sync();
#if !defined(ONLY) || ONLY == 5
    run_gemm(lds, H1B, D, W1T, D, NT, DFF, D, 0, 0, 0, EpiMlp1{SSQ1, HID});
#endif
    grid.sync();
#if !defined(ONLY) || ONLY == 6
    run_gemm(lds, HID, DFF, W2T, DFF, NT, D, DFF, 0, 0, 0, EpiMlp2{H1B, H2B, SSQ2});
#endif
    grid.sync();
#if !defined(ONLY) || ONLY == 7
    run_gemm(lds, PB, PLE, WPT, PLE, NT, D, PLE, 0, 0, 0, EpiPP{PP});
#endif
    grid.sync();
#if !defined(ONLY) || ONLY == 8
    run_gemm(lds, H2B, D, WGT, D, NT, D, D, 0, 0, 0, EpiGate{SSQ2, H2B, PP, H3F});
#endif
    grid.sync();
    ph_final(H3F, g_final, a.out);
}

extern "C" void kernel_launch(void* const* d_in, const int* in_sizes, int n_in, void* d_out, int out_size, void* d_ws, size_t ws_size, hipStream_t stream) {
    static int grid_blocks = 0;
    if (n_in != 27 || ws_size < WS_END || out_size != NT * D) { fprintf(stderr, "kernel_launch: unexpected sizes n_in %d ws %zu out %d\n", n_in, ws_size, out_size); return; }
    if (!grid_blocks) {
        int dev = 0, cus = 0, per_cu = 0;
        (void)hipGetDevice(&dev);
        (void)hipDeviceGetAttribute(&cus, hipDeviceAttributeMultiprocessorCount, dev);
        if (hipFuncSetAttribute((const void*)mega, hipFuncAttributeMaxDynamicSharedMemorySize, LDS_BYTES) != hipSuccess) { fprintf(stderr, "kernel_launch: hipFuncSetAttribute failed\n"); return; }
        (void)hipOccupancyMaxActiveBlocksPerMultiprocessor(&per_cu, mega, NTHR, LDS_BYTES);
        if (per_cu < 1) { fprintf(stderr, "kernel_launch: occupancy query says %d blocks per CU\n", per_cu); return; }
        grid_blocks = cus;
    }
    Args a{};
    for (int i = 0; i < 27; ++i) a.in[i] = (const float*)d_in[i];
    a.out = (float*)d_out; a.ws = (unsigned char*)d_ws;
    void* args[] = {&a};
    hipError_t e = hipLaunchCooperativeKernel((void*)mega, dim3(grid_blocks), dim3(NTHR), args, LDS_BYTES, stream);
    if (e != hipSuccess) fprintf(stderr, "cooperative launch failed: %s (grid %d)\n", hipGetErrorString(e), grid_blocks);
}
```

```cpp
#include <hip/hip_runtime.h>
#include <hip/hip_cooperative_groups.h>
namespace cg = cooperative_groups;
#include <cstdio>
#include <cstdint>
#include <cmath>

typedef unsigned short bf16_t;
typedef short bf16x8 __attribute__((ext_vector_type(8)));
typedef float f32x4 __attribute__((ext_vector_type(4)));
typedef unsigned u32x2 __attribute__((ext_vector_type(2)));
typedef unsigned u32x4 __attribute__((ext_vector_type(4)));

constexpr int NT = 49152, SEQ = 8192, NSEQ = 6, NPROMPT = 16384;
constexpr int D = 1024, DFF = 4096, PLE = 256, INC = 2048, AW = 512, SW = 512;
constexpr int NH = 8, HD = 64, NG = 32, GC = 16, NS = 64;
constexpr int TCH = 16, NCHT = NT / TCH  , NCHS = SEQ / TCH  ;
constexpr float EPS = 1e-6f;
constexpr float LOG2E = 1.4426950408889634f;
constexpr float C2 = 0.125f * LOG2E;

constexpr size_t MiB = 1u << 20;
constexpr size_t WS_BIAS = 0;
constexpr size_t WS_PW = 64 * 1024;
constexpr size_t WS_BB = 1 * MiB;
constexpr size_t WS_RS0 = 2 * MiB;
constexpr size_t WS_SSQA = 3 * MiB;
constexpr size_t WS_SSQS = 5 * MiB;
constexpr size_t WS_SSQ1 = 7 * MiB;
constexpr size_t WS_SSQ2 = 11 * MiB;
constexpr size_t WS_AM = 15 * MiB;
constexpr size_t WS_AL = WS_AM + 1536 * 1024;
constexpr size_t WS_W1T = 18 * MiB, WS_W2T = 26 * MiB, WS_WGT = 34 * MiB, WS_WPT = 36 * MiB;
constexpr size_t WS_PB = 37 * MiB;
constexpr size_t WS_WINT = 61 * MiB, WS_WOUTT = 65 * MiB, WS_WGLUT = 67 * MiB, WS_WST = 68 * MiB, WS_WYT = 72 * MiB;
constexpr size_t WS_SB = 80 * MiB;
constexpr size_t WS_QB = 128 * MiB, WS_KB = 176 * MiB, WS_VB = 224 * MiB;
constexpr size_t WS_UH = 272 * MiB;
constexpr size_t WS_MIX = 368 * MiB;
constexpr size_t WS_GB = 464 * MiB;
constexpr size_t WS_HID = 128 * MiB;
constexpr size_t WS_PP = 128 * MiB;
constexpr size_t WS_H3F = 224 * MiB;
constexpr size_t WS_END = 512 * MiB;
static_assert(WS_KB - WS_QB == (size_t)NT * AW * 2 && WS_VB - WS_KB == (size_t)NT * AW * 2, "QB | KB | VB contiguous");
constexpr size_t DO_XB = 0, DO_H1B = 0, DO_H2B = 96 * MiB;

__device__ __forceinline__ unsigned f2bf(float f) { unsigned u = __builtin_bit_cast(unsigned, f); return (u + 0x7fffu + ((u >> 16) & 1u)) >> 16; }
__device__ __forceinline__ unsigned pk2(float lo, float hi) { return f2bf(lo) | (f2bf(hi) << 16); }
__device__ __forceinline__ float bf2f(unsigned short b) { return __builtin_bit_cast(float, (unsigned)b << 16); }
__device__ __forceinline__ float bflo(unsigned w) { return __builtin_bit_cast(float, w << 16); }
__device__ __forceinline__ float bfhi(unsigned w) { return __builtin_bit_cast(float, w & 0xffff0000u); }
__device__ __forceinline__ float wave_sum(float v) {
#pragma unroll
    for (int o = 1; o < 64; o <<= 1) v += __shfl_xor(v, o);
    return v;
}
__device__ __forceinline__ const float* xrow(const float* xp, const float* xs, int tok, int width) {
    return tok < NPROMPT ? xp + (size_t)tok * width : xs + (size_t)(tok - NPROMPT) * width;
}


constexpr int NTHR = 512;
__device__ __forceinline__ int tid_fresh() { int t = threadIdx.x; asm volatile("" : "+v"(t)); return t; }
__device__ __forceinline__ size_t gtid_fresh() { return (size_t)blockIdx.x * NTHR + tid_fresh(); }
#define GTID gtid_fresh()
#define GSIZE ((size_t)gridDim.x * NTHR)

__device__ __forceinline__ void ph_prep_wt(const float* __restrict__ W, int K, int N, const float* __restrict__ g, bf16_t* __restrict__ out, int ldo, int nscale, float sc) {
    for (size_t i = GTID; i < (size_t)K * N; i += GSIZE) {
        const int k = (int)(i / N), n = (int)(i % N);
        float v = W[i]; if (g) v *= g[k]; if (n < nscale) v *= sc;
        out[(size_t)n * ldo + k] = (bf16_t)f2bf(v);
    }
}
__device__ __forceinline__ void ph_prep_wout(const float* __restrict__ W, const float* __restrict__ ga, const float* __restrict__ gs, bf16_t* __restrict__ out) {
    for (size_t i = GTID; i < (size_t)D * D; i += GSIZE) {
        const int k = (int)(i / D), n = (int)(i % D);
        const float v = W[i] * (k < AW ? ga[k] : gs[k - AW]);
        out[(size_t)n * D + k] = (bf16_t)f2bf(v);
    }
}
__device__ __forceinline__ int t5_bucket(int rel) {
    int n = -rel; int ret = n < 0 ? 16 : 0; n = n < 0 ? -n : n;
    if (n < 8) return ret + n;
    int large = 8 + (int)(log((double)n / 8.0) / log(128.0) * 8.0);
    large = large < 15 ? large : 15;
    return ret + large;
}
__device__ __forceinline__ void ph_prep_bias(const float* __restrict__ rel_bias, float* __restrict__ bias) {
    for (size_t i = GTID; i < 3 * 8 * 129; i += GSIZE) {
        const int o = (int)(i % 129), h = (int)((i / 129) % 8), b = (int)(i / (129 * 8));
        const int dil = b == 0 ? 1 : (b == 1 ? 4 : 16);
        bias[i] = rel_bias[t5_bucket((o - 64) * dil) * NH + h] * LOG2E;
    }
}
__device__ __forceinline__ void ph_rows_x(const float* __restrict__ xp, const float* __restrict__ xs, bf16_t* __restrict__ XB, float* __restrict__ RS0) {
    const int tidf = tid_fresh(), lane = tidf & 63;
    for (int row = blockIdx.x * 8 + (tidf >> 6); row < NT; row += gridDim.x * 8) {
        const f32x4* xr = (const f32x4*)xrow(xp, xs, row, D) + lane;
        float s = 0.f; f32x4 v[4];
#pragma unroll
        for (int j = 0; j < 4; ++j) { v[j] = xr[64 * j]; s += v[j].x * v[j].x + v[j].y * v[j].y + v[j].z * v[j].z + v[j].w * v[j].w; }
        s = wave_sum(s);
        u32x2* o = (u32x2*)(XB + (size_t)row * D) + lane;
#pragma unroll
        for (int j = 0; j < 4; ++j) { u32x2 w; w.x = pk2(v[j].x, v[j].y); w.y = pk2(v[j].z, v[j].w); o[64 * j] = w; }
        if (lane == 0) RS0[row] = 1.0f / sqrtf(s * (1.0f / D) + EPS);
    }
}
__device__ __forceinline__ void ph_cvt_p(const float* __restrict__ pp, const float* __restrict__ ps, bf16_t* __restrict__ PB) {
    for (size_t i = GTID; i < (size_t)NT * PLE / 4; i += GSIZE) {
        const int tok = (int)(i / (PLE / 4)), c4 = (int)(i % (PLE / 4));
        const f32x4 v = *((const f32x4*)xrow(pp, ps, tok, PLE) + c4);
        u32x2 w; w.x = pk2(v.x, v.y); w.y = pk2(v.z, v.w);
        *((u32x2*)(PB + (size_t)tok * PLE) + c4) = w;
    }
}
__device__ __forceinline__ void ph_ssm_tab(const float* __restrict__ a_re, const float* __restrict__ a_im, const float* __restrict__ log_dt,
                          const float* __restrict__ b_re, const float* __restrict__ b_im, float* __restrict__ PW, float* __restrict__ BB) {
    for (size_t ii = GTID; ii < NG * 2 * NS; ii += GSIZE) {
        const int i = (int)ii;
        const int n = i % NS, dir = (i / NS) % 2, g = i / (2 * NS);
        const int pi = (dir * NG + g) * NS + n;
        const double ar = a_re[pi], ai = a_im[pi], dt = exp((double)log_dt[dir * NG + g]);
        float* pw = PW + (size_t)((g * 2 + dir) * NS + n) * 17 * 2;
        for (int e = 0; e <= 16; ++e) { const double mag = exp(ar * dt * e), ang = ai * dt * e; pw[2 * e] = (float)(mag * cos(ang)); pw[2 * e + 1] = (float)(mag * sin(ang)); }
        const double abr = exp(ar * dt) * cos(ai * dt), abi = exp(ar * dt) * sin(ai * dt), inv = 1.0 / (ar * ar + ai * ai);
        const double fr = ((abr - 1.0) * ar + abi * ai) * inv, fi = (abi * ar - (abr - 1.0) * ai) * inv;
        float* bb = BB + (size_t)((g * 2 + dir) * NS + n) * GC * 2;
        for (int h = 0; h < GC; ++h) { const double br = b_re[(size_t)pi * GC + h], bi = b_im[(size_t)pi * GC + h]; bb[2 * h] = (float)(fr * br - fi * bi); bb[2 * h + 1] = (float)(fr * bi + fi * br); }
    }
}
__device__ __forceinline__ void ph_ssm_ws(const float* __restrict__ PW, const float* __restrict__ BB, bf16_t* __restrict__ WST) {
    for (size_t ii = GTID; ii < (size_t)NG * 256 * 256; ii += GSIZE) {
        const int i = (int)ii;
        const int k = i % 256, col = (i / 256) % 256, g = i / 65536;
        const int j = k / 16, hp = k % 16, dir = col / 128, n = (col % 128) / 2, ri = col & 1;
        const int e = dir == 0 ? 15 - j : j;
        const float* pw = PW + ((size_t)((g * 2 + dir) * NS + n) * 17 + e) * 2; const float* bb = BB + ((size_t)((g * 2 + dir) * NS + n) * GC + hp) * 2;
        const float vr = pw[0] * bb[0] - pw[1] * bb[1], vi = pw[0] * bb[1] + pw[1] * bb[0];
        WST[i] = (bf16_t)f2bf(ri ? vi : vr);
    }
}
__device__ __forceinline__ void ph_ssm_wy(const float* __restrict__ PW, const float* __restrict__ BB, const float* __restrict__ c_re, const float* __restrict__ c_im,
                         const float* __restrict__ dd, bf16_t* __restrict__ WYT) {
    for (size_t ii = GTID; ii < (size_t)NG * 256 * 512; ii += GSIZE) {
        const int i = (int)ii;
        const int k = i % 512, jh = (i / 512) % 256, g = i / (512 * 256);
        const int j = jh / 16, h = jh % 16;
        float v = 0.f;
        if (k < 256) {
            const int jp = k / 16, hp = k % 16;
            for (int dir = 0; dir < 2; ++dir) {
                const int e = dir == 0 ? j - jp : jp - j;
                if (e < 0) continue;
                for (int n = 0; n < NS; ++n) {
                    const float* pw = PW + ((size_t)((g * 2 + dir) * NS + n) * 17 + e) * 2; const float* bb = BB + ((size_t)((g * 2 + dir) * NS + n) * GC + hp) * 2;
                    const size_t ci = ((size_t)(dir * NG + g) * GC + h) * NS + n;
                    const float cr = c_re[ci], cim = c_im[ci];
                    const float tr = pw[0] * bb[0] - pw[1] * bb[1], ti = pw[0] * bb[1] + pw[1] * bb[0];
                    v += cr * tr - cim * ti;
                }
            }
            if (jp == j && hp == h) v += dd[g * GC + h];
        } else {
            const int kk = k - 256, dir = kk / 128, n = (kk % 128) / 2, ri = kk & 1;
            const int e = dir == 0 ? j + 1 : 16 - j;
            const float* pw = PW + ((size_t)((g * 2 + dir) * NS + n) * 17 + e) * 2;
            const size_t ci = ((size_t)(dir * NG + g) * GC + h) * NS + n;
            const float cr = c_re[ci], cim = c_im[ci];
            const float pr = cr * pw[0] - cim * pw[1], pim = cr * pw[1] + cim * pw[0];
            v = ri ? -pim : pr;
        }
        WYT[i] = (bf16_t)f2bf(v);
    }
}


__device__ __forceinline__ void st_bf4(bf16_t* p, f32x4 v) { u32x2 w; w.x = pk2(v.x, v.y); w.y = pk2(v.z, v.w); *(u32x2*)p = w; }
__device__ __forceinline__ f32x4 ld_bf4(const bf16_t* p) { const u32x2 w = *(const u32x2*)p; return (f32x4){bflo(w.x), bfhi(w.x), bflo(w.y), bfhi(w.y)}; }
namespace pg8 {
#define PG8_LAS __attribute__((address_space(3)))
constexpr int BM = 256, BK = 64, HALF = 128, HTB = HALF * BK * 2  , STAGE_BYTES = 8 * HTB, NXCD = 8, WGM = 8;

__host__ __device__ __forceinline__ int lds_byte(int r, int c) { const int st = (r >> 4) * 2 + (c >> 5), rr = r & 15, cc = c & 31, ob = rr * 64 + cc * 2; return st * 1024 + (ob ^ (((ob >> 9) & 1) << 5)); }
__host__ __device__ __forceinline__ void stage_rc(int b, int& R, int& C) { const int st = b / 1024, sb = b % 1024, swz = sb ^ (((sb >> 9) & 1) << 5); R = (st >> 1) * 16 + swz / 64; C = (st & 1) * 32 + (swz % 64) / 2; }
__host__ __device__ __forceinline__ int perm32(int rho) { const int n = rho >> 4, i = rho & 15; return 8 * (i >> 2) + 4 * n + (i & 3); }
struct Unit { int pm, pn, kh; };
struct Gemm { const bf16_t* A; const bf16_t* Bt; int lda, ldb, K, khb; };
struct Order {
    int nM, nN, nwg, G, c, split, bdiv;
    __device__ void init(int M, int N, int G_, int c_, int split_ = 0, int bdiv_ = 0) { nM = M / BM; nN = N / BM; nwg = nM * nN; G = G_; c = c_; split = split_; bdiv = bdiv_; }
    __device__ bool next(int i, Unit& u) const {
        const int ti = split ? (i >> 1) : i;
        const long L = (long)ti * G + c; if (L >= nwg) return false;
        int wgid = (int)L; { const int q = nwg / NXCD, r = nwg % NXCD, xcd = wgid % NXCD, off = wgid / NXCD; wgid = (xcd < r ? xcd * (q + 1) : r * (q + 1) + (xcd - r) * q) + off; }
        const int nig = WGM * nN, gid = wgid / nig, fm = gid * WGM, gsz = (nM - fm) < WGM ? (nM - fm) : WGM;
        u.pm = fm + ((wgid % nig) % gsz); u.pn = (wgid % nig) / gsz; u.kh = split ? (i & 1) : 0;
        if (bdiv) u.pn = u.pm / bdiv;
        return true;
    }
    __device__ __forceinline__ void a_ready(const Unit&) const {}
    __device__ __forceinline__ void done(const Unit&) const {}
};
__device__ __forceinline__ unsigned cvt_pk_bf16(float lo, float hi) { unsigned r; asm volatile("v_cvt_pk_bf16_f32 %0, %1, %2" : "=v"(r) : "v"(lo), "v"(hi)); return r; }
template <class Epi, class Sched, bool ALIGN_EPI = false, bool SP2 = false>
__device__ __forceinline__ void gemm_phase(PG8_LAS unsigned char* lds, const Gemm g, const Sched& S, const Epi& E) {
    const int tid = tid_fresh(), wid = __builtin_amdgcn_readfirstlane(tid >> 6), lane = tid & 63, wr = wid >> 2, wc = wid & 3, fr = lane & 15, fq = lane >> 4;
    const int K = g.K, nt = K / BK;
    unsigned voffA[2], voffB[2];
#pragma unroll
    for (int i = 0; i < 2; ++i) { int R, C; stage_rc(tid * 16 + i * 8192, R, C); const int Rb = Epi::PERM ? ((R & ~31) + perm32(R & 31)) : R;
        voffA[i] = (unsigned)(R * g.lda + C) * 2u; voffB[i] = (unsigned)(Rb * g.ldb + C) * 2u; }
    const size_t kstep = (size_t)(BK * 2);
    const size_t hstepA = (size_t)HALF * g.lda * 2, hstepB = (size_t)HALF * g.ldb * 2;
    const size_t tstepA = 2 * hstepA, tstepB = 2 * hstepB;
    const unsigned ldsw = (unsigned)wid * 1024u;
    const int aoff = lds_byte(wr * 64 + fr, fq * 8), boff = lds_byte(wc * 32 + fr, fq * 8);
#define PG8_SA(b, h) (((b) * 2 + (h)) * HTB)
#define PG8_SB(b, h) ((4 + (b) * 2 + (h)) * HTB)
#define PG8_STAGE(bufoff, gbase, voff) do { _Pragma("unroll") for (int _i = 0; _i < 2; ++_i) \
        __builtin_amdgcn_global_load_lds((const unsigned*)((const char*)(gbase) + (voff)[_i]), (PG8_LAS unsigned*)(lds + (bufoff) + ldsw + _i * 8192), 16, 0, 0); } while (0)
#define PG8_LDA(dst, b, h) do { _Pragma("unroll") for (int m = 0; m < 4; ++m) _Pragma("unroll") for (int k = 0; k < 2; ++k) dst[m][k] = *(const PG8_LAS bf16x8*)(lds + PG8_SA(b, h) + aoff + m * 2048 + k * 1024); } while (0)
#define PG8_LDB(dst, b, h) do { _Pragma("unroll") for (int n = 0; n < 2; ++n) _Pragma("unroll") for (int k = 0; k < 2; ++k) dst[n][k] = *(const PG8_LAS bf16x8*)(lds + PG8_SB(b, h) + boff + n * 2048 + k * 1024); } while (0)
#define PG8_MMA(ai, bj, At, Bt) do { __builtin_amdgcn_s_setprio(1); _Pragma("unroll") for (int m = 0; m < 4; ++m) _Pragma("unroll") for (int n = 0; n < 2; ++n) _Pragma("unroll") for (int k = 0; k < 2; ++k) \
        acc[ai][bj][m][n] = __builtin_amdgcn_mfma_f32_16x16x32_bf16(Bt[n][k], At[m][k], acc[ai][bj][m][n], 0, 0, 0); __builtin_amdgcn_s_setprio(0); } while (0)
#define PG8_WAIT_V(n) asm volatile("s_waitcnt vmcnt(" #n ")" ::: "memory")
#define PG8_WAIT_L(n) asm volatile("s_waitcnt lgkmcnt(" #n ")" ::: "memory")
#define PG8_BAR __builtin_amdgcn_s_barrier()
#define PG8_SCHED __builtin_amdgcn_sched_barrier(0)
    Unit cur, nxt; int ui = 0;
    if (!S.next(0, cur)) return;
    f32x4 acc[2][2][4][2];
#pragma unroll
    for (int a = 0; a < 2; ++a)
#pragma unroll
        for (int b = 0; b < 2; ++b)
#pragma unroll
            for (int m = 0; m < 4; ++m)
#pragma unroll
                for (int n = 0; n < 2; ++n) acc[a][b][m][n] = (f32x4){0.f, 0.f, 0.f, 0.f};
    bf16x8 At[4][2], B0[2][2], B1[2][2];
    const char* cA = (const char*)g.A + (size_t)cur.pm * tstepA + (size_t)cur.kh * g.khb; const char* cB = (const char*)g.Bt + (size_t)cur.pn * tstepB + (size_t)cur.kh * g.khb;
    S.a_ready(cur);
    if constexpr (SP2) {
        PG8_STAGE(PG8_SB(0, 0), cB, voffB); PG8_STAGE(PG8_SB(0, 1), cB + hstepB, voffB); PG8_STAGE(PG8_SA(0, 0), cA, voffA); PG8_STAGE(PG8_SA(0, 1), cA + hstepA, voffA);
        if (wr == 1) PG8_BAR;
        PG8_WAIT_V(2); PG8_BAR;
        PG8_STAGE(PG8_SB(1, 0), cB + kstep, voffB); PG8_STAGE(PG8_SA(1, 0), cA + kstep, voffA); PG8_STAGE(PG8_SB(1, 1), cB + hstepB + kstep, voffB);
        PG8_WAIT_V(6); PG8_BAR;
    } else {
        PG8_STAGE(PG8_SB(0, 0), cB, voffB); PG8_STAGE(PG8_SA(0, 0), cA, voffA); PG8_STAGE(PG8_SB(0, 1), cB + hstepB, voffB); PG8_STAGE(PG8_SA(0, 1), cA + hstepA, voffA);
        if (wr == 1) PG8_BAR;
        PG8_WAIT_V(4); PG8_BAR;
        PG8_STAGE(PG8_SB(1, 0), cB + kstep, voffB); PG8_STAGE(PG8_SA(1, 0), cA + kstep, voffA); PG8_STAGE(PG8_SB(1, 1), cB + hstepB + kstep, voffB);
        PG8_WAIT_V(6); PG8_BAR;
    }
    for (;;) {
        const bool has_next = S.next(ui + 1, nxt);
        const char* nA = has_next ? (const char*)g.A + (size_t)nxt.pm * tstepA + (size_t)nxt.kh * g.khb : cA; const char* nB = has_next ? (const char*)g.Bt + (size_t)nxt.pn * tstepB + (size_t)nxt.kh * g.khb : cB;
#pragma nounroll
        for (int t = 0; t < nt; t += 2) {
            const bool last = (t == nt - 2);
            const char* a1 = cA + (size_t)(t + 1) * kstep;
            const char* a2 = last ? nA : cA + (size_t)(t + 2) * kstep; const char* b2 = last ? nB : cB + (size_t)(t + 2) * kstep;
            const char* a3 = a2 + kstep; const char* b3 = b2 + kstep;
            if (last && has_next) S.a_ready(nxt);
            if constexpr (SP2) {
            PG8_LDB(B0, 0, 0); PG8_LDB(B1, 0, 1); PG8_SCHED; PG8_LDA(At, 0, 0); PG8_STAGE(PG8_SA(1, 1), a1 + hstepA, voffA);
            PG8_WAIT_V(8); PG8_WAIT_L(0); PG8_BAR; PG8_MMA(0, 0, At, B0); PG8_MMA(0, 1, At, B1); PG8_BAR; PG8_SCHED;
            PG8_LDA(At, 0, 1); PG8_STAGE(PG8_SB(0, 0), b2, voffB); PG8_STAGE(PG8_SB(0, 1), b2 + hstepB, voffB); PG8_STAGE(PG8_SA(0, 0), a2, voffA);
            PG8_WAIT_V(8); PG8_WAIT_L(0); PG8_BAR; PG8_MMA(1, 0, At, B0); PG8_MMA(1, 1, At, B1); PG8_BAR; PG8_SCHED;
            PG8_LDB(B0, 1, 0); PG8_LDB(B1, 1, 1); PG8_SCHED; PG8_LDA(At, 1, 0); PG8_STAGE(PG8_SA(0, 1), a2 + hstepA, voffA);
            PG8_WAIT_V(8); PG8_WAIT_L(0); PG8_BAR; PG8_MMA(0, 0, At, B0); PG8_MMA(0, 1, At, B1); PG8_BAR; PG8_SCHED;
            PG8_LDA(At, 1, 1); PG8_STAGE(PG8_SB(1, 0), b3, voffB); PG8_STAGE(PG8_SB(1, 1), b3 + hstepB, voffB); PG8_STAGE(PG8_SA(1, 0), a3, voffA);
            PG8_WAIT_V(8); PG8_WAIT_L(0); PG8_BAR; PG8_MMA(1, 0, At, B0); PG8_MMA(1, 1, At, B1); PG8_BAR; PG8_SCHED;
            } else {
            PG8_LDB(B0, 0, 0); PG8_SCHED; PG8_LDA(At, 0, 0); PG8_STAGE(PG8_SA(1, 1), a1 + hstepA, voffA);
            PG8_WAIT_L(8); PG8_BAR; PG8_WAIT_L(0); PG8_MMA(0, 0, At, B0); PG8_BAR; PG8_SCHED;
            PG8_LDB(B1, 0, 1); PG8_STAGE(PG8_SB(0, 0), b2, voffB);
            PG8_BAR; PG8_WAIT_L(0); PG8_MMA(0, 1, At, B1); PG8_BAR;
            PG8_LDA(At, 0, 1); PG8_STAGE(PG8_SA(0, 0), a2, voffA);
            PG8_BAR; PG8_WAIT_L(0); PG8_MMA(1, 0, At, B0); PG8_BAR; PG8_SCHED;
            PG8_STAGE(PG8_SB(0, 1), b2 + hstepB, voffB);
            PG8_WAIT_V(6); PG8_BAR; PG8_MMA(1, 1, At, B1); PG8_BAR;
            PG8_LDB(B0, 1, 0); PG8_SCHED; PG8_LDA(At, 1, 0); PG8_STAGE(PG8_SA(0, 1), a2 + hstepA, voffA);
            PG8_WAIT_L(8); PG8_BAR; PG8_WAIT_L(0); PG8_MMA(0, 0, At, B0); PG8_BAR; PG8_SCHED;
            PG8_LDB(B1, 1, 1); PG8_STAGE(PG8_SB(1, 0), b3, voffB);
            PG8_BAR; PG8_WAIT_L(0); PG8_MMA(0, 1, At, B1); PG8_BAR;
            PG8_LDA(At, 1, 1); PG8_STAGE(PG8_SA(1, 0), a3, voffA);
            PG8_BAR; PG8_WAIT_L(0); PG8_MMA(1, 0, At, B0); PG8_BAR; PG8_SCHED;
            PG8_STAGE(PG8_SB(1, 1), b3 + hstepB, voffB);
            PG8_WAIT_V(6); PG8_BAR; PG8_MMA(1, 1, At, B1); PG8_BAR;
            }
        }
        if constexpr (ALIGN_EPI) { if (wr == 0) PG8_BAR; }
        if constexpr (!Epi::AFTER_DRAIN) { E(acc, cur, wr, wc, fr, fq); S.done(cur); }
        if (!has_next) break;
        if (Epi::zero_after(cur)) {
#pragma unroll
        for (int a = 0; a < 2; ++a)
#pragma unroll
            for (int b = 0; b < 2; ++b)
#pragma unroll
                for (int m = 0; m < 4; ++m)
#pragma unroll
                    for (int n = 0; n < 2; ++n) acc[a][b][m][n] = (f32x4){0.f, 0.f, 0.f, 0.f};
        }
        cur = nxt; cA = nA; cB = nB; ++ui;
        if constexpr (ALIGN_EPI) { if (wr == 1) PG8_BAR; }
    }
    PG8_WAIT_V(0);
    if constexpr (!ALIGN_EPI) { if (wr == 0) PG8_BAR; }
    PG8_BAR;
    if constexpr (Epi::AFTER_DRAIN) { E.fused(acc, cur, wr, wc, fr, fq, lds, wid, lane); S.done(cur); }
#undef PG8_SA
#undef PG8_SB
#undef PG8_STAGE
#undef PG8_LDA
#undef PG8_LDB
#undef PG8_MMA
#undef PG8_WAIT_V
#undef PG8_WAIT_L
#undef PG8_BAR
#undef PG8_SCHED
}
}

typedef f32x4 AccT[2][2][4][2];
__device__ __forceinline__ float sigm(float x) { return 1.0f / (1.0f + __expf(-x)); }
__device__ __forceinline__ float gelu_tanh(float x) { const float u = 0.7978845608028654f * (x + 0.044715f * x * x * x); return 0.5f * x * (1.0f + tanhf(u)); }
__device__ __forceinline__ u32x4 pack8(f32x4 a, f32x4 b) { u32x4 w; w.x = pg8::cvt_pk_bf16(a.x, a.y); w.y = pg8::cvt_pk_bf16(a.z, a.w); w.z = pg8::cvt_pk_bf16(b.x, b.y); w.w = pg8::cvt_pk_bf16(b.z, b.w); return w; }
__device__ __forceinline__ void unpack8(u32x4 w, f32x4& a, f32x4& b) { a = (f32x4){bflo(w.x), bfhi(w.x), bflo(w.y), bfhi(w.y)}; b = (f32x4){bflo(w.z), bfhi(w.z), bflo(w.w), bfhi(w.w)}; }
__device__ __forceinline__ float sumsq4(f32x4 v) { return (v.x * v.x + v.y * v.y) + (v.z * v.z + v.w * v.w); }
__device__ __forceinline__ float sum8f(const float* p) { const f32x4 a = *(const f32x4*)p, b = *(const f32x4*)(p + 4); return ((a.x + a.y) + (a.z + a.w)) + ((b.x + b.y) + (b.z + b.w)); }
__device__ __forceinline__ float sum16f(const float* p) { return sum8f(p) + sum8f(p + 8); }
__device__ __forceinline__ float red_fq(float s) { s += __shfl_xor(s, 16); s += __shfl_xor(s, 32); return s; }
#define EPI_ROWS(...) _Pragma("unroll") for (int ai = 0; ai < 2; ++ai) _Pragma("unroll") for (int m = 0; m < 4; ++m) { const int row = u.pm * 256 + ai * 128 + wr * 64 + m * 16 + fr; __VA_ARGS__ }
#define EPI_COLS(...) _Pragma("unroll") for (int bj = 0; bj < 2; ++bj) { const int col = u.pn * 256 + bj * 128 + wc * 32 + 8 * fq; f32x4& v0 = acc[ai][bj][m][0]; f32x4& v1 = acc[ai][bj][m][1]; __VA_ARGS__ }

struct EpiIn {
    static constexpr bool PERM = true, AFTER_DRAIN = false; __device__ static bool zero_after(const pg8::Unit&) { return true; }
    const float* RS0; bf16_t *QB, *KB, *VB, *UH;
    __device__ __forceinline__ void operator()(AccT& acc, const pg8::Unit& u, int wr, int wc, int fr, int fq) const {
        EPI_ROWS( const float rs = RS0[row];
            EPI_COLS( const u32x4 w = pack8(v0 * rs, v1 * rs);
                if (u.pn < 6) { bf16_t* dst = QB + (size_t)(u.pn >> 1) * ((size_t)NT * AW); *(u32x4*)(dst + (size_t)row * AW + (col & (AW - 1))) = w; }
                else { const int c = col - 3 * AW, g = c >> 4, ch = c & 15; *(u32x4*)(UH + ((size_t)(g * NCHT + (row >> 4))) * 512 + (row & 15) * 16 + ch) = w; } ) )
    }
};
struct EpiS {
    static constexpr bool PERM = true, AFTER_DRAIN = false; __device__ static bool zero_after(const pg8::Unit&) { return true; }
    bf16_t* SB;
    __device__ __forceinline__ void operator()(AccT& acc, const pg8::Unit& u, int wr, int wc, int fr, int fq) const {
        EPI_ROWS( EPI_COLS( *(u32x4*)(SB + (size_t)row * 256 + (col - u.pn * 256)) = pack8(v0, v1); ) )
    }
};
struct EpiY {
    static constexpr bool PERM = true, AFTER_DRAIN = false; __device__ static bool zero_after(const pg8::Unit&) { return true; }
    bf16_t* GB;
    __device__ __forceinline__ void operator()(AccT& acc, const pg8::Unit& u, int wr, int wc, int fr, int fq) const {
        const int g = u.pn;
        EPI_ROWS( const int chunk = row - g * NCHT;
            EPI_COLS( const int cl = col - u.pn * 256, j = cl >> 4, h = cl & 15; const size_t tok = (size_t)chunk * 16 + j;
                f32x4 a, b; a.x = gelu_tanh(v0.x); a.y = gelu_tanh(v0.y); a.z = gelu_tanh(v0.z); a.w = gelu_tanh(v0.w); b.x = gelu_tanh(v1.x); b.y = gelu_tanh(v1.y); b.z = gelu_tanh(v1.z); b.w = gelu_tanh(v1.w);
                *(u32x4*)(GB + tok * SW + g * 16 + h) = pack8(a, b); ) )
    }
};
struct EpiGlu {
    static constexpr bool PERM = true, AFTER_DRAIN = false; __device__ static bool zero_after(const pg8::Unit&) { return true; }
    const bf16_t* GB; const float* bglu; bf16_t* MIX; float* SSQS;
    __device__ __forceinline__ void operator()(AccT& acc, const pg8::Unit& u, int wr, int wc, int fr, int fq) const {
        EPI_ROWS( float sq = 0.f;
            EPI_COLS( f32x4 g0, g1; unpack8(*(const u32x4*)(GB + (size_t)row * SW + col), g0, g1); const f32x4 b0 = *(const f32x4*)(bglu + col), b1 = *(const f32x4*)(bglu + col + 4);
                f32x4 o0, o1; o0.x = g0.x * sigm(v0.x + b0.x); o0.y = g0.y * sigm(v0.y + b0.y); o0.z = g0.z * sigm(v0.z + b0.z); o0.w = g0.w * sigm(v0.w + b0.w);
                o1.x = g1.x * sigm(v1.x + b1.x); o1.y = g1.y * sigm(v1.y + b1.y); o1.z = g1.z * sigm(v1.z + b1.z); o1.w = g1.w * sigm(v1.w + b1.w);
                sq += sumsq4(o0) + sumsq4(o1); *(u32x4*)(MIX + (size_t)row * D + AW + col) = pack8(o0, o1); )
            sq = red_fq(sq); if (fq == 0) SSQS[(size_t)row * 8 + u.pn * 4 + wc] = sq; )
    }
};
struct EpiOut {
    static constexpr bool PERM = true, AFTER_DRAIN = false; __device__ static bool zero_after(const pg8::Unit& u) { return u.kh != 0; }
    const float *xp, *xs; const float *SSQA, *SSQS; bf16_t* H1B; float* SSQ1;
    __device__ __forceinline__ void operator()(AccT& acc, const pg8::Unit& u, int wr, int wc, int fr, int fq) const {
        if (u.kh == 0) {
            EPI_ROWS( const float rsa = 1.0f / sqrtf(sum8f(SSQA + (size_t)row * 8) * (1.0f / AW) + EPS), rss = 1.0f / sqrtf(sum8f(SSQS + (size_t)row * 8) * (1.0f / SW) + EPS); const float r = rsa / rss;
                EPI_COLS( v0 = v0 * r; v1 = v1 * r; ) )
        } else {
            EPI_ROWS( const float rss = 1.0f / sqrtf(sum8f(SSQS + (size_t)row * 8) * (1.0f / SW) + EPS); float sq = 0.f; const float* xr = xrow(xp, xs, row, D);
                EPI_COLS( const f32x4 o0 = *(const f32x4*)(xr + col) + v0 * rss, o1 = *(const f32x4*)(xr + col + 4) + v1 * rss;
                    sq += sumsq4(o0) + sumsq4(o1); *(u32x4*)(H1B + (size_t)row * D + col) = pack8(o0, o1); )
                sq = red_fq(sq); if (fq == 0) SSQ1[(size_t)row * 16 + u.pn * 4 + wc] = sq; )
        }
    }
};
struct EpiMlp1 {
    static constexpr bool PERM = true, AFTER_DRAIN = false; __device__ static bool zero_after(const pg8::Unit&) { return true; }
    const float* SSQ1; bf16_t* HID;
    __device__ __forceinline__ void operator()(AccT& acc, const pg8::Unit& u, int wr, int wc, int fr, int fq) const {
        EPI_ROWS( const float rs = 1.0f / sqrtf(sum16f(SSQ1 + (size_t)row * 16) * (1.0f / D) + EPS);
            EPI_COLS( f32x4 a = v0 * rs, b = v1 * rs; a.x = fmaxf(a.x, 0.f); a.y = fmaxf(a.y, 0.f); a.z = fmaxf(a.z, 0.f); a.w = fmaxf(a.w, 0.f); b.x = fmaxf(b.x, 0.f); b.y = fmaxf(b.y, 0.f); b.z = fmaxf(b.z, 0.f); b.w = fmaxf(b.w, 0.f);
                *(u32x4*)(HID + (size_t)row * DFF + col) = pack8(a * a, b * b); ) )
    }
};
struct EpiMlp2 {
    static constexpr bool PERM = true, AFTER_DRAIN = false; __device__ static bool zero_after(const pg8::Unit&) { return true; }
    const bf16_t* H1B; bf16_t* H2B; float* SSQ2;
    __device__ __forceinline__ void operator()(AccT& acc, const pg8::Unit& u, int wr, int wc, int fr, int fq) const {
        EPI_ROWS( float sq = 0.f;
            EPI_COLS( f32x4 h0, h1; unpack8(*(const u32x4*)(H1B + (size_t)row * D + col), h0, h1); const f32x4 o0 = h0 + v0, o1 = h1 + v1;
                sq += sumsq4(o0) + sumsq4(o1); *(u32x4*)(H2B + (size_t)row * D + col) = pack8(o0, o1); )
            sq = red_fq(sq); if (fq == 0) SSQ2[(size_t)row * 16 + u.pn * 4 + wc] = sq; )
    }
};
struct EpiPP {
    static constexpr bool PERM = true, AFTER_DRAIN = false; __device__ static bool zero_after(const pg8::Unit&) { return true; }
    bf16_t* PP;
    __device__ __forceinline__ void operator()(AccT& acc, const pg8::Unit& u, int wr, int wc, int fr, int fq) const {
        EPI_ROWS( EPI_COLS( *(u32x4*)(PP + (size_t)row * D + col) = pack8(v0, v1); ) )
    }
};
struct EpiGate {
    static constexpr bool PERM = true, AFTER_DRAIN = false; __device__ static bool zero_after(const pg8::Unit&) { return true; }
    const float* SSQ2; const bf16_t* H2B; const bf16_t* PP; float* H3F;
    __device__ __forceinline__ void operator()(AccT& acc, const pg8::Unit& u, int wr, int wc, int fr, int fq) const {
        EPI_ROWS( const float rs = 1.0f / sqrtf(sum16f(SSQ2 + (size_t)row * 16) * (1.0f / D) + EPS);
            EPI_COLS( f32x4 h0, h1, p0, p1; unpack8(*(const u32x4*)(H2B + (size_t)row * D + col), h0, h1); unpack8(*(const u32x4*)(PP + (size_t)row * D + col), p0, p1);
                f32x4 o0, o1; o0.x = h0.x + sigm(v0.x * rs) * p0.x; o0.y = h0.y + sigm(v0.y * rs) * p0.y; o0.z = h0.z + sigm(v0.z * rs) * p0.z; o0.w = h0.w + sigm(v0.w * rs) * p0.w;
                o1.x = h1.x + sigm(v1.x * rs) * p1.x; o1.y = h1.y + sigm(v1.y * rs) * p1.y; o1.z = h1.z + sigm(v1.z * rs) * p1.z; o1.w = h1.w + sigm(v1.w * rs) * p1.w;
                *(f32x4*)(H3F + (size_t)row * D + col) = o0; *(f32x4*)(H3F + (size_t)row * D + col + 4) = o1; ) )
    }
};

__device__ __forceinline__ void ph_final(const float* __restrict__ H3F, const float* __restrict__ gf, float* __restrict__ out) {
    const int tidf = tid_fresh(), lane = tidf & 63;
    for (int row = blockIdx.x * 8 + (tidf >> 6); row < NT; row += gridDim.x * 8) {
        const f32x4* xr = (const f32x4*)(H3F + (size_t)row * D) + lane;
        float s = 0.f; f32x4 v[4];
#pragma unroll
        for (int j = 0; j < 4; ++j) { v[j] = xr[64 * j]; s += v[j].x * v[j].x + v[j].y * v[j].y + v[j].z * v[j].z + v[j].w * v[j].w; }
        s = wave_sum(s); const float rs = 1.0f / sqrtf(s * (1.0f / D) + EPS);
        f32x4* o = (f32x4*)(out + (size_t)row * D) + lane; const f32x4* g4 = (const f32x4*)gf + lane;
#pragma unroll
        for (int j = 0; j < 4; ++j) o[64 * j] = v[j] * rs * g4[64 * j];
    }
}

__device__ __forceinline__ void ph_attn_naive(const bf16_t* __restrict__ QB, const bf16_t* __restrict__ KB, const bf16_t* __restrict__ VB, const float* __restrict__ bias, bf16_t* __restrict__ MIX, float* __restrict__ SSQA) {
    for (size_t ii = GTID; ii < (size_t)NT * NH * 2; ii += GSIZE) {
        const int i = (int)(ii >> 1), hf = (int)(ii & 1);
        const int h = i % NH, tok = i / NH;
        const int s = tok / SEQ, pos = tok % SEQ;
        u32x4 qw[8];
        { const u32x4* qp = (const u32x4*)(QB + (size_t)tok * AW + h * HD);
#pragma unroll
          for (int c = 0; c < 8; ++c) qw[c] = qp[c]; }
        float o[32];
#pragma unroll
        for (int c = 0; c < 32; ++c) o[c] = 0.f;
        float m = -1e30f, l = 0.f;
        for (int b = 0; b < 3; ++b) {
            const int dil = b == 0 ? 1 : (b == 1 ? 4 : 16);
            const float* bt = bias + (b * NH + h) * 129;
            for (int off = -64; off <= 64; ++off) {
                const int kp = pos + off * dil; if (kp < 0 || kp >= SEQ) continue;
                const size_t kt = (size_t)s * SEQ + kp;
                const u32x4* kr = (const u32x4*)(KB + kt * AW + h * HD);
                float sc = 0.f;
#pragma unroll
                for (int c = 0; c < 8; ++c) { const u32x4 w = kr[c]; const u32x4 qq = qw[c]; sc += bflo(qq.x) * bflo(w.x) + bfhi(qq.x) * bfhi(w.x) + bflo(qq.y) * bflo(w.y) + bfhi(qq.y) * bfhi(w.y) + bflo(qq.z) * bflo(w.z) + bfhi(qq.z) * bfhi(w.z) + bflo(qq.w) * bflo(w.w) + bfhi(qq.w) * bfhi(w.w); }
                sc += bt[off + 64];
                const float mn = fmaxf(m, sc), f = exp2f(m - mn), pe = exp2f(sc - mn);
                l = l * f + pe; m = mn;
                const u32x4* vr = (const u32x4*)(VB + kt * AW + h * HD + hf * 32);
#pragma unroll
                for (int c = 0; c < 4; ++c) { const u32x4 w = vr[c];
                    o[8 * c] = o[8 * c] * f + pe * bflo(w.x); o[8 * c + 1] = o[8 * c + 1] * f + pe * bfhi(w.x); o[8 * c + 2] = o[8 * c + 2] * f + pe * bflo(w.y); o[8 * c + 3] = o[8 * c + 3] * f + pe * bfhi(w.y);
                    o[8 * c + 4] = o[8 * c + 4] * f + pe * bflo(w.z); o[8 * c + 5] = o[8 * c + 5] * f + pe * bfhi(w.z); o[8 * c + 6] = o[8 * c + 6] * f + pe * bflo(w.w); o[8 * c + 7] = o[8 * c + 7] * f + pe * bfhi(w.w); }
            }
        }
        const float il = 1.0f / l;
        { float sq = 0.f;
#pragma unroll
          for (int c = 0; c < 32; ++c) sq += (o[c] * il) * (o[c] * il);
          sq += __shfl_xor(sq, 1);
          if (hf == 0) SSQA[(size_t)tok * NH + h] = sq; }
        u32x4* op = (u32x4*)(MIX + (size_t)tok * D + h * HD + hf * 32);
#pragma unroll
        for (int c = 0; c < 4; ++c) { u32x4 w; w.x = pk2(o[8 * c] * il, o[8 * c + 1] * il); w.y = pk2(o[8 * c + 2] * il, o[8 * c + 3] * il); w.z = pk2(o[8 * c + 4] * il, o[8 * c + 5] * il); w.w = pk2(o[8 * c + 6] * il, o[8 * c + 7] * il); op[c] = w; }
    }
}


typedef float f32x16 __attribute__((ext_vector_type(16)));
typedef short v4i16_t __attribute__((ext_vector_type(4)));
typedef float f32x2_t __attribute__((ext_vector_type(2))); typedef __bf16 bf16x2_t __attribute__((ext_vector_type(2)));
__device__ __forceinline__ unsigned cvtpk_s(float lo, float hi) { f32x2_t v = {lo, hi}; bf16x2_t b = __builtin_convertvector(v, bf16x2_t); return __builtin_bit_cast(unsigned, b); }
constexpr int ATT_CT_BYTES = 3 * 5 * 4 * 64 * 16;
constexpr int ATT_V_OFF = ATT_CT_BYTES, ATT_V_BYTES = 4096, ATT_LDS = ATT_V_OFF + 8 * ATT_V_BYTES;
__device__ __forceinline__ void ph_attn(PG8_LAS unsigned char* lds, const bf16_t* __restrict__ QB, const bf16_t* __restrict__ KB, const bf16_t* __restrict__ VB, const float* __restrict__ bias,
                                        bf16_t* MIX, float* AM, float* AL, float* __restrict__ SSQA) {
    const int tid = tid_fresh(), lane = tid & 63, wid = __builtin_amdgcn_readfirstlane(tid >> 6), q = lane & 31, hi = lane >> 5;
    PG8_LAS unsigned char* vt = lds + ATT_V_OFF + wid * ATT_V_BYTES;
    const int vrow = lane >> 3, vch = lane & 7;
    PG8_LAS unsigned char* vwr = vt + (vch >> 2) * 2048 + vrow * 64 + (vch & 3) * 16;
    PG8_LAS unsigned char* vrd = vt + (4 * hi + ((lane & 15) >> 2)) * 64 + (16 * ((lane >> 4) & 1) + 4 * (lane & 3)) * 2;
    int last_h = -1;
    for (int it = blockIdx.x; it < NH * NSEQ * 16; it += gridDim.x) {
        const int h = it & 7, sw = it >> 3, sq_ = sw >> 4, w = sw & 15;
        if (h != last_h) {
            __syncthreads();
            for (int e = tid; e < 3 * 5 * 4 * 64 * 4; e += NTHR) {
                const int el = e & 3, ln = (e >> 2) & 63, rq = (e >> 8) & 3, tb = e >> 10, ti = tb % 5, b = tb / 5;
                const int r16 = 4 * rq + el, kv = (r16 & 3) + 8 * (r16 >> 2) + 4 * (ln >> 5), off = 32 * (ti - 2) + kv - (ln & 31);
                ((PG8_LAS float*)lds)[e] = (off >= -64 && off <= 64) ? bias[(b * NH + h) * 129 + off + 64] : -1e30f;
            }
            __syncthreads(); last_h = h;
        }
        const int p0 = w * 512; const size_t seqbase = (size_t)sq_ * SEQ;
#pragma unroll 1
        for (int b = 0; b < 3; ++b) {
            const int dsh = 2 * b, L = SEQ >> dsh;
#pragma unroll 1
            for (int tq = 0; tq < 2; ++tq) {
                const int ti = wid + 8 * tq;
                int r, m0;
                if (b == 0) { r = 0; m0 = p0 + 32 * ti; } else if (b == 1) { r = ti & 3; m0 = (p0 >> 2) + 32 * (ti >> 2); } else { r = ti; m0 = p0 >> 4; }
                const size_t qtok = seqbase + ((size_t)(m0 + q) << dsh) + r;
                bf16x8 qf[4];
#pragma unroll
                for (int s4 = 0; s4 < 4; ++s4) qf[s4] = *(const bf16x8*)(QB + qtok * AW + h * HD + 16 * s4 + 8 * hi);
                float m_run = -1e30f, l_part = 0.f; f32x16 o0, o1;
#pragma unroll
                for (int e = 0; e < 16; ++e) { o0[e] = 0.f; o1[e] = 0.f; }
                bf16x8 kf[4]; u32x4 vr[4];
#define ATT_LOADKV(KT) do { const int mk0_ = m0 + 32 * (KT); const int mkc_ = (mk0_ >= 0 && mk0_ < L) ? mk0_ : m0; \
                    const bf16_t* kp_ = KB + (seqbase + ((size_t)(mkc_ + q) << dsh) + r) * AW + h * HD + 8 * hi; \
                    _Pragma("unroll") for (int s4 = 0; s4 < 4; ++s4) kf[s4] = *(const bf16x8*)(kp_ + 16 * s4); \
                    _Pragma("unroll") for (int j4 = 0; j4 < 4; ++j4) vr[j4] = *(const u32x4*)(VB + (seqbase + ((size_t)(mkc_ + 8 * j4 + vrow) << dsh) + r) * AW + h * HD + 8 * vch); } while (0)
#pragma unroll 1
                for (int i = 0; i < 5; ++i) {
                    const int kt = (i == 0) ? 0 : ((i & 1) ? -((i + 1) >> 1) : (i >> 1));
                    const int mk0 = m0 + 32 * kt; const bool valid = (mk0 >= 0) && (mk0 < L);
                    ATT_LOADKV(kt);
                    f32x16 acc;
                    { const PG8_LAS f32x4* cp = (const PG8_LAS f32x4*)(lds + ((b * 5 + kt + 2) * 4) * 1024 + lane * 16);
#pragma unroll
                      for (int rq = 0; rq < 4; ++rq) { const f32x4 c4 = cp[rq * 64]; acc[4 * rq] = c4.x; acc[4 * rq + 1] = c4.y; acc[4 * rq + 2] = c4.z; acc[4 * rq + 3] = c4.w; } }
#pragma unroll
                    for (int s4 = 0; s4 < 4; ++s4) acc = __builtin_amdgcn_mfma_f32_32x32x16_bf16(kf[s4], qf[s4], acc, 0, 0, 0);
                    if (!valid) {
#pragma unroll
                        for (int e = 0; e < 16; ++e) acc[e] = -1e30f;
                    }
#pragma unroll
                    for (int j4 = 0; j4 < 4; ++j4) *(PG8_LAS u32x4*)(vwr + j4 * 512) = vr[j4];
                    float tm = acc[0];
#pragma unroll
                    for (int e = 1; e < 16; ++e) tm = fmaxf(tm, acc[e]);
                    tm = fmaxf(tm, __shfl_xor(tm, 32));
                    const float mn = fmaxf(m_run, tm), sc = exp2f(m_run - mn); m_run = mn;
                    float rs = 0.f;
#pragma unroll
                    for (int e = 0; e < 16; ++e) { acc[e] = exp2f(acc[e] - mn); rs += acc[e]; }
                    l_part = l_part * sc + rs;
#pragma unroll
                    for (int e = 0; e < 16; ++e) { o0[e] *= sc; o1[e] *= sc; }
                    u32x4 pw0, pw1;
                    pw0.x = cvtpk_s(acc[0], acc[1]); pw0.y = cvtpk_s(acc[2], acc[3]); pw0.z = cvtpk_s(acc[4], acc[5]); pw0.w = cvtpk_s(acc[6], acc[7]);
                    pw1.x = cvtpk_s(acc[8], acc[9]); pw1.y = cvtpk_s(acc[10], acc[11]); pw1.z = cvtpk_s(acc[12], acc[13]); pw1.w = cvtpk_s(acc[14], acc[15]);
                    const bf16x8 pb0 = __builtin_bit_cast(bf16x8, pw0), pb1 = __builtin_bit_cast(bf16x8, pw1);
                    asm volatile("s_waitcnt lgkmcnt(0)" ::: "memory");
#define ATT_VTR(off) __builtin_amdgcn_ds_read_tr16_b64_v4i16((PG8_LAS v4i16_t*)(vrd + (off)))
#define ATT_VF(lo4, hi4) (bf16x8){lo4[0], lo4[1], lo4[2], lo4[3], hi4[0], hi4[1], hi4[2], hi4[3]}
                    { const v4i16_t a0 = ATT_VTR(0), a1 = ATT_VTR(512), a2 = ATT_VTR(1024), a3 = ATT_VTR(1536);
                      const v4i16_t c0 = ATT_VTR(2048), c1 = ATT_VTR(2048 + 512), c2 = ATT_VTR(2048 + 1024), c3 = ATT_VTR(2048 + 1536);
                      o0 = __builtin_amdgcn_mfma_f32_32x32x16_bf16(ATT_VF(a0, a1), pb0, o0, 0, 0, 0);
                      o0 = __builtin_amdgcn_mfma_f32_32x32x16_bf16(ATT_VF(a2, a3), pb1, o0, 0, 0, 0);
                      o1 = __builtin_amdgcn_mfma_f32_32x32x16_bf16(ATT_VF(c0, c1), pb0, o1, 0, 0, 0);
                      o1 = __builtin_amdgcn_mfma_f32_32x32x16_bf16(ATT_VF(c2, c3), pb1, o1, 0, 0, 0); }
                    asm volatile("s_waitcnt lgkmcnt(0)" ::: "memory");
                }
                const float l_b = l_part + __shfl_xor(l_part, 32);
                float fa = 0.f, fc, mm = m_run, ln = l_b;
                if (b > 0) { const float pm = AM[qtok * NH + h], pl = AL[qtok * NH + h]; mm = fmaxf(pm, m_run); fa = pl * exp2f(pm - mm); fc = exp2f(m_run - mm); ln = fa + l_b * fc; }
                else fc = 1.f;
                const float inv = 1.0f / ln; fa *= inv; fc *= inv;
                bf16_t* op = MIX + qtok * D + h * HD + 4 * hi;
                float ssq = 0.f;
#pragma unroll
                for (int dt = 0; dt < 2; ++dt)
#pragma unroll
                    for (int rq = 0; rq < 4; ++rq) {
                        f32x4 v;
                        if (dt == 0) v = (f32x4){o0[4 * rq], o0[4 * rq + 1], o0[4 * rq + 2], o0[4 * rq + 3]}; else v = (f32x4){o1[4 * rq], o1[4 * rq + 1], o1[4 * rq + 2], o1[4 * rq + 3]};
                        v = v * fc;
                        bf16_t* pp_ = op + 32 * dt + 8 * rq;
                        if (b > 0) { const u32x2 pw = *(const u32x2*)pp_; v = v + (f32x4){bflo(pw.x), bfhi(pw.x), bflo(pw.y), bfhi(pw.y)} * fa; }
                        ssq += sumsq4(v);
                        u32x2 w2; w2.x = cvtpk_s(v.x, v.y); w2.y = cvtpk_s(v.z, v.w); *(u32x2*)pp_ = w2;
                    }
                if (b < 2) { if (hi == 0) { AM[qtok * NH + h] = mm; AL[qtok * NH + h] = ln; } }
                else { ssq += __shfl_xor(ssq, 32); if (hi == 0) SSQA[qtok * NH + h] = ssq; }
            }
            __syncthreads();
        }
    }
#undef ATT_LOADKV
#undef ATT_VTR
#undef ATT_VF
}

__device__ __forceinline__ void ph_scan(const bf16_t* __restrict__ SB, const float* __restrict__ PW, bf16_t* __restrict__ UH) {
    for (size_t ii = GTID; ii < (size_t)NSEQ * NG * 2 * NS; ii += GSIZE) {
        const int i = (int)ii;
        const int n = i % NS, dir = (i / NS) % 2, g = (i / (2 * NS)) % NG, s = i / (2 * NS * NG);
        const float* pw = PW + ((size_t)((g * 2 + dir) * NS + n) * 17 + 16) * 2;
        const float ar = pw[0], ai = pw[1];
        float hr = 0.f, hi = 0.f;
        const size_t base = (size_t)g * NCHT + (size_t)s * NCHS; const int colo = dir * 128 + 2 * n;
        for (int t = 0; t < NCHS; ++t) {
            const int c = dir == 0 ? t : NCHS - 1 - t;
            *(unsigned*)(UH + (base + c) * 512 + 256 + colo) = pk2(hr, hi);
            const unsigned w = *(const unsigned*)(SB + (base + c) * 256 + colo);
            const float sr = bflo(w), si = bfhi(w);
            const float nr = ar * hr - ai * hi + sr, ni = ar * hi + ai * hr + si;
            hr = nr; hi = ni;
        }
    }
}


constexpr int LDS_BYTES = 147456;
struct Args { const float* in[27]; float* out; unsigned char* ws; };
template <class Epi>
__device__ __forceinline__ void run_gemm(PG8_LAS unsigned char* lds, const bf16_t* A, int lda, const bf16_t* Bt, int ldb, int M, int N, int K, int khb, int split, int bdiv, const Epi& E) {
    pg8::Gemm g{A, Bt, lda, ldb, K, khb}; pg8::Order S; S.init(M, N, (int)gridDim.x, (int)blockIdx.x, split, bdiv);
    pg8::gemm_phase<Epi, pg8::Order, true, true>(lds, g, S, E);
}
__global__ void __launch_bounds__(NTHR, 2) mega(Args a) {
    extern __shared__ __attribute__((aligned(16))) unsigned char lds_raw[];
    PG8_LAS unsigned char* lds = (PG8_LAS unsigned char*)lds_raw;
    cg::grid_group grid = cg::this_grid();
    const float *xp = a.in[0], *xs = a.in[1], *pp = a.in[2], *ps = a.in[3], *rel_bias = a.in[4], *g_mix = a.in[5], *w_in = a.in[6];
    const float *a_re = a.in[7], *a_im = a.in[8], *log_dt = a.in[9], *b_re = a.in[10], *b_im = a.in[11], *c_re = a.in[12], *c_im = a.in[13], *ssm_d = a.in[14];
    const float *w_glu = a.in[15], *b_glu = a.in[16], *g_att = a.in[17], *g_ssm = a.in[18], *w_out = a.in[19], *g_mlp = a.in[20], *w_mlp1 = a.in[21], *w_mlp2 = a.in[22];
    const float *g_ple = a.in[23], *w_gate = a.in[24], *w_proj = a.in[25], *g_final = a.in[26];
    unsigned char* ws = a.ws; unsigned char* dob = (unsigned char*)a.out;
    float* BIAS = (float*)(ws + WS_BIAS); float* PW = (float*)(ws + WS_PW); float* BBt = (float*)(ws + WS_BB);
    float *RS0 = (float*)(ws + WS_RS0), *SSQA = (float*)(ws + WS_SSQA), *SSQS = (float*)(ws + WS_SSQS), *SSQ1 = (float*)(ws + WS_SSQ1), *SSQ2 = (float*)(ws + WS_SSQ2);
    bf16_t *W1T = (bf16_t*)(ws + WS_W1T), *W2T = (bf16_t*)(ws + WS_W2T), *WGT = (bf16_t*)(ws + WS_WGT), *WPT = (bf16_t*)(ws + WS_WPT), *PB = (bf16_t*)(ws + WS_PB);
    bf16_t *WINT = (bf16_t*)(ws + WS_WINT), *WOUTT = (bf16_t*)(ws + WS_WOUTT), *WGLUT = (bf16_t*)(ws + WS_WGLUT), *WST = (bf16_t*)(ws + WS_WST), *WYT = (bf16_t*)(ws + WS_WYT);
    bf16_t *SB = (bf16_t*)(ws + WS_SB), *QB = (bf16_t*)(ws + WS_QB), *KB = (bf16_t*)(ws + WS_KB), *VB = (bf16_t*)(ws + WS_VB), *UH = (bf16_t*)(ws + WS_UH);
    bf16_t *MIX = (bf16_t*)(ws + WS_MIX), *GB = (bf16_t*)(ws + WS_GB), *HID = (bf16_t*)(ws + WS_HID), *PP = (bf16_t*)(ws + WS_PP);
    float* H3F = (float*)(ws + WS_H3F);
    bf16_t *XB = (bf16_t*)(dob + DO_XB), *H1B = (bf16_t*)(dob + DO_H1B), *H2B = (bf16_t*)(dob + DO_H2B);
    ph_prep_wt(w_in, D, INC, g_mix, WINT, D, AW, C2);
    ph_prep_wt(w_glu, SW, SW, nullptr, WGLUT, SW, 0, 1.f);
    ph_prep_wout(w_out, g_att, g_ssm, WOUTT);
    ph_prep_wt(w_mlp1, D, DFF, g_mlp, W1T, D, 0, 1.f);
    ph_prep_wt(w_mlp2, DFF, D, nullptr, W2T, DFF, 0, 1.f);
    ph_prep_wt(w_gate, D, D, g_ple, WGT, D, 0, 1.f);
    ph_prep_wt(w_proj, PLE, D, nullptr, WPT, PLE, 0, 1.f);
    ph_prep_bias(rel_bias, BIAS);
    ph_ssm_tab(a_re, a_im, log_dt, b_re, b_im, PW, BBt);
    ph_rows_x(xp, xs, XB, RS0);
    ph_cvt_p(pp, ps, PB);
    grid.sync();
    ph_ssm_ws(PW, BBt, WST);
    ph_ssm_wy(PW, BBt, c_re, c_im, ssm_d, WYT);
#if !defined(ONLY) || ONLY == 0
    run_gemm(lds, XB, D, WINT, D, NT, INC, D, 0, 0, 0, EpiIn{RS0, QB, KB, VB, UH});
#endif
    grid.sync();
#ifdef NAIVE_ATTN
    ph_attn_naive(QB, KB, VB, BIAS, MIX, SSQA);
#else
    ph_attn(lds, QB, KB, VB, BIAS, MIX, (float*)(ws + WS_AM), (float*)(ws + WS_AL), SSQA);
#endif
#if !defined(ONLY) || ONLY == 1
    run_gemm(lds, UH, 512, WST, 256, NG * NCHT, 256, 256, 0, 0, NCHT / 256, EpiS{SB});
#endif
    grid.sync();
    ph_scan(SB, PW, UH);
    grid.sync();
#if !defined(ONLY) || ONLY == 2
    run_gemm(lds, UH, 512, WYT, 512, NG * NCHT, 256, 512, 0, 0, NCHT / 256, EpiY{GB});
#endif
    grid.sync();
#if !defined(ONLY) || ONLY == 3
    run_gemm(lds, GB, SW, WGLUT, SW, NT, SW, SW, 0, 0, 0, EpiGlu{GB, b_glu, MIX, SSQS});
#endif
    grid.sync();
#if !defined(ONLY) || ONLY == 4
    run_gemm(lds, MIX, D, WOUTT, D, NT, D, AW, AW * 2, 1, 0, EpiOut{xp, xs, SSQA, SSQS, H1B, SSQ1});
#endif
    grid.sync();
#if !defined(ONLY) || ONLY == 5
    run_gemm(lds, H1B, D, W1T, D, NT, DFF, D, 0, 0, 0, EpiMlp1{SSQ1, HID});
#endif
    grid.sync();
#if !defined(ONLY) || ONLY == 6
    run_gemm(lds, HID, DFF, W2T, DFF, NT, D, DFF, 0, 0, 0, EpiMlp2{H1B, H2B, SSQ2});
#endif
    grid.sync();
#if !defined(ONLY) || ONLY == 7
    run_gemm(lds, PB, PLE, WPT, PLE, NT, D, PLE, 0, 0, 0, EpiPP{PP});
#endif
    grid.sync();
#if !defined(ONLY) || ONLY == 8
    run_gemm(lds, H2B, D, WGT, D, NT, D, D, 0, 0, 0, EpiGate{SSQ2, H2B, PP, H3F});
#endif
    grid.sync();
    ph_final(H3F, g_final, a.out);
}

extern "C" void kernel_launch(void* const* d_in, const int* in_sizes, int n_in, void* d_out, int out_size, void* d_ws, size_t ws_size, hipStream_t stream) {
    static int grid_blocks = 0;
    if (n_in != 27 || ws_size < WS_END || out_size != NT * D) { fprintf(stderr, "kernel_launch: unexpected sizes n_in %d ws %zu out %d\n", n_in, ws_size, out_size); return; }
    if (!grid_blocks) {
        int dev = 0, cus = 0, per_cu = 0;
        (void)hipGetDevice(&dev);
        (void)hipDeviceGetAttribute(&cus, hipDeviceAttributeMultiprocessorCount, dev);
        if (hipFuncSetAttribute((const void*)mega, hipFuncAttributeMaxDynamicSharedMemorySize, LDS_BYTES) != hipSuccess) { fprintf(stderr, "kernel_launch: hipFuncSetAttribute failed\n"); return; }
        (void)hipOccupancyMaxActiveBlocksPerMultiprocessor(&per_cu, mega, NTHR, LDS_BYTES);
        if (per_cu < 1) { fprintf(stderr, "kernel_launch: occupancy query says %d blocks per CU\n", per_cu); return; }
        grid_blocks = cus;
    }
    Args a{};
    for (int i = 0; i < 27; ++i) a.in[i] = (const float*)d_in[i];
    a.out = (float*)d_out; a.ws = (unsigned char*)d_ws;
    void* args[] = {&a};
    hipError_t e = hipLaunchCooperativeKernel((void*)mega, dim3(grid_blocks), dim3(NTHR), args, LDS_BYTES, stream);
    if (e != hipSuccess) fprintf(stderr, "cooperative launch failed: %s (grid %d)\n", hipGetErrorString(e), grid_blocks);
}
```

```cpp
#include <hip/hip_runtime.h>
#include <hip/hip_cooperative_groups.h>
namespace cg = cooperative_groups;
#include <cstdio>
#include <cstdint>
#include <cmath>

typedef unsigned short bf16_t;
typedef short bf16x8 __attribute__((ext_vector_type(8)));
typedef float f32x4 __attribute__((ext_vector_type(4)));
typedef unsigned u32x2 __attribute__((ext_vector_type(2)));
typedef unsigned u32x4 __attribute__((ext_vector_type(4)));

constexpr int NT = 49152, SEQ = 8192, NSEQ = 6, NPROMPT = 16384;
constexpr int D = 1024, DFF = 4096, PLE = 256, INC = 2048, AW = 512, SW = 512;
constexpr int NH = 8, HD = 64, NG = 32, GC = 16, NS = 64;
constexpr int TCH = 16, NCHT = NT / TCH  , NCHS = SEQ / TCH  ;
constexpr float EPS = 1e-6f;
constexpr float LOG2E = 1.4426950408889634f;
constexpr float C2 = 0.125f * LOG2E;

constexpr size_t MiB = 1u << 20;
constexpr size_t WS_BIAS = 0;
constexpr size_t WS_PW = 64 * 1024;
constexpr size_t WS_BB = 1 * MiB;
constexpr size_t WS_KT = 1536 * 1024;
constexpr size_t WS_RS0 = 2560 * 1024;
constexpr size_t WS_SSQA = 3 * MiB;
constexpr size_t WS_SSQS = 4608 * 1024;
constexpr size_t WS_SSQ1 = 6 * MiB;
constexpr size_t WS_SSQ2 = 9 * MiB;
constexpr size_t WS_SSQ3 = 12 * MiB;
constexpr size_t WS_AM = 15 * MiB;
constexpr size_t WS_AL = WS_AM + 1536 * 1024;
constexpr size_t WS_WGT = 18 * MiB, WS_WPT = 20 * MiB;
constexpr size_t WS_CTL = 20 * MiB + 512 * 1024;
constexpr size_t WS_HB = 32 * MiB;
constexpr size_t WS_QB = 128 * MiB, WS_KB = 176 * MiB, WS_VB = 224 * MiB;
constexpr size_t WS_UH = 272 * MiB;
constexpr size_t WS_MIX = 368 * MiB;
constexpr size_t WS_GB = 464 * MiB;
constexpr size_t WS_HID = 128 * MiB;
constexpr size_t WS_PP = 128 * MiB;
constexpr size_t WS_H3F = 224 * MiB;
constexpr size_t WS_END = 512 * MiB;
static_assert(WS_KB - WS_QB == (size_t)NT * AW * 2 && WS_VB - WS_KB == (size_t)NT * AW * 2, "QB | KB | VB contiguous");
constexpr size_t DO_XB = 0, DO_SB = 0;
constexpr size_t DO_W1T = 96 * MiB, DO_W2T = 104 * MiB, DO_WINT = 112 * MiB, DO_WOUTT = 116 * MiB, DO_WGLUT = 118 * MiB, DO_WST = 119 * MiB, DO_WYT = 123 * MiB, DO_PB = 131 * MiB;

__device__ __forceinline__ unsigned f2bf(float f) { unsigned u = __builtin_bit_cast(unsigned, f); return (u + 0x7fffu + ((u >> 16) & 1u)) >> 16; }
__device__ __forceinline__ unsigned pk2(float lo, float hi) { return f2bf(lo) | (f2bf(hi) << 16); }
__device__ __forceinline__ float bf2f(unsigned short b) { return __builtin_bit_cast(float, (unsigned)b << 16); }
__device__ __forceinline__ float bflo(unsigned w) { return __builtin_bit_cast(float, w << 16); }
__device__ __forceinline__ float bfhi(unsigned w) { return __builtin_bit_cast(float, w & 0xffff0000u); }
__device__ __forceinline__ float wave_sum(float v) {
#pragma unroll
    for (int o = 1; o < 64; o <<= 1) v += __shfl_xor(v, o);
    return v;
}
__device__ __forceinline__ const float* xrow(const float* xp, const float* xs, int tok, int width) {
    return tok < NPROMPT ? xp + (size_t)tok * width : xs + (size_t)(tok - NPROMPT) * width;
}


constexpr int NTHR = 512;
#define PG8_LAS __attribute__((address_space(3)))
__device__ __forceinline__ int tid_fresh() { int t = threadIdx.x; asm volatile("" : "+v"(t)); return t; }
__device__ __forceinline__ size_t gtid_fresh() { return (size_t)blockIdx.x * NTHR + tid_fresh(); }
#define GTID gtid_fresh()
#define GSIZE ((size_t)gridDim.x * NTHR)

__device__ __forceinline__ void ph_prep_wt(PG8_LAS unsigned char* lds, const float* __restrict__ W, int K, int N, const float* __restrict__ g1, const float* __restrict__ g2, int ksplit,
                                           bf16_t* __restrict__ out, int ldo, int nscale, float sc) {
    const int tid = tid_fresh(), lane = tid & 63, wave = tid >> 6;
    PG8_LAS float* scr = (PG8_LAS float*)(lds + wave * 8448);
    const int nblk = N / 32, nitems = (K / 64) * nblk;
    for (int item = blockIdx.x * 8 + wave; item < nitems; item += gridDim.x * 8) {
        const int kb = item / nblk, nb = item % nblk, k0 = 64 * kb, n0 = 32 * nb;
#pragma unroll 8
        for (int i = 0; i < 32; ++i) { const int kk = 2 * i + (lane >> 5), k = k0 + kk; float gv = 1.f; if (g1) { const float* gp = (k < ksplit) ? (g1 + k) : (g2 + (k - ksplit)); gv = *gp; }
            scr[kk * 33 + (lane & 31)] = W[(size_t)k * N + n0 + (lane & 31)] * gv; }
        asm volatile("s_waitcnt lgkmcnt(0)" ::: "memory");
        const int c = lane & 7;
#pragma unroll
        for (int j = 0; j < 4; ++j) { const int n = (lane >> 3) + 8 * j; const PG8_LAS float* sp = scr + (8 * c) * 33 + n; const float cs = (n0 + n) < nscale ? sc : 1.f;
            u32x4 o; o.x = pk2(sp[0 * 33] * cs, sp[1 * 33] * cs); o.y = pk2(sp[2 * 33] * cs, sp[3 * 33] * cs); o.z = pk2(sp[4 * 33] * cs, sp[5 * 33] * cs); o.w = pk2(sp[6 * 33] * cs, sp[7 * 33] * cs);
            *(u32x4*)(out + (size_t)(n0 + n) * ldo + k0 + 8 * c) = o; }
        asm volatile("s_waitcnt lgkmcnt(0)" ::: "memory");
    }
}
__device__ __forceinline__ int t5_bucket(int rel) {
    int n = -rel; int ret = n < 0 ? 16 : 0; n = n < 0 ? -n : n;
    if (n < 8) return ret + n;
    int large = 8 + (int)(log((double)n / 8.0) / log(128.0) * 8.0);
    large = large < 15 ? large : 15;
    return ret + large;
}
__device__ __forceinline__ void ph_prep_bias(const float* __restrict__ rel_bias, float* __restrict__ bias) {
    for (size_t i = GTID; i < 3 * 8 * 129; i += GSIZE) {
        const int o = (int)(i % 129), h = (int)((i / 129) % 8), b = (int)(i / (129 * 8));
        const int dil = b == 0 ? 1 : (b == 1 ? 4 : 16);
        bias[i] = rel_bias[t5_bucket((o - 64) * dil) * NH + h] * LOG2E;
    }
}
__device__ __forceinline__ void ph_rows_x(const float* __restrict__ xp, const float* __restrict__ xs, bf16_t* __restrict__ XB, float* __restrict__ RS0) {
    const int tidf = tid_fresh(), lane = tidf & 63;
    for (int row = blockIdx.x * 8 + (tidf >> 6); row < NT; row += gridDim.x * 8) {
        const f32x4* xr = (const f32x4*)xrow(xp, xs, row, D) + lane;
        float s = 0.f; f32x4 v[4];
#pragma unroll
        for (int j = 0; j < 4; ++j) { v[j] = xr[64 * j]; s += v[j].x * v[j].x + v[j].y * v[j].y + v[j].z * v[j].z + v[j].w * v[j].w; }
        s = wave_sum(s);
        u32x2* o = (u32x2*)(XB + (size_t)row * D) + lane;
#pragma unroll
        for (int j = 0; j < 4; ++j) { u32x2 w; w.x = pk2(v[j].x, v[j].y); w.y = pk2(v[j].z, v[j].w); o[64 * j] = w; }
        if (lane == 0) RS0[row] = 1.0f / sqrtf(s * (1.0f / D) + EPS);
    }
}
__device__ __forceinline__ void ph_cvt_p(const float* __restrict__ pp, const float* __restrict__ ps, bf16_t* __restrict__ PB) {
    for (size_t i = GTID; i < (size_t)NT * PLE / 4; i += GSIZE) {
        const int tok = (int)(i / (PLE / 4)), c4 = (int)(i % (PLE / 4));
        const f32x4 v = *((const f32x4*)xrow(pp, ps, tok, PLE) + c4);
        u32x2 w; w.x = pk2(v.x, v.y); w.y = pk2(v.z, v.w);
        *((u32x2*)(PB + (size_t)tok * PLE) + c4) = w;
    }
}
__device__ __forceinline__ void ph_ssm_tab(const float* __restrict__ a_re, const float* __restrict__ a_im, const float* __restrict__ log_dt,
                          const float* __restrict__ b_re, const float* __restrict__ b_im, float* __restrict__ PW, float* __restrict__ BB) {
    for (size_t ii = GTID; ii < NG * 2 * NS; ii += GSIZE) {
        const int i = (int)ii;
        const int n = i % NS, dir = (i / NS) % 2, g = i / (2 * NS);
        const int pi = (dir * NG + g) * NS + n;
        const double ar = a_re[pi], ai = a_im[pi], dt = exp((double)log_dt[dir * NG + g]);
        float* pw = PW + (size_t)((g * 2 + dir) * NS + n) * 17 * 2;
        for (int e = 0; e <= 16; ++e) { const double mag = exp(ar * dt * e), ang = ai * dt * e; pw[2 * e] = (float)(mag * cos(ang)); pw[2 * e + 1] = (float)(mag * sin(ang)); }
        const double abr = exp(ar * dt) * cos(ai * dt), abi = exp(ar * dt) * sin(ai * dt), inv = 1.0 / (ar * ar + ai * ai);
        const double fr = ((abr - 1.0) * ar + abi * ai) * inv, fi = (abi * ar - (abr - 1.0) * ai) * inv;
        float* bb = BB + (size_t)((g * 2 + dir) * NS + n) * GC * 2;
        for (int h = 0; h < GC; ++h) { const double br = b_re[(size_t)pi * GC + h], bi = b_im[(size_t)pi * GC + h]; bb[2 * h] = (float)(fr * br - fi * bi); bb[2 * h + 1] = (float)(fr * bi + fi * br); }
    }
}
__device__ __forceinline__ void ph_ssm_kt(const float* __restrict__ PW, const float* __restrict__ BB, const float* __restrict__ c_re, const float* __restrict__ c_im, float* __restrict__ KT) {
    for (size_t ii = GTID; ii < (size_t)NG * 2 * 16 * GC; ii += GSIZE) {
        const int i = (int)ii, h = i % GC, e = (i / GC) % 16, dir = (i / (GC * 16)) % 2, g = i / (GC * 16 * 2);
        float acc[GC];
#pragma unroll
        for (int hp = 0; hp < GC; ++hp) acc[hp] = 0.f;
        for (int n = 0; n < NS; ++n) {
            const float* pw = PW + ((size_t)((g * 2 + dir) * NS + n) * 17 + e) * 2; const size_t ci = ((size_t)(dir * NG + g) * GC + h) * NS + n;
            const float cr = c_re[ci], cim = c_im[ci], tr = cr * pw[0] - cim * pw[1], ti = cr * pw[1] + cim * pw[0];
            const f32x4* bb = (const f32x4*)(BB + (size_t)((g * 2 + dir) * NS + n) * GC * 2);
#pragma unroll
            for (int q4 = 0; q4 < 8; ++q4) { const f32x4 b4 = bb[q4]; acc[2 * q4] += tr * b4.x - ti * b4.y; acc[2 * q4 + 1] += tr * b4.z - ti * b4.w; }
        }
        f32x4* o = (f32x4*)(KT + (size_t)i * GC);
#pragma unroll
        for (int q4 = 0; q4 < 4; ++q4) o[q4] = (f32x4){acc[4 * q4], acc[4 * q4 + 1], acc[4 * q4 + 2], acc[4 * q4 + 3]};
    }
}
__device__ __forceinline__ void ph_ssm_ws(const float* __restrict__ PW, const float* __restrict__ BB, bf16_t* __restrict__ WST) {
    for (size_t ii = GTID; ii < (size_t)NG * 256 * 32; ii += GSIZE) {
        const int i = (int)ii, ko = i % 32, col = (i / 32) % 256, g = i / 8192;
        const int j = ko >> 1, hp0 = (ko & 1) * 8, dir = col / 128, n = (col % 128) / 2, ri = col & 1;
        const int e = dir == 0 ? 15 - j : j;
        const float* pw = PW + ((size_t)((g * 2 + dir) * NS + n) * 17 + e) * 2; const float* bb = BB + ((size_t)((g * 2 + dir) * NS + n) * GC + hp0) * 2;
        const float pr = pw[0], pi = pw[1]; float v[8];
#pragma unroll
        for (int t = 0; t < 8; ++t) v[t] = ri ? (pr * bb[2 * t + 1] + pi * bb[2 * t]) : (pr * bb[2 * t] - pi * bb[2 * t + 1]);
        u32x4 o; o.x = pk2(v[0], v[1]); o.y = pk2(v[2], v[3]); o.z = pk2(v[4], v[5]); o.w = pk2(v[6], v[7]);
        *(u32x4*)(WST + (size_t)(g * 256 + col) * 256 + ko * 8) = o;
    }
}
__device__ __forceinline__ void ph_ssm_wy_carry(const float* __restrict__ PW, const float* __restrict__ c_re, const float* __restrict__ c_im, bf16_t* __restrict__ WYT) {
    for (size_t ii = GTID; ii < (size_t)NG * 256 * 32; ii += GSIZE) {
        const int i = (int)ii, ko = i % 32, jh = (i / 32) % 256, g = i / 8192;
        const int j = jh / 16, h = jh % 16, dir = ko / 16, n0 = (ko % 16) * 4;
        const int e = dir == 0 ? j + 1 : 16 - j; float v[8];
#pragma unroll
        for (int t = 0; t < 4; ++t) { const int n = n0 + t; const float* pw = PW + ((size_t)((g * 2 + dir) * NS + n) * 17 + e) * 2; const size_t ci = ((size_t)(dir * NG + g) * GC + h) * NS + n;
            const float cr = c_re[ci], cim = c_im[ci]; v[2 * t] = cr * pw[0] - cim * pw[1]; v[2 * t + 1] = -(cr * pw[1] + cim * pw[0]); }
        u32x4 o; o.x = pk2(v[0], v[1]); o.y = pk2(v[2], v[3]); o.z = pk2(v[4], v[5]); o.w = pk2(v[6], v[7]);
        *(u32x4*)(WYT + (size_t)(g * 256 + jh) * 512 + 256 + ko * 8) = o;
    }
}
__device__ __forceinline__ void ph_ssm_wy_fill(const float* __restrict__ KT, const float* __restrict__ dd, bf16_t* __restrict__ WYT) {
    for (size_t ii = GTID; ii < (size_t)NG * 256 * 32; ii += GSIZE) {
        const int i = (int)ii, ko = i % 32, jh = (i / 32) % 256, g = i / 8192;
        const int j = jh / 16, h = jh % 16, jp = ko >> 1, hp0 = (ko & 1) * 8;
        float v[8];
#pragma unroll
        for (int t = 0; t < 8; ++t) v[t] = 0.f;
        if (j >= jp) { const float* kt = KT + ((size_t)((g * 2 + 0) * 16 + (j - jp)) * GC + h) * GC + hp0;
#pragma unroll
            for (int t = 0; t < 8; ++t) v[t] += kt[t]; }
        if (jp >= j) { const float* kt = KT + ((size_t)((g * 2 + 1) * 16 + (jp - j)) * GC + h) * GC + hp0;
#pragma unroll
            for (int t = 0; t < 8; ++t) v[t] += kt[t]; }
        if (jp == j) { const float dv = dd[g * GC + h];
#pragma unroll
            for (int t = 0; t < 8; ++t) if (hp0 + t == h) v[t] += dv; }
        u32x4 o; o.x = pk2(v[0], v[1]); o.y = pk2(v[2], v[3]); o.z = pk2(v[4], v[5]); o.w = pk2(v[6], v[7]);
        *(u32x4*)(WYT + (size_t)(g * 256 + jh) * 512 + ko * 8) = o;
    }
}

__device__ __forceinline__ void st_bf4(bf16_t* p, f32x4 v) { u32x2 w; w.x = pk2(v.x, v.y); w.y = pk2(v.z, v.w); *(u32x2*)p = w; }
__device__ __forceinline__ f32x4 ld_bf4(const bf16_t* p) { const u32x2 w = *(const u32x2*)p; return (f32x4){bflo(w.x), bfhi(w.x), bflo(w.y), bfhi(w.y)}; }
namespace pg8 {
constexpr int BM = 256, BK = 64, HALF = 128, HTB = HALF * BK * 2  , STAGE_BYTES = 8 * HTB, NXCD = 8, WGM = 8;

__host__ __device__ __forceinline__ int lds_byte(int r, int c) { const int st = (r >> 4) * 2 + (c >> 5), rr = r & 15, cc = c & 31, ob = rr * 64 + cc * 2; return st * 1024 + (ob ^ (((ob >> 9) & 1) << 5)); }
__host__ __device__ __forceinline__ void stage_rc(int b, int& R, int& C) { const int st = b / 1024, sb = b % 1024, swz = sb ^ (((sb >> 9) & 1) << 5); R = (st >> 1) * 16 + swz / 64; C = (st & 1) * 32 + (swz % 64) / 2; }
__host__ __device__ __forceinline__ int perm32(int rho) { const int n = rho >> 4, i = rho & 15; return 8 * (i >> 2) + 4 * n + (i & 3); }
struct Unit { int pm, pn, kh; };
struct Gemm { const bf16_t* A; const bf16_t* Bt; int lda, ldb, K, khb; };
struct Order {
    int nM, nN, nwg, G, c, split, bdiv;
    __device__ void init(int M, int N, int G_, int c_, int split_ = 0, int bdiv_ = 0) { nM = M / BM; nN = N / BM; nwg = nM * nN; G = G_; c = c_; split = split_; bdiv = bdiv_; }
    __device__ bool next(int i, Unit& u) const {
        const int ti = split ? (i >> 1) : i;
        const long L = (long)ti * G + c; if (L >= nwg) return false;
        int wgid = (int)L; { const int q = nwg / NXCD, r = nwg % NXCD, xcd = wgid % NXCD, off = wgid / NXCD; wgid = (xcd < r ? xcd * (q + 1) : r * (q + 1) + (xcd - r) * q) + off; }
        const int nig = WGM * nN, gid = wgid / nig, fm = gid * WGM, gsz = (nM - fm) < WGM ? (nM - fm) : WGM;
        u.pm = fm + ((wgid % nig) % gsz); u.pn = (wgid % nig) / gsz; u.kh = split ? (i & 1) : 0;
        if (bdiv) u.pn = u.pm / bdiv;
        return true;
    }
    __device__ __forceinline__ void a_ready(const Unit&) const {}
    __device__ __forceinline__ void done(const Unit&) const {}
};
__device__ __forceinline__ unsigned cvt_pk_bf16(float lo, float hi) { unsigned r; asm volatile("v_cvt_pk_bf16_f32 %0, %1, %2" : "=v"(r) : "v"(lo), "v"(hi)); return r; }
template <class Epi, class Sched, bool ALIGN_EPI = false, bool SP2 = false>
__device__ __forceinline__ void gemm_phase(PG8_LAS unsigned char* lds, const Gemm g, const Sched& S, const Epi& E) {
    const int tid = tid_fresh(), wid = __builtin_amdgcn_readfirstlane(tid >> 6), lane = tid & 63, wr = wid >> 2, wc = wid & 3, fr = lane & 15, fq = lane >> 4;
    const int K = g.K, nt = K / BK;
    unsigned voffA[2], voffB[2];
#pragma unroll
    for (int i = 0; i < 2; ++i) { int R, C; stage_rc(tid * 16 + i * 8192, R, C); const int Rb = Epi::PERM ? ((R & ~31) + perm32(R & 31)) : R;
        voffA[i] = (unsigned)(R * g.lda + C) * 2u; voffB[i] = (unsigned)(Rb * g.ldb + C) * 2u; }
    const size_t kstep = (size_t)(BK * 2);
    const size_t hstepA = (size_t)HALF * g.lda * 2, hstepB = (size_t)HALF * g.ldb * 2;
    const size_t tstepA = 2 * hstepA, tstepB = 2 * hstepB;
    const unsigned ldsw = (unsigned)wid * 1024u;
    const int aoff = lds_byte(wr * 64 + fr, fq * 8), boff = lds_byte(wc * 32 + fr, fq * 8);
#define PG8_SA(b, h) (((b) * 2 + (h)) * HTB)
#define PG8_SB(b, h) ((4 + (b) * 2 + (h)) * HTB)
#define PG8_STAGE(bufoff, gbase, voff) do { _Pragma("unroll") for (int _i = 0; _i < 2; ++_i) \
        __builtin_amdgcn_global_load_lds((const unsigned*)((const char*)(gbase) + (voff)[_i]), (PG8_LAS unsigned*)(lds + (bufoff) + ldsw + _i * 8192), 16, 0, 0); } while (0)
#define PG8_LDA(dst, b, h) do { _Pragma("unroll") for (int m = 0; m < 4; ++m) _Pragma("unroll") for (int k = 0; k < 2; ++k) dst[m][k] = *(const PG8_LAS bf16x8*)(lds + PG8_SA(b, h) + aoff + m * 2048 + k * 1024); } while (0)
#define PG8_LDB(dst, b, h) do { _Pragma("unroll") for (int n = 0; n < 2; ++n) _Pragma("unroll") for (int k = 0; k < 2; ++k) dst[n][k] = *(const PG8_LAS bf16x8*)(lds + PG8_SB(b, h) + boff + n * 2048 + k * 1024); } while (0)
#define PG8_MMA(ai, bj, At, Bt) do { __builtin_amdgcn_s_setprio(1); _Pragma("unroll") for (int m = 0; m < 4; ++m) _Pragma("unroll") for (int n = 0; n < 2; ++n) _Pragma("unroll") for (int k = 0; k < 2; ++k) \
        acc[ai][bj][m][n] = __builtin_amdgcn_mfma_f32_16x16x32_bf16(Bt[n][k], At[m][k], acc[ai][bj][m][n], 0, 0, 0); __builtin_amdgcn_s_setprio(0); } while (0)
#define PG8_WAIT_V(n) asm volatile("s_waitcnt vmcnt(" #n ")" ::: "memory")
#define PG8_WAIT_L(n) asm volatile("s_waitcnt lgkmcnt(" #n ")" ::: "memory")
#define PG8_BAR __builtin_amdgcn_s_barrier()
#define PG8_SCHED __builtin_amdgcn_sched_barrier(0)
    Unit cur, nxt; int ui = 0;
    if (!S.next(0, cur)) return;
    f32x4 acc[2][2][4][2];
#pragma unroll
    for (int a = 0; a < 2; ++a)
#pragma unroll
        for (int b = 0; b < 2; ++b)
#pragma unroll
            for (int m = 0; m < 4; ++m)
#pragma unroll
                for (int n = 0; n < 2; ++n) acc[a][b][m][n] = (f32x4){0.f, 0.f, 0.f, 0.f};
    bf16x8 At[4][2], B0[2][2], B1[2][2];
    const char* cA = (const char*)g.A + (size_t)cur.pm * tstepA + (size_t)cur.kh * g.khb; const char* cB = (const char*)g.Bt + (size_t)cur.pn * tstepB + (size_t)cur.kh * g.khb;
    S.a_ready(cur);
    if constexpr (SP2) {
        PG8_STAGE(PG8_SB(0, 0), cB, voffB); PG8_STAGE(PG8_SB(0, 1), cB + hstepB, voffB); PG8_STAGE(PG8_SA(0, 0), cA, voffA); PG8_STAGE(PG8_SA(0, 1), cA + hstepA, voffA);
        if (wr == 1) PG8_BAR;
        PG8_WAIT_V(2); PG8_BAR;
        PG8_STAGE(PG8_SB(1, 0), cB + kstep, voffB); PG8_STAGE(PG8_SA(1, 0), cA + kstep, voffA); PG8_STAGE(PG8_SB(1, 1), cB + hstepB + kstep, voffB);
        PG8_WAIT_V(6); PG8_BAR;
    } else {
        PG8_STAGE(PG8_SB(0, 0), cB, voffB); PG8_STAGE(PG8_SA(0, 0), cA, voffA); PG8_STAGE(PG8_SB(0, 1), cB + hstepB, voffB); PG8_STAGE(PG8_SA(0, 1), cA + hstepA, voffA);
        if (wr == 1) PG8_BAR;
        PG8_WAIT_V(4); PG8_BAR;
        PG8_STAGE(PG8_SB(1, 0), cB + kstep, voffB); PG8_STAGE(PG8_SA(1, 0), cA + kstep, voffA); PG8_STAGE(PG8_SB(1, 1), cB + hstepB + kstep, voffB);
        PG8_WAIT_V(6); PG8_BAR;
    }
    for (;;) {
        const bool has_next = S.next(ui + 1, nxt);
        const char* nA = has_next ? (const char*)g.A + (size_t)nxt.pm * tstepA + (size_t)nxt.kh * g.khb : cA; const char* nB = has_next ? (const char*)g.Bt + (size_t)nxt.pn * tstepB + (size_t)nxt.kh * g.khb : cB;
#pragma nounroll
        for (int t = 0; t < nt; t += 2) {
            const bool last = (t == nt - 2);
            const char* a1 = cA + (size_t)(t + 1) * kstep;
            const char* a2 = last ? nA : cA + (size_t)(t + 2) * kstep; const char* b2 = last ? nB : cB + (size_t)(t + 2) * kstep;
            const char* a3 = a2 + kstep; const char* b3 = b2 + kstep;
            if (last && has_next) S.a_ready(nxt);
            if constexpr (SP2) {
            PG8_LDB(B0, 0, 0); PG8_LDB(B1, 0, 1); PG8_SCHED; PG8_LDA(At, 0, 0); PG8_STAGE(PG8_SA(1, 1), a1 + hstepA, voffA);
            PG8_WAIT_V(8); PG8_WAIT_L(0); PG8_BAR; PG8_MMA(0, 0, At, B0); PG8_MMA(0, 1, At, B1); PG8_BAR; PG8_SCHED;
            PG8_LDA(At, 0, 1); PG8_STAGE(PG8_SB(0, 0), b2, voffB); PG8_STAGE(PG8_SB(0, 1), b2 + hstepB, voffB); PG8_STAGE(PG8_SA(0, 0), a2, voffA);
            PG8_WAIT_V(8); PG8_WAIT_L(0); PG8_BAR; PG8_MMA(1, 0, At, B0); PG8_MMA(1, 1, At, B1); PG8_BAR; PG8_SCHED;
            PG8_LDB(B0, 1, 0); PG8_LDB(B1, 1, 1); PG8_SCHED; PG8_LDA(At, 1, 0); PG8_STAGE(PG8_SA(0, 1), a2 + hstepA, voffA);
            PG8_WAIT_V(8); PG8_WAIT_L(0); PG8_BAR; PG8_MMA(0, 0, At, B0); PG8_MMA(0, 1, At, B1); PG8_BAR; PG8_SCHED;
            PG8_LDA(At, 1, 1); PG8_STAGE(PG8_SB(1, 0), b3, voffB); PG8_STAGE(PG8_SB(1, 1), b3 + hstepB, voffB); PG8_STAGE(PG8_SA(1, 0), a3, voffA);
            PG8_WAIT_V(8); PG8_WAIT_L(0); PG8_BAR; PG8_MMA(1, 0, At, B0); PG8_MMA(1, 1, At, B1); PG8_BAR; PG8_SCHED;
            } else {
            PG8_LDB(B0, 0, 0); PG8_SCHED; PG8_LDA(At, 0, 0); PG8_STAGE(PG8_SA(1, 1), a1 + hstepA, voffA);
            PG8_WAIT_L(8); PG8_BAR; PG8_WAIT_L(0); PG8_MMA(0, 0, At, B0); PG8_BAR; PG8_SCHED;
            PG8_LDB(B1, 0, 1); PG8_STAGE(PG8_SB(0, 0), b2, voffB);
            PG8_BAR; PG8_WAIT_L(0); PG8_MMA(0, 1, At, B1); PG8_BAR;
            PG8_LDA(At, 0, 1); PG8_STAGE(PG8_SA(0, 0), a2, voffA);
            PG8_BAR; PG8_WAIT_L(0); PG8_MMA(1, 0, At, B0); PG8_BAR; PG8_SCHED;
            PG8_STAGE(PG8_SB(0, 1), b2 + hstepB, voffB);
            PG8_WAIT_V(6); PG8_BAR; PG8_MMA(1, 1, At, B1); PG8_BAR;
            PG8_LDB(B0, 1, 0); PG8_SCHED; PG8_LDA(At, 1, 0); PG8_STAGE(PG8_SA(0, 1), a2 + hstepA, voffA);
            PG8_WAIT_L(8); PG8_BAR; PG8_WAIT_L(0); PG8_MMA(0, 0, At, B0); PG8_BAR; PG8_SCHED;
            PG8_LDB(B1, 1, 1); PG8_STAGE(PG8_SB(1, 0), b3, voffB);
            PG8_BAR; PG8_WAIT_L(0); PG8_MMA(0, 1, At, B1); PG8_BAR;
            PG8_LDA(At, 1, 1); PG8_STAGE(PG8_SA(1, 0), a3, voffA);
            PG8_BAR; PG8_WAIT_L(0); PG8_MMA(1, 0, At, B0); PG8_BAR; PG8_SCHED;
            PG8_STAGE(PG8_SB(1, 1), b3 + hstepB, voffB);
            PG8_WAIT_V(6); PG8_BAR; PG8_MMA(1, 1, At, B1); PG8_BAR;
            }
        }
        if constexpr (ALIGN_EPI) { if (wr == 0) PG8_BAR; }
        if constexpr (!Epi::AFTER_DRAIN) { E(acc, cur, wr, wc, fr, fq); S.done(cur); }
        if (!has_next) break;
        if (Epi::zero_after(cur)) {
#pragma unroll
        for (int a = 0; a < 2; ++a)
#pragma unroll
            for (int b = 0; b < 2; ++b)
#pragma unroll
                for (int m = 0; m < 4; ++m)
#pragma unroll
                    for (int n = 0; n < 2; ++n) acc[a][b][m][n] = (f32x4){0.f, 0.f, 0.f, 0.f};
        }
        cur = nxt; cA = nA; cB = nB; ++ui;
        if constexpr (ALIGN_EPI) { if (wr == 1) PG8_BAR; }
    }
    PG8_WAIT_V(0);
    if constexpr (!ALIGN_EPI) { if (wr == 0) PG8_BAR; }
    PG8_BAR;
    if constexpr (Epi::AFTER_DRAIN) { E.fused(acc, cur, wr, wc, fr, fq, lds, wid, lane); S.done(cur); }
#undef PG8_SA
#undef PG8_SB
#undef PG8_STAGE
#undef PG8_LDA
#undef PG8_LDB
#undef PG8_MMA
#undef PG8_WAIT_V
#undef PG8_WAIT_L
#undef PG8_BAR
#undef PG8_SCHED
}
}

typedef f32x4 AccT[2][2][4][2];
__device__ __forceinline__ float sigm(float x) { return 1.0f / (1.0f + __expf(-x)); }
__device__ __forceinline__ float gelu_tanh(float x) { const float u = 0.7978845608028654f * (x + 0.044715f * x * x * x); return 0.5f * x * (1.0f + tanhf(u)); }
__device__ __forceinline__ u32x4 pack8(f32x4 a, f32x4 b) { u32x4 w; w.x = pg8::cvt_pk_bf16(a.x, a.y); w.y = pg8::cvt_pk_bf16(a.z, a.w); w.z = pg8::cvt_pk_bf16(b.x, b.y); w.w = pg8::cvt_pk_bf16(b.z, b.w); return w; }
__device__ __forceinline__ void unpack8(u32x4 w, f32x4& a, f32x4& b) { a = (f32x4){bflo(w.x), bfhi(w.x), bflo(w.y), bfhi(w.y)}; b = (f32x4){bflo(w.z), bfhi(w.z), bflo(w.w), bfhi(w.w)}; }
__device__ __forceinline__ float sumsq4(f32x4 v) { return (v.x * v.x + v.y * v.y) + (v.z * v.z + v.w * v.w); }
__device__ __forceinline__ float sum8f(const float* p) { const f32x4 a = *(const f32x4*)p, b = *(const f32x4*)(p + 4); return ((a.x + a.y) + (a.z + a.w)) + ((b.x + b.y) + (b.z + b.w)); }
__device__ __forceinline__ float sum16f(const float* p) { return sum8f(p) + sum8f(p + 8); }
__device__ __forceinline__ float red_fq(float s) { s += __shfl_xor(s, 16); s += __shfl_xor(s, 32); return s; }
#define EPI_ROWS(...) _Pragma("unroll") for (int ai = 0; ai < 2; ++ai) _Pragma("unroll") for (int m = 0; m < 4; ++m) { const int row = u.pm * 256 + ai * 128 + wr * 64 + m * 16 + fr; __VA_ARGS__ }
#define EPI_COLS(...) _Pragma("unroll") for (int bj = 0; bj < 2; ++bj) { const int col = u.pn * 256 + bj * 128 + wc * 32 + 8 * fq; f32x4& v0 = acc[ai][bj][m][0]; f32x4& v1 = acc[ai][bj][m][1]; __VA_ARGS__ }

struct EpiIn {
    static constexpr bool PERM = true, AFTER_DRAIN = false; __device__ static bool zero_after(const pg8::Unit&) { return true; }
    const float* RS0; bf16_t *QB, *KB, *VB, *UH;
    __device__ __forceinline__ void operator()(AccT& acc, const pg8::Unit& u, int wr, int wc, int fr, int fq) const {
        EPI_ROWS( const float rs = RS0[row];
            EPI_COLS( const u32x4 w = pack8(v0 * rs, v1 * rs);
                if (u.pn < 6) { bf16_t* dst = QB + (size_t)(u.pn >> 1) * ((size_t)NT * AW); *(u32x4*)(dst + (size_t)row * AW + (col & (AW - 1))) = w; }
                else { const int c = col - 3 * AW, g = c >> 4, ch = c & 15; *(u32x4*)(UH + ((size_t)(g * NCHT + (row >> 4))) * 512 + (row & 15) * 16 + ch) = w; } ) )
    }
};
struct EpiS {
    static constexpr bool PERM = true, AFTER_DRAIN = false; __device__ static bool zero_after(const pg8::Unit&) { return true; }
    bf16_t* SB;
    __device__ __forceinline__ void operator()(AccT& acc, const pg8::Unit& u, int wr, int wc, int fr, int fq) const {
        EPI_ROWS( EPI_COLS( *(u32x4*)(SB + (size_t)row * 256 + (col - u.pn * 256)) = pack8(v0, v1); ) )
    }
};
struct EpiY {
    static constexpr bool PERM = true, AFTER_DRAIN = false; __device__ static bool zero_after(const pg8::Unit&) { return true; }
    bf16_t* GB;
    __device__ __forceinline__ void operator()(AccT& acc, const pg8::Unit& u, int wr, int wc, int fr, int fq) const {
        const int g = u.pn;
        EPI_ROWS( const int chunk = row - g * NCHT;
            EPI_COLS( const int cl = col - u.pn * 256, j = cl >> 4, h = cl & 15; const size_t tok = (size_t)chunk * 16 + j;
                f32x4 a, b; a.x = gelu_tanh(v0.x); a.y = gelu_tanh(v0.y); a.z = gelu_tanh(v0.z); a.w = gelu_tanh(v0.w); b.x = gelu_tanh(v1.x); b.y = gelu_tanh(v1.y); b.z = gelu_tanh(v1.z); b.w = gelu_tanh(v1.w);
                *(u32x4*)(GB + tok * SW + g * 16 + h) = pack8(a, b); ) )
    }
};
struct EpiGlu {
    static constexpr bool PERM = true, AFTER_DRAIN = false; __device__ static bool zero_after(const pg8::Unit&) { return true; }
    const bf16_t* GB; const float* bglu; bf16_t* MIX; float* SSQS;
    __device__ __forceinline__ void operator()(AccT& acc, const pg8::Unit& u, int wr, int wc, int fr, int fq) const {
        EPI_ROWS( float sq = 0.f;
            EPI_COLS( f32x4 g0, g1; unpack8(*(const u32x4*)(GB + (size_t)row * SW + col), g0, g1); const f32x4 b0 = *(const f32x4*)(bglu + col), b1 = *(const f32x4*)(bglu + col + 4);
                f32x4 o0, o1; o0.x = g0.x * sigm(v0.x + b0.x); o0.y = g0.y * sigm(v0.y + b0.y); o0.z = g0.z * sigm(v0.z + b0.z); o0.w = g0.w * sigm(v0.w + b0.w);
                o1.x = g1.x * sigm(v1.x + b1.x); o1.y = g1.y * sigm(v1.y + b1.y); o1.z = g1.z * sigm(v1.z + b1.z); o1.w = g1.w * sigm(v1.w + b1.w);
                sq += sumsq4(o0) + sumsq4(o1); *(u32x4*)(MIX + (size_t)row * D + AW + col) = pack8(o0, o1); )
            sq = red_fq(sq); if (fq == 0) SSQS[(size_t)row * 8 + u.pn * 4 + wc] = sq; )
    }
};
struct EpiOut {
    static constexpr bool PERM = true, AFTER_DRAIN = false; __device__ static bool zero_after(const pg8::Unit& u) { return u.kh != 0; }
    const float *xp, *xs; const float *SSQA, *SSQS; bf16_t* H1B; float* SSQ1;
    __device__ __forceinline__ void operator()(AccT& acc, const pg8::Unit& u, int wr, int wc, int fr, int fq) const {
        if (u.kh == 0) {
            EPI_ROWS( const float rsa = 1.0f / sqrtf(sum8f(SSQA + (size_t)row * 8) * (1.0f / AW) + EPS), rss = 1.0f / sqrtf(sum8f(SSQS + (size_t)row * 8) * (1.0f / SW) + EPS); const float r = rsa / rss;
                EPI_COLS( v0 = v0 * r; v1 = v1 * r; ) )
        } else {
            EPI_ROWS( const float rss = 1.0f / sqrtf(sum8f(SSQS + (size_t)row * 8) * (1.0f / SW) + EPS); float sq = 0.f; const float* xr = xrow(xp, xs, row, D);
                EPI_COLS( const f32x4 o0 = *(const f32x4*)(xr + col) + v0 * rss, o1 = *(const f32x4*)(xr + col + 4) + v1 * rss;
                    sq += sumsq4(o0) + sumsq4(o1); *(u32x4*)(H1B + (size_t)row * D + col) = pack8(o0, o1); )
                sq = red_fq(sq); if (fq == 0) SSQ1[(size_t)row * 16 + u.pn * 4 + wc] = sq; )
        }
    }
};
struct EpiMlp1 {
    static constexpr bool PERM = true, AFTER_DRAIN = false; __device__ static bool zero_after(const pg8::Unit&) { return true; }
    const float* SSQ1; bf16_t* HID;
    __device__ __forceinline__ void operator()(AccT& acc, const pg8::Unit& u, int wr, int wc, int fr, int fq) const {
        EPI_ROWS( const float rs = 1.0f / sqrtf(sum16f(SSQ1 + (size_t)row * 16) * (1.0f / D) + EPS);
            EPI_COLS( f32x4 a = v0 * rs, b = v1 * rs; a.x = fmaxf(a.x, 0.f); a.y = fmaxf(a.y, 0.f); a.z = fmaxf(a.z, 0.f); a.w = fmaxf(a.w, 0.f); b.x = fmaxf(b.x, 0.f); b.y = fmaxf(b.y, 0.f); b.z = fmaxf(b.z, 0.f); b.w = fmaxf(b.w, 0.f);
                *(u32x4*)(HID + (size_t)row * DFF + col) = pack8(a * a, b * b); ) )
    }
};
struct EpiMlp2 {
    static constexpr bool PERM = true, AFTER_DRAIN = false; __device__ static bool zero_after(const pg8::Unit&) { return true; }
    const bf16_t* H1B; bf16_t* H2B; float* SSQ2;
    __device__ __forceinline__ void operator()(AccT& acc, const pg8::Unit& u, int wr, int wc, int fr, int fq) const {
        EPI_ROWS( float sq = 0.f;
            EPI_COLS( f32x4 h0, h1; unpack8(*(const u32x4*)(H1B + (size_t)row * D + col), h0, h1); const f32x4 o0 = h0 + v0, o1 = h1 + v1;
                sq += sumsq4(o0) + sumsq4(o1); *(u32x4*)(H2B + (size_t)row * D + col) = pack8(o0, o1); )
            sq = red_fq(sq); if (fq == 0) SSQ2[(size_t)row * 16 + u.pn * 4 + wc] = sq; )
    }
};
struct EpiPP {
    static constexpr bool PERM = true, AFTER_DRAIN = false; __device__ static bool zero_after(const pg8::Unit&) { return true; }
    bf16_t* PP;
    __device__ __forceinline__ void operator()(AccT& acc, const pg8::Unit& u, int wr, int wc, int fr, int fq) const {
        EPI_ROWS( EPI_COLS( *(u32x4*)(PP + (size_t)row * D + col) = pack8(v0, v1); ) )
    }
};
struct EpiGate {
    static constexpr bool PERM = true, AFTER_DRAIN = false; __device__ static bool zero_after(const pg8::Unit&) { return true; }
    const float* SSQ2; const bf16_t* H2B; const bf16_t* PP; float* H3F;
    __device__ __forceinline__ void operator()(AccT& acc, const pg8::Unit& u, int wr, int wc, int fr, int fq) const {
        EPI_ROWS( const float rs = 1.0f / sqrtf(sum16f(SSQ2 + (size_t)row * 16) * (1.0f / D) + EPS);
            EPI_COLS( f32x4 h0, h1, p0, p1; unpack8(*(const u32x4*)(H2B + (size_t)row * D + col), h0, h1); unpack8(*(const u32x4*)(PP + (size_t)row * D + col), p0, p1);
                f32x4 o0, o1; o0.x = h0.x + sigm(v0.x * rs) * p0.x; o0.y = h0.y + sigm(v0.y * rs) * p0.y; o0.z = h0.z + sigm(v0.z * rs) * p0.z; o0.w = h0.w + sigm(v0.w * rs) * p0.w;
                o1.x = h1.x + sigm(v1.x * rs) * p1.x; o1.y = h1.y + sigm(v1.y * rs) * p1.y; o1.z = h1.z + sigm(v1.z * rs) * p1.z; o1.w = h1.w + sigm(v1.w * rs) * p1.w;
                *(f32x4*)(H3F + (size_t)row * D + col) = o0; *(f32x4*)(H3F + (size_t)row * D + col + 4) = o1; ) )
    }
};

__device__ __forceinline__ void ph_final(const float* __restrict__ H3F, const float* __restrict__ gf, float* __restrict__ out) {
    const int tidf = tid_fresh(), lane = tidf & 63;
    for (int row = blockIdx.x * 8 + (tidf >> 6); row < NT; row += gridDim.x * 8) {
        const f32x4* xr = (const f32x4*)(H3F + (size_t)row * D) + lane;
        float s = 0.f; f32x4 v[4];
#pragma unroll
        for (int j = 0; j < 4; ++j) { v[j] = xr[64 * j]; s += v[j].x * v[j].x + v[j].y * v[j].y + v[j].z * v[j].z + v[j].w * v[j].w; }
        s = wave_sum(s); const float rs = 1.0f / sqrtf(s * (1.0f / D) + EPS);
        f32x4* o = (f32x4*)(out + (size_t)row * D) + lane; const f32x4* g4 = (const f32x4*)gf + lane;
#pragma unroll
        for (int j = 0; j < 4; ++j) o[64 * j] = v[j] * rs * g4[64 * j];
    }
}


typedef float f32x16 __attribute__((ext_vector_type(16)));
typedef short v4i16_t __attribute__((ext_vector_type(4)));
typedef float f32x2_t __attribute__((ext_vector_type(2))); typedef __bf16 bf16x2_t __attribute__((ext_vector_type(2)));
__device__ __forceinline__ unsigned cvtpk_s(float lo, float hi) { f32x2_t v = {lo, hi}; bf16x2_t b = __builtin_convertvector(v, bf16x2_t); return __builtin_bit_cast(unsigned, b); }
constexpr int ATT_CT_BYTES = 3 * 5 * 4 * 64 * 16;
constexpr int ATT_V_OFF = ATT_CT_BYTES, ATT_V_BYTES = 4096, ATT_LDS = ATT_V_OFF + 8 * ATT_V_BYTES;
__device__ __forceinline__ void ph_attn(PG8_LAS unsigned char* lds, const bf16_t* __restrict__ QB, const bf16_t* __restrict__ KB, const bf16_t* __restrict__ VB, const float* __restrict__ bias,
                                        bf16_t* MIX, float* AM, float* AL, float* __restrict__ SSQA) {
    const int tid = tid_fresh(), lane = tid & 63, wid = __builtin_amdgcn_readfirstlane(tid >> 6), q = lane & 31, hi = lane >> 5;
    PG8_LAS unsigned char* vt = lds + ATT_V_OFF + wid * ATT_V_BYTES;
    const int vrow = lane >> 3, vch = lane & 7;
    PG8_LAS unsigned char* vwr = vt + (vch >> 2) * 2048 + vrow * 64 + (vch & 3) * 16;
    PG8_LAS unsigned char* vrd = vt + (4 * hi + ((lane & 15) >> 2)) * 64 + (16 * ((lane >> 4) & 1) + 4 * (lane & 3)) * 2;
    int last_h = -1;
    for (int it = blockIdx.x; it < NH * NSEQ * 16; it += gridDim.x) {
        const int h = it & 7, sw = it >> 3, sq_ = sw >> 4, w = sw & 15;
        if (h != last_h) {
            __syncthreads();
            for (int e = tid; e < 3 * 5 * 4 * 64 * 4; e += NTHR) {
                const int el = e & 3, ln = (e >> 2) & 63, rq = (e >> 8) & 3, tb = e >> 10, ti = tb % 5, b = tb / 5;
                const int r16 = 4 * rq + el, kv = (r16 & 3) + 8 * (r16 >> 2) + 4 * (ln >> 5), off = 32 * (ti - 2) + kv - (ln & 31);
                ((PG8_LAS float*)lds)[e] = (off >= -64 && off <= 64) ? bias[(b * NH + h) * 129 + off + 64] : -1e30f;
            }
            __syncthreads(); last_h = h;
        }
        const int p0 = w * 512; const size_t seqbase = (size_t)sq_ * SEQ;
#pragma unroll 1
        for (int b = 0; b < 3; ++b) {
            const int dsh = 2 * b, L = SEQ >> dsh;
#pragma unroll 1
            for (int tq = 0; tq < 2; ++tq) {
                const int ti = wid + 8 * tq;
                int r, m0;
                if (b == 0) { r = 0; m0 = p0 + 32 * ti; } else if (b == 1) { r = ti & 3; m0 = (p0 >> 2) + 32 * (ti >> 2); } else { r = ti; m0 = p0 >> 4; }
                const size_t qtok = seqbase + ((size_t)(m0 + q) << dsh) + r;
                bf16x8 qf[4];
#pragma unroll
                for (int s4 = 0; s4 < 4; ++s4) qf[s4] = *(const bf16x8*)(QB + qtok * AW + h * HD + 16 * s4 + 8 * hi);
                float m_run = -1e30f, l_part = 0.f; f32x16 o0, o1;
#pragma unroll
                for (int e = 0; e < 16; ++e) { o0[e] = 0.f; o1[e] = 0.f; }
                bf16x8 kf[4]; u32x4 vr[4];
#define ATT_LOADKV(KT) do { const int mk0_ = m0 + 32 * (KT); const int mkc_ = (mk0_ >= 0 && mk0_ < L) ? mk0_ : m0; \
                    const bf16_t* kp_ = KB + (seqbase + ((size_t)(mkc_ + q) << dsh) + r) * AW + h * HD + 8 * hi; \
                    _Pragma("unroll") for (int s4 = 0; s4 < 4; ++s4) kf[s4] = *(const bf16x8*)(kp_ + 16 * s4); \
                    _Pragma("unroll") for (int j4 = 0; j4 < 4; ++j4) vr[j4] = *(const u32x4*)(VB + (seqbase + ((size_t)(mkc_ + 8 * j4 + vrow) << dsh) + r) * AW + h * HD + 8 * vch); } while (0)
#pragma unroll 1
                for (int i = 0; i < 5; ++i) {
                    const int kt = (i == 0) ? 0 : ((i & 1) ? -((i + 1) >> 1) : (i >> 1));
                    const int mk0 = m0 + 32 * kt; const bool valid = (mk0 >= 0) && (mk0 < L);
                    ATT_LOADKV(kt);
                    f32x16 acc;
                    { const PG8_LAS f32x4* cp = (const PG8_LAS f32x4*)(lds + ((b * 5 + kt + 2) * 4) * 1024 + lane * 16);
#pragma unroll
                      for (int rq = 0; rq < 4; ++rq) { const f32x4 c4 = cp[rq * 64]; acc[4 * rq] = c4.x; acc[4 * rq + 1] = c4.y; acc[4 * rq + 2] = c4.z; acc[4 * rq + 3] = c4.w; } }
#pragma unroll
                    for (int s4 = 0; s4 < 4; ++s4) acc = __builtin_amdgcn_mfma_f32_32x32x16_bf16(kf[s4], qf[s4], acc, 0, 0, 0);
                    if (!valid) {
#pragma unroll
                        for (int e = 0; e < 16; ++e) acc[e] = -1e30f;
                    }
#pragma unroll
                    for (int j4 = 0; j4 < 4; ++j4) *(PG8_LAS u32x4*)(vwr + j4 * 512) = vr[j4];
                    float tm = acc[0];
#pragma unroll
                    for (int e = 1; e < 16; ++e) tm = fmaxf(tm, acc[e]);
                    tm = fmaxf(tm, __shfl_xor(tm, 32));
                    const float mn = fmaxf(m_run, tm), sc = exp2f(m_run - mn); m_run = mn;
                    float rs = 0.f;
#pragma unroll
                    for (int e = 0; e < 16; ++e) { acc[e] = exp2f(acc[e] - mn); rs += acc[e]; }
                    l_part = l_part * sc + rs;
#pragma unroll
                    for (int e = 0; e < 16; ++e) { o0[e] *= sc; o1[e] *= sc; }
                    u32x4 pw0, pw1;
                    pw0.x = cvtpk_s(acc[0], acc[1]); pw0.y = cvtpk_s(acc[2], acc[3]); pw0.z = cvtpk_s(acc[4], acc[5]); pw0.w = cvtpk_s(acc[6], acc[7]);
                    pw1.x = cvtpk_s(acc[8], acc[9]); pw1.y = cvtpk_s(acc[10], acc[11]); pw1.z = cvtpk_s(acc[12], acc[13]); pw1.w = cvtpk_s(acc[14], acc[15]);
                    const bf16x8 pb0 = __builtin_bit_cast(bf16x8, pw0), pb1 = __builtin_bit_cast(bf16x8, pw1);
                    asm volatile("s_waitcnt lgkmcnt(0)" ::: "memory");
#define ATT_VTR(off) __builtin_amdgcn_ds_read_tr16_b64_v4i16((PG8_LAS v4i16_t*)(vrd + (off)))
#define ATT_VF(lo4, hi4) (bf16x8){lo4[0], lo4[1], lo4[2], lo4[3], hi4[0], hi4[1], hi4[2], hi4[3]}
                    { const v4i16_t a0 = ATT_VTR(0), a1 = ATT_VTR(512), a2 = ATT_VTR(1024), a3 = ATT_VTR(1536);
                      const v4i16_t c0 = ATT_VTR(2048), c1 = ATT_VTR(2048 + 512), c2 = ATT_VTR(2048 + 1024), c3 = ATT_VTR(2048 + 1536);
                      o0 = __builtin_amdgcn_mfma_f32_32x32x16_bf16(ATT_VF(a0, a1), pb0, o0, 0, 0, 0);
                      o0 = __builtin_amdgcn_mfma_f32_32x32x16_bf16(ATT_VF(a2, a3), pb1, o0, 0, 0, 0);
                      o1 = __builtin_amdgcn_mfma_f32_32x32x16_bf16(ATT_VF(c0, c1), pb0, o1, 0, 0, 0);
                      o1 = __builtin_amdgcn_mfma_f32_32x32x16_bf16(ATT_VF(c2, c3), pb1, o1, 0, 0, 0); }
                    asm volatile("s_waitcnt lgkmcnt(0)" ::: "memory");
                }
                const float l_b = l_part + __shfl_xor(l_part, 32);
                float fa = 0.f, fc, mm = m_run, ln = l_b;
                if (b > 0) { const float pm = AM[qtok * NH + h], pl = AL[qtok * NH + h]; mm = fmaxf(pm, m_run); fa = pl * exp2f(pm - mm); fc = exp2f(m_run - mm); ln = fa + l_b * fc; }
                else fc = 1.f;
                const float inv = 1.0f / ln; fa *= inv; fc *= inv;
                bf16_t* op = MIX + qtok * D + h * HD + 4 * hi;
                float ssq = 0.f;
#pragma unroll
                for (int dt = 0; dt < 2; ++dt)
#pragma unroll
                    for (int rq = 0; rq < 4; ++rq) {
                        f32x4 v;
                        if (dt == 0) v = (f32x4){o0[4 * rq], o0[4 * rq + 1], o0[4 * rq + 2], o0[4 * rq + 3]}; else v = (f32x4){o1[4 * rq], o1[4 * rq + 1], o1[4 * rq + 2], o1[4 * rq + 3]};
                        v = v * fc;
                        bf16_t* pp_ = op + 32 * dt + 8 * rq;
                        if (b > 0) { const u32x2 pw = *(const u32x2*)pp_; v = v + (f32x4){bflo(pw.x), bfhi(pw.x), bflo(pw.y), bfhi(pw.y)} * fa; }
                        ssq += sumsq4(v);
                        u32x2 w2; w2.x = cvtpk_s(v.x, v.y); w2.y = cvtpk_s(v.z, v.w); *(u32x2*)pp_ = w2;
                    }
                if (b < 2) { if (hi == 0) { AM[qtok * NH + h] = mm; AL[qtok * NH + h] = ln; } }
                else { ssq += __shfl_xor(ssq, 32); if (hi == 0) SSQA[qtok * NH + h] = ssq; }
            }
            __syncthreads();
        }
    }
#undef ATT_LOADKV
#undef ATT_VTR
#undef ATT_VF
}

__device__ __forceinline__ void ph_scan(const bf16_t* __restrict__ SB, const float* __restrict__ PW, bf16_t* __restrict__ UH) {
    for (size_t ii = GTID; ii < (size_t)NSEQ * NG * 2 * NS; ii += GSIZE) {
        const int i = (int)ii;
        const int n = i % NS, dir = (i / NS) % 2, g = (i / (2 * NS)) % NG, s = i / (2 * NS * NG);
        const float* pw = PW + ((size_t)((g * 2 + dir) * NS + n) * 17 + 16) * 2;
        const float ar = pw[0], ai = pw[1];
        float hr = 0.f, hi = 0.f;
        const size_t base = (size_t)g * NCHT + (size_t)s * NCHS; const int colo = dir * 128 + 2 * n;
        for (int t = 0; t < NCHS; ++t) {
            const int c = dir == 0 ? t : NCHS - 1 - t;
            *(unsigned*)(UH + (base + c) * 512 + 256 + colo) = pk2(hr, hi);
            const unsigned w = *(const unsigned*)(SB + (base + c) * 256 + colo);
            const float sr = bflo(w), si = bfhi(w);
            const float nr = ar * hr - ai * hi + sr, ni = ar * hi + ai * hr + si;
            hr = nr; hi = ni;
        }
    }
}


constexpr int LDS_BYTES = 147456;
struct Args { const float* in[27]; float* out; unsigned char* ws; };
template <class Epi>
__device__ __forceinline__ void run_gemm(PG8_LAS unsigned char* lds, const bf16_t* A, int lda, const bf16_t* Bt, int ldb, int M, int N, int K, int khb, int split, int bdiv, const Epi& E) {
    pg8::Gemm g{A, Bt, lda, ldb, K, khb}; pg8::Order S; S.init(M, N, (int)gridDim.x, (int)blockIdx.x, split, bdiv);
    pg8::gemm_phase<Epi, pg8::Order, true, true>(lds, g, S, E);
}
__global__ void __launch_bounds__(NTHR, 2) mega(Args a) {
    extern __shared__ __attribute__((aligned(16))) unsigned char lds_raw[];
    PG8_LAS unsigned char* lds = (PG8_LAS unsigned char*)lds_raw;
    cg::grid_group grid = cg::this_grid();
    const float *xp = a.in[0], *xs = a.in[1], *pp = a.in[2], *ps = a.in[3], *rel_bias = a.in[4], *g_mix = a.in[5], *w_in = a.in[6];
    const float *a_re = a.in[7], *a_im = a.in[8], *log_dt = a.in[9], *b_re = a.in[10], *b_im = a.in[11], *c_re = a.in[12], *c_im = a.in[13], *ssm_d = a.in[14];
    const float *w_glu = a.in[15], *b_glu = a.in[16], *g_att = a.in[17], *g_ssm = a.in[18], *w_out = a.in[19], *g_mlp = a.in[20], *w_mlp1 = a.in[21], *w_mlp2 = a.in[22];
    const float *g_ple = a.in[23], *w_gate = a.in[24], *w_proj = a.in[25], *g_final = a.in[26];
    unsigned char* ws = a.ws; unsigned char* dob = (unsigned char*)a.out;
    float* BIAS = (float*)(ws + WS_BIAS); float* PW = (float*)(ws + WS_PW); float* BBt = (float*)(ws + WS_BB); float* KT = (float*)(ws + WS_KT);
    float *RS0 = (float*)(ws + WS_RS0), *SSQA = (float*)(ws + WS_SSQA), *SSQS = (float*)(ws + WS_SSQS), *SSQ1 = (float*)(ws + WS_SSQ1), *SSQ2 = (float*)(ws + WS_SSQ2);
    bf16_t *WGT = (bf16_t*)(ws + WS_WGT), *WPT = (bf16_t*)(ws + WS_WPT);
    bf16_t *W1T = (bf16_t*)(dob + DO_W1T), *W2T = (bf16_t*)(dob + DO_W2T), *PB = (bf16_t*)(dob + DO_PB);
    bf16_t *WINT = (bf16_t*)(dob + DO_WINT), *WOUTT = (bf16_t*)(dob + DO_WOUTT), *WGLUT = (bf16_t*)(dob + DO_WGLUT), *WST = (bf16_t*)(dob + DO_WST), *WYT = (bf16_t*)(dob + DO_WYT);
    bf16_t *SB = (bf16_t*)(dob + DO_SB), *QB = (bf16_t*)(ws + WS_QB), *KB = (bf16_t*)(ws + WS_KB), *VB = (bf16_t*)(ws + WS_VB), *UH = (bf16_t*)(ws + WS_UH);
    bf16_t *MIX = (bf16_t*)(ws + WS_MIX), *GB = (bf16_t*)(ws + WS_GB), *HID = (bf16_t*)(ws + WS_HID), *PP = (bf16_t*)(ws + WS_PP);
    float* H3F = (float*)(ws + WS_H3F);
    bf16_t *XB = (bf16_t*)(dob + DO_XB), *H1B = (bf16_t*)(ws + WS_HB), *H2B = (bf16_t*)(ws + WS_HB);
#ifndef PROBE_MASK
#define PROBE_MASK 0
#endif
#define PHASE(id) _Pragma("unroll 1") for (int rep_ = 0; rep_ < (((PROBE_MASK) >> (id)) & 1) + 1; ++rep_)
    PHASE(0) {
        ph_prep_wt(lds, w_in, D, INC, g_mix, g_mix, D, WINT, D, AW, C2);
        ph_prep_wt(lds, w_glu, SW, SW, nullptr, nullptr, SW, WGLUT, SW, 0, 1.f);
        ph_prep_wt(lds, w_out, D, D, g_att, g_ssm, AW, WOUTT, D, 0, 1.f);
        ph_prep_wt(lds, w_mlp1, D, DFF, g_mlp, g_mlp, D, W1T, D, 0, 1.f);
        ph_prep_wt(lds, w_mlp2, DFF, D, nullptr, nullptr, DFF, W2T, DFF, 0, 1.f);
        ph_prep_wt(lds, w_gate, D, D, g_ple, g_ple, D, WGT, D, 0, 1.f);
        ph_prep_wt(lds, w_proj, PLE, D, nullptr, nullptr, PLE, WPT, PLE, 0, 1.f);
        ph_prep_bias(rel_bias, BIAS);
        ph_ssm_tab(a_re, a_im, log_dt, b_re, b_im, PW, BBt);
        ph_rows_x(xp, xs, XB, RS0);
        ph_cvt_p(pp, ps, PB);
        grid.sync();
    }
    PHASE(1) {
        ph_ssm_ws(PW, BBt, WST);
        ph_ssm_kt(PW, BBt, c_re, c_im, KT);
        ph_ssm_wy_carry(PW, c_re, c_im, WYT);
        run_gemm(lds, XB, D, WINT, D, NT, INC, D, 0, 0, 0, EpiIn{RS0, QB, KB, VB, UH});
        grid.sync();
    }
    PHASE(2) {
        ph_ssm_wy_fill(KT, ssm_d, WYT);
        ph_attn(lds, QB, KB, VB, BIAS, MIX, (float*)(ws + WS_AM), (float*)(ws + WS_AL), SSQA);
    }
    PHASE(3) {
        run_gemm(lds, UH, 512, WST, 256, NG * NCHT, 256, 256, 0, 0, NCHT / 256, EpiS{SB});
        grid.sync();
    }
    PHASE(4) {
        ph_scan(SB, PW, UH);
        grid.sync();
    }
    PHASE(5) {
        run_gemm(lds, UH, 512, WYT, 512, NG * NCHT, 256, 512, 0, 0, NCHT / 256, EpiY{GB});
        grid.sync();
    }
    PHASE(6) {
        run_gemm(lds, GB, SW, WGLUT, SW, NT, SW, SW, 0, 0, 0, EpiGlu{GB, b_glu, MIX, SSQS});
        grid.sync();
    }
    PHASE(7) {
        run_gemm(lds, MIX, D, WOUTT, D, NT, D, AW, AW * 2, 1, 0, EpiOut{xp, xs, SSQA, SSQS, H1B, SSQ1});
        grid.sync();
    }
    PHASE(8) {
        run_gemm(lds, H1B, D, W1T, D, NT, DFF, D, 0, 0, 0, EpiMlp1{SSQ1, HID});
        grid.sync();
    }
    PHASE(9) {
        run_gemm(lds, HID, DFF, W2T, DFF, NT, D, DFF, 0, 0, 0, EpiMlp2{H1B, H2B, SSQ2});
        grid.sync();
    }
    PHASE(10) {
        run_gemm(lds, PB, PLE, WPT, PLE, NT, D, PLE, 0, 0, 0, EpiPP{PP});
        grid.sync();
    }
    PHASE(11) {
        run_gemm(lds, H2B, D, WGT, D, NT, D, D, 0, 0, 0, EpiGate{SSQ2, H2B, PP, H3F});
        grid.sync();
    }
    PHASE(12) {
        ph_final(H3F, g_final, a.out);
    }
}

extern "C" void kernel_launch(void* const* d_in, const int* in_sizes, int n_in, void* d_out, int out_size, void* d_ws, size_t ws_size, hipStream_t stream) {
    static int grid_blocks = 0;
    if (n_in != 27 || ws_size < WS_END || out_size != NT * D) { fprintf(stderr, "kernel_launch: unexpected sizes n_in %d ws %zu out %d\n", n_in, ws_size, out_size); return; }
    if (!grid_blocks) {
        int dev = 0, cus = 0, per_cu = 0;
        (void)hipGetDevice(&dev);
        (void)hipDeviceGetAttribute(&cus, hipDeviceAttributeMultiprocessorCount, dev);
        if (hipFuncSetAttribute((const void*)mega, hipFuncAttributeMaxDynamicSharedMemorySize, LDS_BYTES) != hipSuccess) { fprintf(stderr, "kernel_launch: hipFuncSetAttribute failed\n"); return; }
        (void)hipOccupancyMaxActiveBlocksPerMultiprocessor(&per_cu, mega, NTHR, LDS_BYTES);
        if (per_cu < 1) { fprintf(stderr, "kernel_launch: occupancy query says %d blocks per CU\n", per_cu); return; }
        grid_blocks = cus;
    }
    Args a{};
    for (int i = 0; i < 27; ++i) a.in[i] = (const float*)d_in[i];
    a.out = (float*)d_out; a.ws = (unsigned char*)d_ws;
    void* args[] = {&a};
    hipError_t e = hipLaunchCooperativeKernel((void*)mega, dim3(grid_blocks), dim3(NTHR), args, LDS_BYTES, stream);
    if (e != hipSuccess) fprintf(stderr, "cooperative launch failed: %s (grid %d)\n", hipGetErrorString(e), grid_blocks);
}
```

```cpp
#include <hip/hip_runtime.h>
#include <hip/hip_cooperative_groups.h>
namespace cg = cooperative_groups;
#include <cstdio>
#include <cstdint>
#include <cmath>

typedef unsigned short bf16_t;
typedef short bf16x8 __attribute__((ext_vector_type(8)));
typedef float f32x4 __attribute__((ext_vector_type(4)));
typedef unsigned u32x2 __attribute__((ext_vector_type(2)));
typedef unsigned u32x4 __attribute__((ext_vector_type(4)));

constexpr int NT = 49152, SEQ = 8192, NSEQ = 6, NPROMPT = 16384;
constexpr int D = 1024, DFF = 4096, PLE = 256, INC = 2048, AW = 512, SW = 512;
constexpr int NH = 8, HD = 64, NG = 32, GC = 16, NS = 64;
constexpr int TCH = 16, NCHT = NT / TCH  , NCHS = SEQ / TCH  ;
constexpr float EPS = 1e-6f;
constexpr float LOG2E = 1.4426950408889634f;
constexpr float C2 = 0.125f * LOG2E;

constexpr size_t MiB = 1u << 20;
constexpr size_t WS_BIAS = 0;
constexpr size_t WS_PW = 64 * 1024;
constexpr size_t WS_BB = 1 * MiB;
constexpr size_t WS_KT = 1536 * 1024;
constexpr size_t WS_RS0 = 2560 * 1024;
constexpr size_t WS_SSQA = 3 * MiB;
constexpr size_t WS_SSQS = 4608 * 1024;
constexpr size_t WS_SSQ1 = 6 * MiB;
constexpr size_t WS_SSQ2 = 9 * MiB;
constexpr size_t WS_SSQ3 = 12 * MiB;
constexpr size_t WS_AM = 15 * MiB;
constexpr size_t WS_AL = WS_AM + 1536 * 1024;
constexpr size_t WS_WGT = 18 * MiB, WS_WPT = 20 * MiB;
constexpr size_t WS_CTL = 20 * MiB + 512 * 1024;
constexpr size_t WS_HB = 32 * MiB;
constexpr size_t WS_QB = 128 * MiB, WS_KB = 176 * MiB, WS_VB = 224 * MiB;
constexpr size_t WS_UH = 272 * MiB;
constexpr size_t WS_MIX = 368 * MiB;
constexpr size_t WS_GB = 464 * MiB;
constexpr size_t WS_HID = 128 * MiB;
constexpr size_t WS_PP = 128 * MiB;
constexpr size_t WS_H3F = 224 * MiB;
constexpr size_t WS_END = 512 * MiB;
static_assert(WS_KB - WS_QB == (size_t)NT * AW * 2 && WS_VB - WS_KB == (size_t)NT * AW * 2, "QB | KB | VB contiguous");
constexpr size_t DO_XB = 0, DO_SB = 0;
constexpr size_t DO_W1T = 96 * MiB, DO_W2T = 104 * MiB, DO_WINT = 112 * MiB, DO_WOUTT = 116 * MiB, DO_WGLUT = 118 * MiB, DO_WST = 119 * MiB, DO_WYT = 123 * MiB, DO_PB = 131 * MiB;

__device__ __forceinline__ unsigned f2bf(float f) { unsigned u = __builtin_bit_cast(unsigned, f); return (u + 0x7fffu + ((u >> 16) & 1u)) >> 16; }
__device__ __forceinline__ unsigned pk2(float lo, float hi) { return f2bf(lo) | (f2bf(hi) << 16); }
__device__ __forceinline__ float bf2f(unsigned short b) { return __builtin_bit_cast(float, (unsigned)b << 16); }
__device__ __forceinline__ float bflo(unsigned w) { return __builtin_bit_cast(float, w << 16); }
__device__ __forceinline__ float bfhi(unsigned w) { return __builtin_bit_cast(float, w & 0xffff0000u); }
__device__ __forceinline__ float wave_sum(float v) {
#pragma unroll
    for (int o = 1; o < 64; o <<= 1) v += __shfl_xor(v, o);
    return v;
}
__device__ __forceinline__ const float* xrow(const float* xp, const float* xs, int tok, int width) {
    return tok < NPROMPT ? xp + (size_t)tok * width : xs + (size_t)(tok - NPROMPT) * width;
}


constexpr int NTHR = 512;
#define PG8_LAS __attribute__((address_space(3)))
__device__ __forceinline__ int tid_fresh() { int t = threadIdx.x; asm volatile("" : "+v"(t)); return t; }
__device__ __forceinline__ size_t gtid_fresh() { return (size_t)blockIdx.x * NTHR + tid_fresh(); }
#define GTID gtid_fresh()
#define GSIZE ((size_t)gridDim.x * NTHR)

__device__ __forceinline__ void ph_prep_wt(PG8_LAS unsigned char* lds, const float* __restrict__ W, int K, int N, const float* __restrict__ g1, const float* __restrict__ g2, int ksplit,
                                           bf16_t* __restrict__ out, int ldo, int nscale, float sc) {
    const int tid = tid_fresh(), lane = tid & 63, wave = tid >> 6;
    PG8_LAS float* scr = (PG8_LAS float*)(lds + wave * 8448);
    const int nblk = N / 32, nitems = (K / 64) * nblk;
    for (int item = blockIdx.x * 8 + wave; item < nitems; item += gridDim.x * 8) {
        const int kb = item / nblk, nb = item % nblk, k0 = 64 * kb, n0 = 32 * nb;
#pragma unroll 8
        for (int i = 0; i < 32; ++i) { const int kk = 2 * i + (lane >> 5), k = k0 + kk; float gv = 1.f; if (g1) { const float* gp = (k < ksplit) ? (g1 + k) : (g2 + (k - ksplit)); gv = *gp; }
            scr[kk * 33 + (lane & 31)] = W[(size_t)k * N + n0 + (lane & 31)] * gv; }
        asm volatile("s_waitcnt lgkmcnt(0)" ::: "memory");
        const int c = lane & 7;
#pragma unroll
        for (int j = 0; j < 4; ++j) { const int n = (lane >> 3) + 8 * j; const PG8_LAS float* sp = scr + (8 * c) * 33 + n; const float cs = (n0 + n) < nscale ? sc : 1.f;
            u32x4 o; o.x = pk2(sp[0 * 33] * cs, sp[1 * 33] * cs); o.y = pk2(sp[2 * 33] * cs, sp[3 * 33] * cs); o.z = pk2(sp[4 * 33] * cs, sp[5 * 33] * cs); o.w = pk2(sp[6 * 33] * cs, sp[7 * 33] * cs);
            *(u32x4*)(out + (size_t)(n0 + n) * ldo + k0 + 8 * c) = o; }
        asm volatile("s_waitcnt lgkmcnt(0)" ::: "memory");
    }
}
__device__ __forceinline__ int t5_bucket(int rel) {
    int n = -rel; int ret = n < 0 ? 16 : 0; n = n < 0 ? -n : n;
    if (n < 8) return ret + n;
    int large = 8 + (int)(log((double)n / 8.0) / log(128.0) * 8.0);
    large = large < 15 ? large : 15;
    return ret + large;
}
__device__ __forceinline__ void ph_prep_bias(const float* __restrict__ rel_bias, float* __restrict__ bias) {
    for (size_t i = GTID; i < 3 * 8 * 129; i += GSIZE) {
        const int o = (int)(i % 129), h = (int)((i / 129) % 8), b = (int)(i / (129 * 8));
        const int dil = b == 0 ? 1 : (b == 1 ? 4 : 16);
        bias[i] = rel_bias[t5_bucket((o - 64) * dil) * NH + h] * LOG2E;
    }
}
__device__ __forceinline__ void ph_rows_x(const float* __restrict__ xp, const float* __restrict__ xs, bf16_t* __restrict__ XB, float* __restrict__ RS0) {
    const int tidf = tid_fresh(), lane = tidf & 63;
    for (int row = blockIdx.x * 8 + (tidf >> 6); row < NT; row += gridDim.x * 8) {
        const f32x4* xr = (const f32x4*)xrow(xp, xs, row, D) + lane;
        float s = 0.f; f32x4 v[4];
#pragma unroll
        for (int j = 0; j < 4; ++j) { v[j] = xr[64 * j]; s += v[j].x * v[j].x + v[j].y * v[j].y + v[j].z * v[j].z + v[j].w * v[j].w; }
        s = wave_sum(s);
        u32x2* o = (u32x2*)(XB + (size_t)row * D) + lane;
#pragma unroll
        for (int j = 0; j < 4; ++j) { u32x2 w; w.x = pk2(v[j].x, v[j].y); w.y = pk2(v[j].z, v[j].w); o[64 * j] = w; }
        if (lane == 0) RS0[row] = 1.0f / sqrtf(s * (1.0f / D) + EPS);
    }
}
__device__ __forceinline__ void ph_cvt_p(const float* __restrict__ pp, const float* __restrict__ ps, bf16_t* __restrict__ PB) {
    for (size_t i = GTID; i < (size_t)NT * PLE / 4; i += GSIZE) {
        const int tok = (int)(i / (PLE / 4)), c4 = (int)(i % (PLE / 4));
        const f32x4 v = *((const f32x4*)xrow(pp, ps, tok, PLE) + c4);
        u32x2 w; w.x = pk2(v.x, v.y); w.y = pk2(v.z, v.w);
        *((u32x2*)(PB + (size_t)tok * PLE) + c4) = w;
    }
}
__device__ __forceinline__ void ph_ssm_tab(const float* __restrict__ a_re, const float* __restrict__ a_im, const float* __restrict__ log_dt,
                          const float* __restrict__ b_re, const float* __restrict__ b_im, float* __restrict__ PW, float* __restrict__ BB) {
    for (size_t ii = GTID; ii < NG * 2 * NS; ii += GSIZE) {
        const int i = (int)ii;
        const int n = i % NS, dir = (i / NS) % 2, g = i / (2 * NS);
        const int pi = (dir * NG + g) * NS + n;
        const double ar = a_re[pi], ai = a_im[pi], dt = exp((double)log_dt[dir * NG + g]);
        float* pw = PW + (size_t)((g * 2 + dir) * NS + n) * 17 * 2;
        for (int e = 0; e <= 16; ++e) { const double mag = exp(ar * dt * e), ang = ai * dt * e; pw[2 * e] = (float)(mag * cos(ang)); pw[2 * e + 1] = (float)(mag * sin(ang)); }
        const double abr = exp(ar * dt) * cos(ai * dt), abi = exp(ar * dt) * sin(ai * dt), inv = 1.0 / (ar * ar + ai * ai);
        const double fr = ((abr - 1.0) * ar + abi * ai) * inv, fi = (abi * ar - (abr - 1.0) * ai) * inv;
        float* bb = BB + (size_t)((g * 2 + dir) * NS + n) * GC * 2;
        for (int h = 0; h < GC; ++h) { const double br = b_re[(size_t)pi * GC + h], bi = b_im[(size_t)pi * GC + h]; bb[2 * h] = (float)(fr * br - fi * bi); bb[2 * h + 1] = (float)(fr * bi + fi * br); }
    }
}
__device__ __forceinline__ void ph_ssm_kt(const float* __restrict__ PW, const float* __restrict__ BB, const float* __restrict__ c_re, const float* __restrict__ c_im, float* __restrict__ KT) {
    for (size_t ii = GTID; ii < (size_t)NG * 2 * 16 * GC; ii += GSIZE) {
        const int i = (int)ii, h = i % GC, e = (i / GC) % 16, dir = (i / (GC * 16)) % 2, g = i / (GC * 16 * 2);
        float acc[GC];
#pragma unroll
        for (int hp = 0; hp < GC; ++hp) acc[hp] = 0.f;
        for (int n = 0; n < NS; ++n) {
            const float* pw = PW + ((size_t)((g * 2 + dir) * NS + n) * 17 + e) * 2; const size_t ci = ((size_t)(dir * NG + g) * GC + h) * NS + n;
            const float cr = c_re[ci], cim = c_im[ci], tr = cr * pw[0] - cim * pw[1], ti = cr * pw[1] + cim * pw[0];
            const f32x4* bb = (const f32x4*)(BB + (size_t)((g * 2 + dir) * NS + n) * GC * 2);
#pragma unroll
            for (int q4 = 0; q4 < 8; ++q4) { const f32x4 b4 = bb[q4]; acc[2 * q4] += tr * b4.x - ti * b4.y; acc[2 * q4 + 1] += tr * b4.z - ti * b4.w; }
        }
        f32x4* o = (f32x4*)(KT + (size_t)i * GC);
#pragma unroll
        for (int q4 = 0; q4 < 4; ++q4) o[q4] = (f32x4){acc[4 * q4], acc[4 * q4 + 1], acc[4 * q4 + 2], acc[4 * q4 + 3]};
    }
}
__device__ __forceinline__ void ph_ssm_ws(const float* __restrict__ PW, const float* __restrict__ BB, bf16_t* __restrict__ WST) {
    for (size_t ii = GTID; ii < (size_t)NG * 256 * 32; ii += GSIZE) {
        const int i = (int)ii, ko = i % 32, col = (i / 32) % 256, g = i / 8192;
        const int j = ko >> 1, hp0 = (ko & 1) * 8, dir = col / 128, n = (col % 128) / 2, ri = col & 1;
        const int e = dir == 0 ? 15 - j : j;
        const float* pw = PW + ((size_t)((g * 2 + dir) * NS + n) * 17 + e) * 2; const float* bb = BB + ((size_t)((g * 2 + dir) * NS + n) * GC + hp0) * 2;
        const float pr = pw[0], pi = pw[1]; float v[8];
#pragma unroll
        for (int t = 0; t < 8; ++t) v[t] = ri ? (pr * bb[2 * t + 1] + pi * bb[2 * t]) : (pr * bb[2 * t] - pi * bb[2 * t + 1]);
        u32x4 o; o.x = pk2(v[0], v[1]); o.y = pk2(v[2], v[3]); o.z = pk2(v[4], v[5]); o.w = pk2(v[6], v[7]);
        *(u32x4*)(WST + (size_t)(g * 256 + col) * 256 + ko * 8) = o;
    }
}
__device__ __forceinline__ void ph_ssm_wy_carry(const float* __restrict__ PW, const float* __restrict__ c_re, const float* __restrict__ c_im, bf16_t* __restrict__ WYT) {
    for (size_t ii = GTID; ii < (size_t)NG * 256 * 32; ii += GSIZE) {
        const int i = (int)ii, ko = i % 32, jh = (i / 32) % 256, g = i / 8192;
        const int j = jh / 16, h = jh % 16, dir = ko / 16, n0 = (ko % 16) * 4;
        const int e = dir == 0 ? j + 1 : 16 - j; float v[8];
#pragma unroll
        for (int t = 0; t < 4; ++t) { const int n = n0 + t; const float* pw = PW + ((size_t)((g * 2 + dir) * NS + n) * 17 + e) * 2; const size_t ci = ((size_t)(dir * NG + g) * GC + h) * NS + n;
            const float cr = c_re[ci], cim = c_im[ci]; v[2 * t] = cr * pw[0] - cim * pw[1]; v[2 * t + 1] = -(cr * pw[1] + cim * pw[0]); }
        u32x4 o; o.x = pk2(v[0], v[1]); o.y = pk2(v[2], v[3]); o.z = pk2(v[4], v[5]); o.w = pk2(v[6], v[7]);
        *(u32x4*)(WYT + (size_t)(g * 256 + jh) * 512 + 256 + ko * 8) = o;
    }
}
__device__ __forceinline__ void ph_ssm_wy_fill(const float* __restrict__ KT, const float* __restrict__ dd, bf16_t* __restrict__ WYT) {
    for (size_t ii = GTID; ii < (size_t)NG * 256 * 32; ii += GSIZE) {
        const int i = (int)ii, ko = i % 32, jh = (i / 32) % 256, g = i / 8192;
        const int j = jh / 16, h = jh % 16, jp = ko >> 1, hp0 = (ko & 1) * 8;
        float v[8];
#pragma unroll
        for (int t = 0; t < 8; ++t) v[t] = 0.f;
        if (j >= jp) { const float* kt = KT + ((size_t)((g * 2 + 0) * 16 + (j - jp)) * GC + h) * GC + hp0;
#pragma unroll
            for (int t = 0; t < 8; ++t) v[t] += kt[t]; }
        if (jp >= j) { const float* kt = KT + ((size_t)((g * 2 + 1) * 16 + (jp - j)) * GC + h) * GC + hp0;
#pragma unroll
            for (int t = 0; t < 8; ++t) v[t] += kt[t]; }
        if (jp == j) { const float dv = dd[g * GC + h];
#pragma unroll
            for (int t = 0; t < 8; ++t) if (hp0 + t == h) v[t] += dv; }
        u32x4 o; o.x = pk2(v[0], v[1]); o.y = pk2(v[2], v[3]); o.z = pk2(v[4], v[5]); o.w = pk2(v[6], v[7]);
        *(u32x4*)(WYT + (size_t)(g * 256 + jh) * 512 + ko * 8) = o;
    }
}

__device__ __forceinline__ void st_bf4(bf16_t* p, f32x4 v) { u32x2 w; w.x = pk2(v.x, v.y); w.y = pk2(v.z, v.w); *(u32x2*)p = w; }
__device__ __forceinline__ f32x4 ld_bf4(const bf16_t* p) { const u32x2 w = *(const u32x2*)p; return (f32x4){bflo(w.x), bfhi(w.x), bflo(w.y), bfhi(w.y)}; }
namespace pg8 {
constexpr int BM = 256, BK = 64, HALF = 128, HTB = HALF * BK * 2  , STAGE_BYTES = 8 * HTB, NXCD = 8, WGM = 8;

__host__ __device__ __forceinline__ int lds_byte(int r, int c) { const int st = (r >> 4) * 2 + (c >> 5), rr = r & 15, cc = c & 31, ob = rr * 64 + cc * 2; return st * 1024 + (ob ^ (((ob >> 9) & 1) << 5)); }
__host__ __device__ __forceinline__ void stage_rc(int b, int& R, int& C) { const int st = b / 1024, sb = b % 1024, swz = sb ^ (((sb >> 9) & 1) << 5); R = (st >> 1) * 16 + swz / 64; C = (st & 1) * 32 + (swz % 64) / 2; }
__host__ __device__ __forceinline__ int perm32(int rho) { const int n = rho >> 4, i = rho & 15; return 8 * (i >> 2) + 4 * n + (i & 3); }
struct Unit { int pm, pn, kh; };
struct Gemm { const bf16_t* A; const bf16_t* Bt; int lda, ldb, K, khb; };
struct Order {
    int nM, nN, nwg, G, c, split, bdiv;
    __device__ void init(int M, int N, int G_, int c_, int split_ = 0, int bdiv_ = 0) { nM = M / BM; nN = N / BM; nwg = nM * nN; G = G_; c = c_; split = split_; bdiv = bdiv_; }
    __device__ bool next(int i, Unit& u) const {
        const int ti = split ? (i >> 1) : i;
        const long L = (long)ti * G + c; if (L >= nwg) return false;
        int wgid = (int)L; { const int q = nwg / NXCD, r = nwg % NXCD, xcd = wgid % NXCD, off = wgid / NXCD; wgid = (xcd < r ? xcd * (q + 1) : r * (q + 1) + (xcd - r) * q) + off; }
        const int nig = WGM * nN, gid = wgid / nig, fm = gid * WGM, gsz = (nM - fm) < WGM ? (nM - fm) : WGM;
        u.pm = fm + ((wgid % nig) % gsz); u.pn = (wgid % nig) / gsz; u.kh = split ? (i & 1) : 0;
        if (bdiv) u.pn = u.pm / bdiv;
        return true;
    }
    __device__ __forceinline__ void a_ready(const Unit&) const {}
    __device__ __forceinline__ void done(const Unit&) const {}
};
__device__ __forceinline__ unsigned cvt_pk_bf16(float lo, float hi) { unsigned r; asm volatile("v_cvt_pk_bf16_f32 %0, %1, %2" : "=v"(r) : "v"(lo), "v"(hi)); return r; }
template <class Epi, class Sched, bool ALIGN_EPI = false, bool SP2 = false>
__device__ __forceinline__ void gemm_phase(PG8_LAS unsigned char* lds, const Gemm g, const Sched& S, const Epi& E) {
    const int tid = tid_fresh(), wid = __builtin_amdgcn_readfirstlane(tid >> 6), lane = tid & 63, wr = wid >> 2, wc = wid & 3, fr = lane & 15, fq = lane >> 4;
    const int K = g.K, nt = K / BK;
    unsigned voffA[2], voffB[2];
#pragma unroll
    for (int i = 0; i < 2; ++i) { int R, C; stage_rc(tid * 16 + i * 8192, R, C); const int Rb = Epi::PERM ? ((R & ~31) + perm32(R & 31)) : R;
        voffA[i] = (unsigned)(R * g.lda + C) * 2u; voffB[i] = (unsigned)(Rb * g.ldb + C) * 2u; }
    const size_t kstep = (size_t)(BK * 2);
    const size_t hstepA = (size_t)HALF * g.lda * 2, hstepB = (size_t)HALF * g.ldb * 2;
    const size_t tstepA = 2 * hstepA, tstepB = 2 * hstepB;
    const unsigned ldsw = (unsigned)wid * 1024u;
    const int aoff = lds_byte(wr * 64 + fr, fq * 8), boff = lds_byte(wc * 32 + fr, fq * 8);
#define PG8_SA(b, h) (((b) * 2 + (h)) * HTB)
#define PG8_SB(b, h) ((4 + (b) * 2 + (h)) * HTB)
#define PG8_STAGE(bufoff, gbase, voff) do { _Pragma("unroll") for (int _i = 0; _i < 2; ++_i) \
        __builtin_amdgcn_global_load_lds((const unsigned*)((const char*)(gbase) + (voff)[_i]), (PG8_LAS unsigned*)(lds + (bufoff) + ldsw + _i * 8192), 16, 0, 0); } while (0)
#define PG8_LDA(dst, b, h) do { _Pragma("unroll") for (int m = 0; m < 4; ++m) _Pragma("unroll") for (int k = 0; k < 2; ++k) dst[m][k] = *(const PG8_LAS bf16x8*)(lds + PG8_SA(b, h) + aoff + m * 2048 + k * 1024); } while (0)
#define PG8_LDB(dst, b, h) do { _Pragma("unroll") for (int n = 0; n < 2; ++n) _Pragma("unroll") for (int k = 0; k < 2; ++k) dst[n][k] = *(const PG8_LAS bf16x8*)(lds + PG8_SB(b, h) + boff + n * 2048 + k * 1024); } while (0)
#define PG8_MMA(ai, bj, At, Bt) do { __builtin_amdgcn_s_setprio(1); _Pragma("unroll") for (int m = 0; m < 4; ++m) _Pragma("unroll") for (int n = 0; n < 2; ++n) _Pragma("unroll") for (int k = 0; k < 2; ++k) \
        acc[ai][bj][m][n] = __builtin_amdgcn_mfma_f32_16x16x32_bf16(Bt[n][k], At[m][k], acc[ai][bj][m][n], 0, 0, 0); __builtin_amdgcn_s_setprio(0); } while (0)
#define PG8_WAIT_V(n) asm volatile("s_waitcnt vmcnt(" #n ")" ::: "memory")
#define PG8_WAIT_L(n) asm volatile("s_waitcnt lgkmcnt(" #n ")" ::: "memory")
#define PG8_BAR __builtin_amdgcn_s_barrier()
#define PG8_SCHED __builtin_amdgcn_sched_barrier(0)
    Unit cur, nxt; int ui = 0;
    if (!S.next(0, cur)) return;
    f32x4 acc[2][2][4][2];
#pragma unroll
    for (int a = 0; a < 2; ++a)
#pragma unroll
        for (int b = 0; b < 2; ++b)
#pragma unroll
            for (int m = 0; m < 4; ++m)
#pragma unroll
                for (int n = 0; n < 2; ++n) acc[a][b][m][n] = (f32x4){0.f, 0.f, 0.f, 0.f};
    bf16x8 At[4][2], B0[2][2], B1[2][2];
    const char* cA = (const char*)g.A + (size_t)cur.pm * tstepA + (size_t)cur.kh * g.khb; const char* cB = (const char*)g.Bt + (size_t)cur.pn * tstepB + (size_t)cur.kh * g.khb;
    S.a_ready(cur);
    if constexpr (SP2) {
        PG8_STAGE(PG8_SB(0, 0), cB, voffB); PG8_STAGE(PG8_SB(0, 1), cB + hstepB, voffB); PG8_STAGE(PG8_SA(0, 0), cA, voffA); PG8_STAGE(PG8_SA(0, 1), cA + hstepA, voffA);
        if (wr == 1) PG8_BAR;
        PG8_WAIT_V(2); PG8_BAR;
        PG8_STAGE(PG8_SB(1, 0), cB + kstep, voffB); PG8_STAGE(PG8_SA(1, 0), cA + kstep, voffA); PG8_STAGE(PG8_SB(1, 1), cB + hstepB + kstep, voffB);
        PG8_WAIT_V(6); PG8_BAR;
    } else {
        PG8_STAGE(PG8_SB(0, 0), cB, voffB); PG8_STAGE(PG8_SA(0, 0), cA, voffA); PG8_STAGE(PG8_SB(0, 1), cB + hstepB, voffB); PG8_STAGE(PG8_SA(0, 1), cA + hstepA, voffA);
        if (wr == 1) PG8_BAR;
        PG8_WAIT_V(4); PG8_BAR;
        PG8_STAGE(PG8_SB(1, 0), cB + kstep, voffB); PG8_STAGE(PG8_SA(1, 0), cA + kstep, voffA); PG8_STAGE(PG8_SB(1, 1), cB + hstepB + kstep, voffB);
        PG8_WAIT_V(6); PG8_BAR;
    }
    for (;;) {
        const bool has_next = S.next(ui + 1, nxt);
        const char* nA = has_next ? (const char*)g.A + (size_t)nxt.pm * tstepA + (size_t)nxt.kh * g.khb : cA; const char* nB = has_next ? (const char*)g.Bt + (size_t)nxt.pn * tstepB + (size_t)nxt.kh * g.khb : cB;
#pragma nounroll
        for (int t = 0; t < nt; t += 2) {
            const bool last = (t == nt - 2);
            const char* a1 = cA + (size_t)(t + 1) * kstep;
            const char* a2 = last ? nA : cA + (size_t)(t + 2) * kstep; const char* b2 = last ? nB : cB + (size_t)(t + 2) * kstep;
            const char* a3 = a2 + kstep; const char* b3 = b2 + kstep;
            if (last && has_next) S.a_ready(nxt);
            if constexpr (SP2) {
            PG8_LDB(B0, 0, 0); PG8_LDB(B1, 0, 1); PG8_SCHED; PG8_LDA(At, 0, 0); PG8_STAGE(PG8_SA(1, 1), a1 + hstepA, voffA);
            PG8_WAIT_V(8); PG8_WAIT_L(0); PG8_BAR; PG8_MMA(0, 0, At, B0); PG8_MMA(0, 1, At, B1); PG8_BAR; PG8_SCHED;
            PG8_LDA(At, 0, 1); PG8_STAGE(PG8_SB(0, 0), b2, voffB); PG8_STAGE(PG8_SB(0, 1), b2 + hstepB, voffB); PG8_STAGE(PG8_SA(0, 0), a2, voffA);
            PG8_WAIT_V(8); PG8_WAIT_L(0); PG8_BAR; PG8_MMA(1, 0, At, B0); PG8_MMA(1, 1, At, B1); PG8_BAR; PG8_SCHED;
            PG8_LDB(B0, 1, 0); PG8_LDB(B1, 1, 1); PG8_SCHED; PG8_LDA(At, 1, 0); PG8_STAGE(PG8_SA(0, 1), a2 + hstepA, voffA);
            PG8_WAIT_V(8); PG8_WAIT_L(0); PG8_BAR; PG8_MMA(0, 0, At, B0); PG8_MMA(0, 1, At, B1); PG8_BAR; PG8_SCHED;
            PG8_LDA(At, 1, 1); PG8_STAGE(PG8_SB(1, 0), b3, voffB); PG8_STAGE(PG8_SB(1, 1), b3 + hstepB, voffB); PG8_STAGE(PG8_SA(1, 0), a3, voffA);
            PG8_WAIT_V(8); PG8_WAIT_L(0); PG8_BAR; PG8_MMA(1, 0, At, B0); PG8_MMA(1, 1, At, B1); PG8_BAR; PG8_SCHED;
            } else {
            PG8_LDB(B0, 0, 0); PG8_SCHED; PG8_LDA(At, 0, 0); PG8_STAGE(PG8_SA(1, 1), a1 + hstepA, voffA);
            PG8_WAIT_L(8); PG8_BAR; PG8_WAIT_L(0); PG8_MMA(0, 0, At, B0); PG8_BAR; PG8_SCHED;
            PG8_LDB(B1, 0, 1); PG8_STAGE(PG8_SB(0, 0), b2, voffB);
            PG8_BAR; PG8_WAIT_L(0); PG8_MMA(0, 1, At, B1); PG8_BAR;
            PG8_LDA(At, 0, 1); PG8_STAGE(PG8_SA(0, 0), a2, voffA);
            PG8_BAR; PG8_WAIT_L(0); PG8_MMA(1, 0, At, B0); PG8_BAR; PG8_SCHED;
            PG8_STAGE(PG8_SB(0, 1), b2 + hstepB, voffB);
            PG8_WAIT_V(6); PG8_BAR; PG8_MMA(1, 1, At, B1); PG8_BAR;
            PG8_LDB(B0, 1, 0); PG8_SCHED; PG8_LDA(At, 1, 0); PG8_STAGE(PG8_SA(0, 1), a2 + hstepA, voffA);
            PG8_WAIT_L(8); PG8_BAR; PG8_WAIT_L(0); PG8_MMA(0, 0, At, B0); PG8_BAR; PG8_SCHED;
            PG8_LDB(B1, 1, 1); PG8_STAGE(PG8_SB(1, 0), b3, voffB);
            PG8_BAR; PG8_WAIT_L(0); PG8_MMA(0, 1, At, B1); PG8_BAR;
            PG8_LDA(At, 1, 1); PG8_STAGE(PG8_SA(1, 0), a3, voffA);
            PG8_BAR; PG8_WAIT_L(0); PG8_MMA(1, 0, At, B0); PG8_BAR; PG8_SCHED;
            PG8_STAGE(PG8_SB(1, 1), b3 + hstepB, voffB);
            PG8_WAIT_V(6); PG8_BAR; PG8_MMA(1, 1, At, B1); PG8_BAR;
            }
        }
        if constexpr (ALIGN_EPI) { if (wr == 0) PG8_BAR; }
        if constexpr (!Epi::AFTER_DRAIN) { E(acc, cur, wr, wc, fr, fq); S.done(cur); }
        if (!has_next) break;
        if (Epi::zero_after(cur)) {
#pragma unroll
        for (int a = 0; a < 2; ++a)
#pragma unroll
            for (int b = 0; b < 2; ++b)
#pragma unroll
                for (int m = 0; m < 4; ++m)
#pragma unroll
                    for (int n = 0; n < 2; ++n) acc[a][b][m][n] = (f32x4){0.f, 0.f, 0.f, 0.f};
        }
        cur = nxt; cA = nA; cB = nB; ++ui;
        if constexpr (ALIGN_EPI) { if (wr == 1) PG8_BAR; }
    }
    PG8_WAIT_V(0);
    if constexpr (!ALIGN_EPI) { if (wr == 0) PG8_BAR; }
    PG8_BAR;
    if constexpr (Epi::AFTER_DRAIN) { E.fused(acc, cur, wr, wc, fr, fq, lds, wid, lane); S.done(cur); }
#undef PG8_SA
#undef PG8_SB
#undef PG8_STAGE
#undef PG8_LDA
#undef PG8_LDB
#undef PG8_MMA
#undef PG8_WAIT_V
#undef PG8_WAIT_L
#undef PG8_BAR
#undef PG8_SCHED
}
}

typedef f32x4 AccT[2][2][4][2];
__device__ __forceinline__ float sigm(float x) { return 1.0f / (1.0f + __expf(-x)); }
__device__ __forceinline__ float gelu_tanh(float x) { const float u = 0.7978845608028654f * (x + 0.044715f * x * x * x); return 0.5f * x * (1.0f + tanhf(u)); }
__device__ __forceinline__ u32x4 pack8(f32x4 a, f32x4 b) { u32x4 w; w.x = pg8::cvt_pk_bf16(a.x, a.y); w.y = pg8::cvt_pk_bf16(a.z, a.w); w.z = pg8::cvt_pk_bf16(b.x, b.y); w.w = pg8::cvt_pk_bf16(b.z, b.w); return w; }
__device__ __forceinline__ void unpack8(u32x4 w, f32x4& a, f32x4& b) { a = (f32x4){bflo(w.x), bfhi(w.x), bflo(w.y), bfhi(w.y)}; b = (f32x4){bflo(w.z), bfhi(w.z), bflo(w.w), bfhi(w.w)}; }
__device__ __forceinline__ float sumsq4(f32x4 v) { return (v.x * v.x + v.y * v.y) + (v.z * v.z + v.w * v.w); }
__device__ __forceinline__ float sum8f(const float* p) { const f32x4 a = *(const f32x4*)p, b = *(const f32x4*)(p + 4); return ((a.x + a.y) + (a.z + a.w)) + ((b.x + b.y) + (b.z + b.w)); }
__device__ __forceinline__ float sum16f(const float* p) { return sum8f(p) + sum8f(p + 8); }
__device__ __forceinline__ float red_fq(float s) { s += __shfl_xor(s, 16); s += __shfl_xor(s, 32); return s; }
#define EPI_ROWS(...) _Pragma("unroll") for (int ai = 0; ai < 2; ++ai) _Pragma("unroll") for (int m = 0; m < 4; ++m) { const int row = u.pm * 256 + ai * 128 + wr * 64 + m * 16 + fr; __VA_ARGS__ }
#define EPI_COLS(...) _Pragma("unroll") for (int bj = 0; bj < 2; ++bj) { const int col = u.pn * 256 + bj * 128 + wc * 32 + 8 * fq; f32x4& v0 = acc[ai][bj][m][0]; f32x4& v1 = acc[ai][bj][m][1]; __VA_ARGS__ }

struct EpiIn {
    static constexpr bool PERM = true, AFTER_DRAIN = false; __device__ static bool zero_after(const pg8::Unit&) { return true; }
    const float* RS0; bf16_t *QB, *KB, *VB, *UH;
    __device__ __forceinline__ void operator()(AccT& acc, const pg8::Unit& u, int wr, int wc, int fr, int fq) const {
        EPI_ROWS( const float rs = RS0[row];
            EPI_COLS( const u32x4 w = pack8(v0 * rs, v1 * rs);
                if (u.pn < 6) { bf16_t* dst = QB + (size_t)(u.pn >> 1) * ((size_t)NT * AW); *(u32x4*)(dst + (size_t)row * AW + (col & (AW - 1))) = w; }
                else { const int c = col - 3 * AW, g = c >> 4, ch = c & 15; *(u32x4*)(UH + ((size_t)(g * NCHT + (row >> 4))) * 512 + (row & 15) * 16 + ch) = w; } ) )
    }
};
struct EpiS {
    static constexpr bool PERM = true, AFTER_DRAIN = false; __device__ static bool zero_after(const pg8::Unit&) { return true; }
    bf16_t* SB;
    __device__ __forceinline__ void operator()(AccT& acc, const pg8::Unit& u, int wr, int wc, int fr, int fq) const {
        EPI_ROWS( EPI_COLS( *(u32x4*)(SB + (size_t)row * 256 + (col - u.pn * 256)) = pack8(v0, v1); ) )
    }
};
struct EpiY {
    static constexpr bool PERM = true, AFTER_DRAIN = false; __device__ static bool zero_after(const pg8::Unit&) { return true; }
    bf16_t* GB;
    __device__ __forceinline__ void operator()(AccT& acc, const pg8::Unit& u, int wr, int wc, int fr, int fq) const {
        const int g = u.pn;
        EPI_ROWS( const int chunk = row - g * NCHT;
            EPI_COLS( const int cl = col - u.pn * 256, j = cl >> 4, h = cl & 15; const size_t tok = (size_t)chunk * 16 + j;
                f32x4 a, b; a.x = gelu_tanh(v0.x); a.y = gelu_tanh(v0.y); a.z = gelu_tanh(v0.z); a.w = gelu_tanh(v0.w); b.x = gelu_tanh(v1.x); b.y = gelu_tanh(v1.y); b.z = gelu_tanh(v1.z); b.w = gelu_tanh(v1.w);
                *(u32x4*)(GB + tok * SW + g * 16 + h) = pack8(a, b); ) )
    }
};
struct EpiGlu {
    static constexpr bool PERM = true, AFTER_DRAIN = false; __device__ static bool zero_after(const pg8::Unit&) { return true; }
    const bf16_t* GB; const float* bglu; bf16_t* MIX; float* SSQS;
    __device__ __forceinline__ void operator()(AccT& acc, const pg8::Unit& u, int wr, int wc, int fr, int fq) const {
        EPI_ROWS( float sq = 0.f;
            EPI_COLS( f32x4 g0, g1; unpack8(*(const u32x4*)(GB + (size_t)row * SW + col), g0, g1); const f32x4 b0 = *(const f32x4*)(bglu + col), b1 = *(const f32x4*)(bglu + col + 4);
                f32x4 o0, o1; o0.x = g0.x * sigm(v0.x + b0.x); o0.y = g0.y * sigm(v0.y + b0.y); o0.z = g0.z * sigm(v0.z + b0.z); o0.w = g0.w * sigm(v0.w + b0.w);
                o1.x = g1.x * sigm(v1.x + b1.x); o1.y = g1.y * sigm(v1.y + b1.y); o1.z = g1.z * sigm(v1.z + b1.z); o1.w = g1.w * sigm(v1.w + b1.w);
                sq += sumsq4(o0) + sumsq4(o1); *(u32x4*)(MIX + (size_t)row * D + AW + col) = pack8(o0, o1); )
            sq = red_fq(sq); if (fq == 0) SSQS[(size_t)row * 8 + u.pn * 4 + wc] = sq; )
    }
};
struct EpiOut {
    static constexpr bool PERM = true, AFTER_DRAIN = false; __device__ static bool zero_after(const pg8::Unit& u) { return u.kh != 0; }
    const float *xp, *xs; const float *SSQA, *SSQS; bf16_t* H1B; float* SSQ1;
    __device__ __forceinline__ void operator()(AccT& acc, const pg8::Unit& u, int wr, int wc, int fr, int fq) const {
        if (u.kh == 0) {
            EPI_ROWS( const float rsa = 1.0f / sqrtf(sum8f(SSQA + (size_t)row * 8) * (1.0f / AW) + EPS), rss = 1.0f / sqrtf(sum8f(SSQS + (size_t)row * 8) * (1.0f / SW) + EPS); const float r = rsa / rss;
                EPI_COLS( v0 = v0 * r; v1 = v1 * r; ) )
        } else {
            EPI_ROWS( const float rss = 1.0f / sqrtf(sum8f(SSQS + (size_t)row * 8) * (1.0f / SW) + EPS); float sq = 0.f; const float* xr = xrow(xp, xs, row, D);
                EPI_COLS( const f32x4 o0 = *(const f32x4*)(xr + col) + v0 * rss, o1 = *(const f32x4*)(xr + col + 4) + v1 * rss;
                    sq += sumsq4(o0) + sumsq4(o1); *(u32x4*)(H1B + (size_t)row * D + col) = pack8(o0, o1); )
                sq = red_fq(sq); if (fq == 0) SSQ1[(size_t)row * 16 + u.pn * 4 + wc] = sq; )
        }
    }
};
struct EpiMlp1 {
    static constexpr bool PERM = true, AFTER_DRAIN = false; __device__ static bool zero_after(const pg8::Unit&) { return true; }
    const float* SSQ1; bf16_t* HID;
    __device__ __forceinline__ void operator()(AccT& acc, const pg8::Unit& u, int wr, int wc, int fr, int fq) const {
        EPI_ROWS( const float rs = 1.0f / sqrtf(sum16f(SSQ1 + (size_t)row * 16) * (1.0f / D) + EPS);
            EPI_COLS( f32x4 a = v0 * rs, b = v1 * rs; a.x = fmaxf(a.x, 0.f); a.y = fmaxf(a.y, 0.f); a.z = fmaxf(a.z, 0.f); a.w = fmaxf(a.w, 0.f); b.x = fmaxf(b.x, 0.f); b.y = fmaxf(b.y, 0.f); b.z = fmaxf(b.z, 0.f); b.w = fmaxf(b.w, 0.f);
                *(u32x4*)(HID + (size_t)row * DFF + col) = pack8(a * a, b * b); ) )
    }
};
struct EpiMlp2 {
    static constexpr bool PERM = true, AFTER_DRAIN = false; __device__ static bool zero_after(const pg8::Unit&) { return true; }
    const bf16_t* H1B; bf16_t* H2B; float* SSQ2;
    __device__ __forceinline__ void operator()(AccT& acc, const pg8::Unit& u, int wr, int wc, int fr, int fq) const {
        EPI_ROWS( float sq = 0.f;
            EPI_COLS( f32x4 h0, h1; unpack8(*(const u32x4*)(H1B + (size_t)row * D + col), h0, h1); const f32x4 o0 = h0 + v0, o1 = h1 + v1;
                sq += sumsq4(o0) + sumsq4(o1); *(u32x4*)(H2B + (size_t)row * D + col) = pack8(o0, o1); )
            sq = red_fq(sq); if (fq == 0) SSQ2[(size_t)row * 16 + u.pn * 4 + wc] = sq; )
    }
};
struct EpiPP {
    static constexpr bool PERM = true, AFTER_DRAIN = false; __device__ static bool zero_after(const pg8::Unit&) { return true; }
    bf16_t* PP;
    __device__ __forceinline__ void operator()(AccT& acc, const pg8::Unit& u, int wr, int wc, int fr, int fq) const {
        EPI_ROWS( EPI_COLS( *(u32x4*)(PP + (size_t)row * D + col) = pack8(v0, v1); ) )
    }
};
struct EpiGate {
    static constexpr bool PERM = true, AFTER_DRAIN = false; __device__ static bool zero_after(const pg8::Unit&) { return true; }
    const float* SSQ2; const bf16_t* H2B; const bf16_t* PP; float* H3F;
    __device__ __forceinline__ void operator()(AccT& acc, const pg8::Unit& u, int wr, int wc, int fr, int fq) const {
        EPI_ROWS( const float rs = 1.0f / sqrtf(sum16f(SSQ2 + (size_t)row * 16) * (1.0f / D) + EPS);
            EPI_COLS( f32x4 h0, h1, p0, p1; unpack8(*(const u32x4*)(H2B + (size_t)row * D + col), h0, h1); unpack8(*(const u32x4*)(PP + (size_t)row * D + col), p0, p1);
                f32x4 o0, o1; o0.x = h0.x + sigm(v0.x * rs) * p0.x; o0.y = h0.y + sigm(v0.y * rs) * p0.y; o0.z = h0.z + sigm(v0.z * rs) * p0.z; o0.w = h0.w + sigm(v0.w * rs) * p0.w;
                o1.x = h1.x + sigm(v1.x * rs) * p1.x; o1.y = h1.y + sigm(v1.y * rs) * p1.y; o1.z = h1.z + sigm(v1.z * rs) * p1.z; o1.w = h1.w + sigm(v1.w * rs) * p1.w;
                *(f32x4*)(H3F + (size_t)row * D + col) = o0; *(f32x4*)(H3F + (size_t)row * D + col + 4) = o1; ) )
    }
};

__device__ __forceinline__ void ph_final(const float* __restrict__ H3F, const float* __restrict__ gf, float* __restrict__ out) {
    const int tidf = tid_fresh(), lane = tidf & 63;
    for (int row = blockIdx.x * 8 + (tidf >> 6); row < NT; row += gridDim.x * 8) {
        const f32x4* xr = (const f32x4*)(H3F + (size_t)row * D) + lane;
        float s = 0.f; f32x4 v[4];
#pragma unroll
        for (int j = 0; j < 4; ++j) { v[j] = xr[64 * j]; s += v[j].x * v[j].x + v[j].y * v[j].y + v[j].z * v[j].z + v[j].w * v[j].w; }
        s = wave_sum(s); const float rs = 1.0f / sqrtf(s * (1.0f / D) + EPS);
        f32x4* o = (f32x4*)(out + (size_t)row * D) + lane; const f32x4* g4 = (const f32x4*)gf + lane;
#pragma unroll
        for (int j = 0; j < 4; ++j) o[64 * j] = v[j] * rs * g4[64 * j];
    }
}


typedef float f32x16 __attribute__((ext_vector_type(16)));
typedef short v4i16_t __attribute__((ext_vector_type(4)));
typedef float f32x2_t __attribute__((ext_vector_type(2))); typedef __bf16 bf16x2_t __attribute__((ext_vector_type(2)));
__device__ __forceinline__ unsigned cvtpk_s(float lo, float hi) { f32x2_t v = {lo, hi}; bf16x2_t b = __builtin_convertvector(v, bf16x2_t); return __builtin_bit_cast(unsigned, b); }
constexpr int ATT_CT_BYTES = 3 * 5 * 4 * 64 * 16;
constexpr int ATT_KV_OFF = ATT_CT_BYTES, ATT_KV_BYTES = 8192, ATT_LDS = ATT_KV_OFF + 8 * ATT_KV_BYTES;
static_assert(ATT_LDS <= 131072, "attention LDS fits the stage ring region");
template <int MODE>
__device__ __forceinline__ void ph_attn(PG8_LAS unsigned char* lds, const bf16_t* __restrict__ QB, const bf16_t* __restrict__ KB, const bf16_t* __restrict__ VB, const float* __restrict__ bias,
                                        bf16_t* MIX, float* AM, float* AL, float* __restrict__ SSQA) {
    const int tid = tid_fresh(), lane = tid & 63, wid = __builtin_amdgcn_readfirstlane(tid >> 6), q = lane & 31, hi = lane >> 5;
    PG8_LAS unsigned char* ktile = lds + ATT_KV_OFF + wid * ATT_KV_BYTES;
    PG8_LAS unsigned char* vt = ktile + 4096;
    const int vrow = lane >> 3, vch = lane & 7;
    PG8_LAS unsigned char* kwr = ktile + vrow * 128 + ((vch ^ vrow) * 16);
    PG8_LAS unsigned char* vwr = vt + (vch >> 2) * 2048 + vrow * 64 + (vch & 3) * 16;
    const PG8_LAS unsigned char* krd = ktile + q * 128;
    const int kx = q & 7;
    PG8_LAS unsigned char* vrd = vt + (4 * hi + ((lane & 15) >> 2)) * 64 + (16 * ((lane >> 4) & 1) + 4 * (lane & 3)) * 2;
    int last_h = -1;
    for (int it = blockIdx.x; it < NH * NSEQ * 32; it += gridDim.x) {
        const int h = it & 7, sw = it >> 3, sq_ = sw >> 5, w = (MODE == 0) ? (sw & 31) : ((sw & 31) >> 1), half = sw & 1;
        if (h != last_h) {
            __syncthreads();
            for (int e = tid; e < 3 * 5 * 4 * 64 * 4; e += NTHR) {
                const int el = e & 3, ln = (e >> 2) & 63, rq = (e >> 8) & 3, tb = e >> 10, ti = tb % 5, b = tb / 5;
                const int r16 = 4 * rq + el, kv = (r16 & 3) + 8 * (r16 >> 2) + 4 * (ln >> 5), off = 32 * (ti - 2) + kv - (ln & 31);
                ((PG8_LAS float*)lds)[e] = (off >= -64 && off <= 64) ? bias[(b * NH + h) * 129 + off + 64] : -1e30f;
            }
            __syncthreads(); last_h = h;
        }
        const int p0 = (MODE == 0) ? w * 256 : w * 512; const size_t seqbase = (size_t)sq_ * SEQ;
#pragma unroll 1
        for (int b = (MODE == 0 ? 0 : 2); b < (MODE == 0 ? 2 : 3); ++b) {
            const int dsh = 2 * b, L = SEQ >> dsh;
            const PG8_LAS unsigned char* ctb = lds + b * (5 * 4096) + lane * 16;
            {
                int r, m0;
                if (b == 0) { r = 0; m0 = p0 + 32 * wid; } else if (b == 1) { r = wid & 3; m0 = (p0 >> 2) + 32 * (wid >> 2); } else { r = 8 * half + wid; m0 = p0 >> 4; }
                const size_t qtok = seqbase + ((size_t)(m0 + q) << dsh) + r;
                bf16x8 qf[4];
#pragma unroll
                for (int s4 = 0; s4 < 4; ++s4) qf[s4] = *(const bf16x8*)(QB + qtok * AW + h * HD + 16 * s4 + 8 * hi);
                float m_run = -1e30f, l_part = 0.f; f32x16 o0, o1;
#pragma unroll
                for (int e = 0; e < 16; ++e) { o0[e] = 0.f; o1[e] = 0.f; }
                u32x4 kr[2][4], vr[2][4];
                const size_t rstep = ((size_t)8 << dsh) * AW;
#define ATT_ISSUE(KT, SET) do { const int mk0_ = m0 + 32 * (KT); const int mkc_ = (mk0_ >= 0 && mk0_ < L) ? mk0_ : m0; \
                    const size_t rb_ = (seqbase + ((size_t)(mkc_ + vrow) << dsh) + r) * AW + h * HD + 8 * vch; \
                    _Pragma("unroll") for (int j4 = 0; j4 < 4; ++j4) { kr[SET][j4] = *(const u32x4*)(KB + rb_ + j4 * rstep); vr[SET][j4] = *(const u32x4*)(VB + rb_ + j4 * rstep); } } while (0)
#define ATT_VTR(off) __builtin_amdgcn_ds_read_tr16_b64_v4i16((PG8_LAS v4i16_t*)(vrd + (off)))
#define ATT_VF(lo4, hi4) (bf16x8){lo4[0], lo4[1], lo4[2], lo4[3], hi4[0], hi4[1], hi4[2], hi4[3]}
#define ATT_STEP(I, KT, NEXTKT, HASNEXT) do { \
                    if (HASNEXT) ATT_ISSUE(NEXTKT, ((I) + 1) & 1); \
                    const int mk0 = m0 + 32 * (KT); const bool valid = (mk0 >= 0) && (mk0 < L); \
                    _Pragma("unroll") for (int j4 = 0; j4 < 4; ++j4) { *(PG8_LAS u32x4*)(kwr + j4 * 1024) = kr[(I) & 1][j4]; *(PG8_LAS u32x4*)(vwr + j4 * 512) = vr[(I) & 1][j4]; } \
                    f32x16 acc; \
                    { const PG8_LAS f32x4* cp = (const PG8_LAS f32x4*)(ctb + ((KT) + 2) * 4096); \
                      _Pragma("unroll") for (int rq = 0; rq < 4; ++rq) { const f32x4 c4 = cp[rq * 64]; acc[4 * rq] = c4.x; acc[4 * rq + 1] = c4.y; acc[4 * rq + 2] = c4.z; acc[4 * rq + 3] = c4.w; } } \
                    asm volatile("s_waitcnt lgkmcnt(0)" ::: "memory"); \
                    { bf16x8 kf[4]; \
                      _Pragma("unroll") for (int s4 = 0; s4 < 4; ++s4) kf[s4] = *(const PG8_LAS bf16x8*)(krd + (((2 * s4 + hi) ^ kx) * 16)); \
                      _Pragma("unroll") for (int s4 = 0; s4 < 4; ++s4) acc = __builtin_amdgcn_mfma_f32_32x32x16_bf16(kf[s4], qf[s4], acc, 0, 0, 0); } \
                    if (!valid) { _Pragma("unroll") for (int e = 0; e < 16; ++e) acc[e] = -1e30f; } \
                    float tm = fmaxf(acc[0], acc[1]); \
                    _Pragma("unroll") for (int e = 2; e < 16; ++e) tm = fmaxf(tm, acc[e]); \
                    tm = fmaxf(tm, __shfl_xor(tm, 32)); \
                    const float mn = fmaxf(m_run, tm), sc = __builtin_amdgcn_exp2f(m_run - mn); m_run = mn; \
                    float rs = 0.f; \
                    _Pragma("unroll") for (int e = 0; e < 16; ++e) { acc[e] = __builtin_amdgcn_exp2f(acc[e] - mn); rs += acc[e]; } \
                    l_part = l_part * sc + rs; \
                    _Pragma("unroll") for (int e = 0; e < 16; ++e) { o0[e] *= sc; o1[e] *= sc; } \
                    u32x4 pw0, pw1; \
                    pw0.x = cvtpk_s(acc[0], acc[1]); pw0.y = cvtpk_s(acc[2], acc[3]); pw0.z = cvtpk_s(acc[4], acc[5]); pw0.w = cvtpk_s(acc[6], acc[7]); \
                    pw1.x = cvtpk_s(acc[8], acc[9]); pw1.y = cvtpk_s(acc[10], acc[11]); pw1.z = cvtpk_s(acc[12], acc[13]); pw1.w = cvtpk_s(acc[14], acc[15]); \
                    const bf16x8 pb0 = __builtin_bit_cast(bf16x8, pw0), pb1 = __builtin_bit_cast(bf16x8, pw1); \
                    { const v4i16_t a0 = ATT_VTR(0), a1 = ATT_VTR(512), a2 = ATT_VTR(1024), a3 = ATT_VTR(1536); \
                      const v4i16_t c0 = ATT_VTR(2048), c1 = ATT_VTR(2048 + 512), c2 = ATT_VTR(2048 + 1024), c3 = ATT_VTR(2048 + 1536); \
                      o0 = __builtin_amdgcn_mfma_f32_32x32x16_bf16(ATT_VF(a0, a1), pb0, o0, 0, 0, 0); \
                      o0 = __builtin_amdgcn_mfma_f32_32x32x16_bf16(ATT_VF(a2, a3), pb1, o0, 0, 0, 0); \
                      o1 = __builtin_amdgcn_mfma_f32_32x32x16_bf16(ATT_VF(c0, c1), pb0, o1, 0, 0, 0); \
                      o1 = __builtin_amdgcn_mfma_f32_32x32x16_bf16(ATT_VF(c2, c3), pb1, o1, 0, 0, 0); } \
                    asm volatile("s_waitcnt lgkmcnt(0)" ::: "memory"); \
                } while (0)
                ATT_ISSUE(0, 0);
                ATT_STEP(0, 0, -1, true);
                ATT_STEP(1, -1, 1, true);
                ATT_STEP(2, 1, -2, true);
                ATT_STEP(3, -2, 2, true);
                ATT_STEP(4, 2, 0, false);
                const float l_b = l_part + __shfl_xor(l_part, 32);
                float fa = 0.f, fc, mm = m_run, ln = l_b;
                if (b > 0) { const float pm = AM[qtok * NH + h], pl = AL[qtok * NH + h]; mm = fmaxf(pm, m_run); fa = pl * __builtin_amdgcn_exp2f(pm - mm); fc = __builtin_amdgcn_exp2f(m_run - mm); ln = fa + l_b * fc; }
                else fc = 1.f;
                const float inv = 1.0f / ln; fa *= inv; fc *= inv;
                bf16_t* op = MIX + qtok * D + h * HD + 4 * hi;
                float ssq = 0.f;
#pragma unroll
                for (int dt = 0; dt < 2; ++dt)
#pragma unroll
                    for (int rq = 0; rq < 4; ++rq) {
                        f32x4 v;
                        if (dt == 0) v = (f32x4){o0[4 * rq], o0[4 * rq + 1], o0[4 * rq + 2], o0[4 * rq + 3]}; else v = (f32x4){o1[4 * rq], o1[4 * rq + 1], o1[4 * rq + 2], o1[4 * rq + 3]};
                        v = v * fc;
                        bf16_t* pp_ = op + 32 * dt + 8 * rq;
                        if (b > 0) { const u32x2 pw = *(const u32x2*)pp_; v = v + (f32x4){bflo(pw.x), bfhi(pw.x), bflo(pw.y), bfhi(pw.y)} * fa; }
                        ssq += sumsq4(v);
                        u32x2 w2; w2.x = cvtpk_s(v.x, v.y); w2.y = cvtpk_s(v.z, v.w); *(u32x2*)pp_ = w2;
                    }
                if (b < 2) { if (hi == 0) { AM[qtok * NH + h] = mm; AL[qtok * NH + h] = ln; } }
                else { ssq += __shfl_xor(ssq, 32); if (hi == 0) SSQA[qtok * NH + h] = ssq; }
            }
            __syncthreads();
        }
    }
#undef ATT_ISSUE
#undef ATT_STEP
#undef ATT_VTR
#undef ATT_VF
}

__device__ __forceinline__ void ph_scan(PG8_LAS unsigned char* lds, const bf16_t* __restrict__ SB, const float* __restrict__ PW, bf16_t* __restrict__ UH) {
    const int tid = tid_fresh(), seg = tid >> 5, nl = tid & 31;
    PG8_LAS float* ex = (PG8_LAS float*)lds;
    for (int it = blockIdx.x; it < NSEQ * NG * 2 * 2; it += gridDim.x) {
        const int nh = it & 1, dir = (it >> 1) & 1, g = (it >> 2) % NG, s = it / (4 * NG), n = nh * 32 + nl;
        const float* pw = PW + ((size_t)((g * 2 + dir) * NS + n) * 17 + 16) * 2;
        const float ar = pw[0], ai = pw[1];
        const size_t base = (size_t)g * NCHT + (size_t)s * NCHS; const int colo = dir * 128 + 2 * n;
        const int t0 = seg * 32;
        const int c0 = dir == 0 ? t0 : NCHS - 1 - t0; const long cstep = dir == 0 ? 1 : -1;
        const bf16_t* sp = SB + (base + c0) * 256 + colo; const long sstride = cstep * 256;
        float hr = 0.f, hi = 0.f;
#pragma unroll 8
        for (int i = 0; i < 32; ++i) { const unsigned wv = *(const unsigned*)sp; sp += sstride; const float sr = bflo(wv), si = bfhi(wv); const float nr = ar * hr - ai * hi + sr, ni = ar * hi + ai * hr + si; hr = nr; hi = ni; }
        __syncthreads();
        ex[(seg * 32 + nl) * 2] = hr; ex[(seg * 32 + nl) * 2 + 1] = hi;
        float sr_ = ar, si_ = ai;
#pragma unroll
        for (int i = 0; i < 5; ++i) { const float tr = sr_ * sr_ - si_ * si_, ti = 2.f * sr_ * si_; sr_ = tr; si_ = ti; }
        __syncthreads();
        float cr = 0.f, ci = 0.f;
        for (int j = 0; j < seg; ++j) { const float er = ex[(j * 32 + nl) * 2], ei = ex[(j * 32 + nl) * 2 + 1]; const float nr = sr_ * cr - si_ * ci + er, ni = sr_ * ci + si_ * cr + ei; cr = nr; ci = ni; }
        hr = cr; hi = ci;
        sp = SB + (base + c0) * 256 + colo; bf16_t* up = UH + (base + c0) * 512 + 256 + colo; const long ustride = cstep * 512;
#pragma unroll 8
        for (int i = 0; i < 32; ++i) { const unsigned wv = *(const unsigned*)sp; sp += sstride;
            *(unsigned*)up = pk2(hr, hi); up += ustride;
            const float sr = bflo(wv), si = bfhi(wv); const float nr = ar * hr - ai * hi + sr, ni = ar * hi + ai * hr + si; hr = nr; hi = ni; }
    }
    __syncthreads();
}


#define LAS __attribute__((address_space(3)))
#define XB_TMO      128
#define XB_XCNT(j)  (256  + 64 * (j))
#define XB_XSUB(j)  (1280 + 64 * (j))
#define XB_XGEN(j)  (2304 + 64 * (j))
#define XB_TOP      3328
#define XB_TOPGEN   3392
#define XCD_BAR_WORDS 3456
#define XB_SPIN_CAP (1u << 18)

__device__ __forceinline__ unsigned xb_ld(unsigned* p)              { return __hip_atomic_load(p, __ATOMIC_RELAXED, __HIP_MEMORY_SCOPE_AGENT); }
__device__ __forceinline__ unsigned xb_add(unsigned* p, unsigned v) { return __hip_atomic_fetch_add(p, v, __ATOMIC_RELAXED, __HIP_MEMORY_SCOPE_AGENT); }
__device__ __forceinline__ unsigned xb_xcc_id() { return (unsigned)__builtin_amdgcn_s_getreg((3 << 11) | 20) & 0xFu; }
#define XB_SPIN(cond, bar) do { unsigned _sp = 0; while (cond) { __builtin_amdgcn_s_sleep(1); \
    if ((++_sp & 255u) == 0u) { if (xb_ld(&(bar)[XB_TMO])) break; if (_sp > XB_SPIN_CAP) { atomicAdd(&(bar)[XB_TMO], 1u); break; } } } } while (0)

struct XcdBarrier {
    unsigned* bar; unsigned x;
    volatile LAS unsigned* st;
};

__device__ __forceinline__ XcdBarrier xcd_barrier_post(unsigned* bar, volatile LAS unsigned* st) {
    XcdBarrier b; b.bar = bar; b.x = xb_xcc_id(); b.st = st;
    if (threadIdx.x == 0) (void)xb_add(&bar[XB_XCNT(b.x)], 1u);
    return b;
}
__device__ __forceinline__ void xcd_barrier_complete(unsigned* bar, unsigned x, unsigned& nloc, unsigned& nx) {
    const unsigned G = gridDim.x * gridDim.y * gridDim.z;
    unsigned sum, cnt, mine, sp = 0u;
    for (;;) {
        sum = 0u; cnt = 0u; mine = 0u;
#pragma unroll
        for (unsigned j = 0; j < 16; ++j) { const unsigned c = xb_ld(&bar[XB_XCNT(j)]); sum += c; cnt += (c > 0u) ? 1u : 0u; mine = (j == x) ? c : mine; }
        if (sum == G) break;
        __builtin_amdgcn_s_sleep(1);
        if ((++sp & 255u) == 0u) { if (xb_ld(&bar[XB_TMO])) break; if (sp > XB_SPIN_CAP) { atomicAdd(&bar[XB_TMO], 1u); break; } }
    }
    nloc = mine > 0u ? mine : 1u; nx = cnt > 0u ? cnt : 1u;
}

__device__ __forceinline__ void xcd_barrier(const XcdBarrier& b) {
    asm volatile("s_waitcnt vmcnt(0)" ::: "memory");
    __syncthreads();
    if (threadIdx.x == 0) {
        unsigned* bar = b.bar;
        __builtin_amdgcn_s_waitcnt(0);
        unsigned nloc = b.st[0], nx = b.st[1];
        if (nloc == 0u) { xcd_barrier_complete(bar, b.x, nloc, nx); b.st[0] = nloc; b.st[1] = nx; }
        const unsigned old = xb_add(&bar[XB_XSUB(b.x)], 1u);
        const unsigned gen = old / nloc;
        if (old + 1u == (gen + 1u) * nloc) {
            __builtin_amdgcn_fence(__ATOMIC_RELEASE, "agent");
            asm volatile("s_waitcnt vmcnt(0)" ::: "memory");
            const unsigned og = xb_add(&bar[XB_TOP], 1u);
            const unsigned tg = og / nx;
            if (og + 1u == (tg + 1u) * nx) xb_add(&bar[XB_TOPGEN], 1u);
            else XB_SPIN(xb_ld(&bar[XB_TOPGEN]) == tg, bar);
            __builtin_amdgcn_fence(__ATOMIC_ACQUIRE, "agent");
            xb_add(&bar[XB_XGEN(b.x)], 1u);
            asm volatile("s_waitcnt vmcnt(0)" ::: "memory");
        } else {
            XB_SPIN(xb_ld(&bar[XB_XGEN(b.x)]) == gen, bar);
            __builtin_amdgcn_fence(__ATOMIC_ACQUIRE, "agent");
            asm volatile("s_waitcnt vmcnt(0)" ::: "memory");
        }
    }
    __syncthreads();
}
constexpr int LDS_BYTES = 147456;
struct Args { const float* in[27]; float* out; unsigned char* ws; };
template <class Epi>
__device__ __forceinline__ void run_gemm(PG8_LAS unsigned char* lds, const bf16_t* A, int lda, const bf16_t* Bt, int ldb, int M, int N, int K, int khb, int split, int bdiv, const Epi& E) {
    pg8::Gemm g{A, Bt, lda, ldb, K, khb}; pg8::Order S; S.init(M, N, (int)gridDim.x, (int)blockIdx.x, split, bdiv);
    pg8::gemm_phase<Epi, pg8::Order, true, true>(lds, g, S, E);
}
__global__ void __launch_bounds__(NTHR, 2) mega(Args a) {
    extern __shared__ __attribute__((aligned(16))) unsigned char lds_raw[];
    PG8_LAS unsigned char* lds = (PG8_LAS unsigned char*)lds_raw;
    cg::grid_group grid = cg::this_grid();
    unsigned* xbar = (unsigned*)(a.ws + WS_CTL);
    volatile LAS unsigned* xst = (volatile LAS unsigned*)(lds + 131072);
    if (threadIdx.x < 2) xst[threadIdx.x] = 0u;
    if (blockIdx.x == 0) for (int i_ = threadIdx.x; i_ < XCD_BAR_WORDS; i_ += NTHR) xbar[i_] = 0u;
    __syncthreads();
    const float *xp = a.in[0], *xs = a.in[1], *pp = a.in[2], *ps = a.in[3], *rel_bias = a.in[4], *g_mix = a.in[5], *w_in = a.in[6];
    const float *a_re = a.in[7], *a_im = a.in[8], *log_dt = a.in[9], *b_re = a.in[10], *b_im = a.in[11], *c_re = a.in[12], *c_im = a.in[13], *ssm_d = a.in[14];
    const float *w_glu = a.in[15], *b_glu = a.in[16], *g_att = a.in[17], *g_ssm = a.in[18], *w_out = a.in[19], *g_mlp = a.in[20], *w_mlp1 = a.in[21], *w_mlp2 = a.in[22];
    const float *g_ple = a.in[23], *w_gate = a.in[24], *w_proj = a.in[25], *g_final = a.in[26];
    unsigned char* ws = a.ws; unsigned char* dob = (unsigned char*)a.out;
    float* BIAS = (float*)(ws + WS_BIAS); float* PW = (float*)(ws + WS_PW); float* BBt = (float*)(ws + WS_BB); float* KT = (float*)(ws + WS_KT);
    float *RS0 = (float*)(ws + WS_RS0), *SSQA = (float*)(ws + WS_SSQA), *SSQS = (float*)(ws + WS_SSQS), *SSQ1 = (float*)(ws + WS_SSQ1), *SSQ2 = (float*)(ws + WS_SSQ2);
    bf16_t *WGT = (bf16_t*)(ws + WS_WGT), *WPT = (bf16_t*)(ws + WS_WPT);
    bf16_t *W1T = (bf16_t*)(dob + DO_W1T), *W2T = (bf16_t*)(dob + DO_W2T), *PB = (bf16_t*)(dob + DO_PB);
    bf16_t *WINT = (bf16_t*)(dob + DO_WINT), *WOUTT = (bf16_t*)(dob + DO_WOUTT), *WGLUT = (bf16_t*)(dob + DO_WGLUT), *WST = (bf16_t*)(dob + DO_WST), *WYT = (bf16_t*)(dob + DO_WYT);
    bf16_t *SB = (bf16_t*)(dob + DO_SB), *QB = (bf16_t*)(ws + WS_QB), *KB = (bf16_t*)(ws + WS_KB), *VB = (bf16_t*)(ws + WS_VB), *UH = (bf16_t*)(ws + WS_UH);
    bf16_t *MIX = (bf16_t*)(ws + WS_MIX), *GB = (bf16_t*)(ws + WS_GB), *HID = (bf16_t*)(ws + WS_HID), *PP = (bf16_t*)(ws + WS_PP);
    float* H3F = (float*)(ws + WS_H3F);
    bf16_t *XB = (bf16_t*)(dob + DO_XB), *H1B = (bf16_t*)(ws + WS_HB), *H2B = (bf16_t*)(ws + WS_HB);
#ifndef PROBE_MASK
#define PROBE_MASK 0
#endif
#define PHASE(id) _Pragma("unroll 1") for (int rep_ = 0; rep_ < (((PROBE_MASK) >> (id)) & 1) + 1; ++rep_)
    PHASE(0) {
        ph_prep_wt(lds, w_in, D, INC, g_mix, g_mix, D, WINT, D, AW, C2);
        ph_prep_wt(lds, w_glu, SW, SW, nullptr, nullptr, SW, WGLUT, SW, 0, 1.f);
        ph_prep_wt(lds, w_out, D, D, g_att, g_ssm, AW, WOUTT, D, 0, 1.f);
        ph_prep_wt(lds, w_mlp1, D, DFF, g_mlp, g_mlp, D, W1T, D, 0, 1.f);
        ph_prep_wt(lds, w_mlp2, DFF, D, nullptr, nullptr, DFF, W2T, DFF, 0, 1.f);
        ph_prep_wt(lds, w_gate, D, D, g_ple, g_ple, D, WGT, D, 0, 1.f);
        ph_prep_wt(lds, w_proj, PLE, D, nullptr, nullptr, PLE, WPT, PLE, 0, 1.f);
        ph_prep_bias(rel_bias, BIAS);
        ph_ssm_tab(a_re, a_im, log_dt, b_re, b_im, PW, BBt);
        ph_rows_x(xp, xs, XB, RS0);
        ph_cvt_p(pp, ps, PB);
        grid.sync();
    }
    const XcdBarrier xb = xcd_barrier_post(xbar, xst);
    PHASE(1) {
        ph_ssm_ws(PW, BBt, WST);
        ph_ssm_kt(PW, BBt, c_re, c_im, KT);
        ph_ssm_wy_carry(PW, c_re, c_im, WYT);
        run_gemm(lds, XB, D, WINT, D, NT, INC, D, 0, 0, 0, EpiIn{RS0, QB, KB, VB, UH});
        xcd_barrier(xb);
    }
    PHASE(2) {
        ph_ssm_wy_fill(KT, ssm_d, WYT);
        ph_attn<0>(lds, QB, KB, VB, BIAS, MIX, (float*)(ws + WS_AM), (float*)(ws + WS_AL), SSQA);
    }
    PHASE(3) {
        run_gemm(lds, UH, 512, WST, 256, NG * NCHT, 256, 256, 0, 0, NCHT / 256, EpiS{SB});
        xcd_barrier(xb);
    }
    PHASE(4) {
        ph_scan(lds, SB, PW, UH);
        ph_attn<1>(lds, QB, KB, VB, BIAS, MIX, (float*)(ws + WS_AM), (float*)(ws + WS_AL), SSQA);
        xcd_barrier(xb);
    }
    PHASE(5) {
        run_gemm(lds, UH, 512, WYT, 512, NG * NCHT, 256, 512, 0, 0, NCHT / 256, EpiY{GB});
        xcd_barrier(xb);
    }
    PHASE(6) {
        run_gemm(lds, GB, SW, WGLUT, SW, NT, SW, SW, 0, 0, 0, EpiGlu{GB, b_glu, MIX, SSQS});
        xcd_barrier(xb);
    }
    PHASE(7) {
        run_gemm(lds, MIX, D, WOUTT, D, NT, D, AW, AW * 2, 1, 0, EpiOut{xp, xs, SSQA, SSQS, H1B, SSQ1});
        xcd_barrier(xb);
    }
    PHASE(8) {
        run_gemm(lds, H1B, D, W1T, D, NT, DFF, D, 0, 0, 0, EpiMlp1{SSQ1, HID});
        xcd_barrier(xb);
    }
    PHASE(9) {
        run_gemm(lds, HID, DFF, W2T, DFF, NT, D, DFF, 0, 0, 0, EpiMlp2{H1B, H2B, SSQ2});
        xcd_barrier(xb);
    }
    PHASE(10) {
        run_gemm(lds, PB, PLE, WPT, PLE, NT, D, PLE, 0, 0, 0, EpiPP{PP});
        xcd_barrier(xb);
    }
    PHASE(11) {
        run_gemm(lds, H2B, D, WGT, D, NT, D, D, 0, 0, 0, EpiGate{SSQ2, H2B, PP, H3F});
        xcd_barrier(xb);
    }
    PHASE(12) {
        ph_final(H3F, g_final, a.out);
    }
}

extern "C" void kernel_launch(void* const* d_in, const int* in_sizes, int n_in, void* d_out, int out_size, void* d_ws, size_t ws_size, hipStream_t stream) {
    static int grid_blocks = 0;
    if (n_in != 27 || ws_size < WS_END || out_size != NT * D) { fprintf(stderr, "kernel_launch: unexpected sizes n_in %d ws %zu out %d\n", n_in, ws_size, out_size); return; }
    if (!grid_blocks) {
        int dev = 0, cus = 0, per_cu = 0;
        (void)hipGetDevice(&dev);
        (void)hipDeviceGetAttribute(&cus, hipDeviceAttributeMultiprocessorCount, dev);
        if (hipFuncSetAttribute((const void*)mega, hipFuncAttributeMaxDynamicSharedMemorySize, LDS_BYTES) != hipSuccess) { fprintf(stderr, "kernel_launch: hipFuncSetAttribute failed\n"); return; }
        (void)hipOccupancyMaxActiveBlocksPerMultiprocessor(&per_cu, mega, NTHR, LDS_BYTES);
        if (per_cu < 1) { fprintf(stderr, "kernel_launch: occupancy query says %d blocks per CU\n", per_cu); return; }
        grid_blocks = cus;
    }
    Args a{};
    for (int i = 0; i < 27; ++i) a.in[i] = (const float*)d_in[i];
    a.out = (float*)d_out; a.ws = (unsigned char*)d_ws;
    void* args[] = {&a};
    hipError_t e = hipLaunchCooperativeKernel((void*)mega, dim3(grid_blocks), dim3(NTHR), args, LDS_BYTES, stream);
    if (e != hipSuccess) fprintf(stderr, "cooperative launch failed: %s (grid %d)\n", hipGetErrorString(e), grid_blocks);
}
```

```cpp
#include <hip/hip_runtime.h>
#include <hip/hip_cooperative_groups.h>
namespace cg = cooperative_groups;
#include <cstdio>
#include <cstdint>
#include <cmath>

typedef unsigned short bf16_t;
typedef short bf16x8 __attribute__((ext_vector_type(8)));
typedef float f32x4 __attribute__((ext_vector_type(4)));
typedef unsigned u32x2 __attribute__((ext_vector_type(2)));
typedef unsigned u32x4 __attribute__((ext_vector_type(4)));

constexpr int NT = 49152, SEQ = 8192, NSEQ = 6, NPROMPT = 16384;
constexpr int D = 1024, DFF = 4096, PLE = 256, INC = 2048, AW = 512, SW = 512;
constexpr int NH = 8, HD = 64, NG = 32, GC = 16, NS = 64;
constexpr int TCH = 16, NCHT = NT / TCH  , NCHS = SEQ / TCH  ;
constexpr float EPS = 1e-6f;
constexpr float LOG2E = 1.4426950408889634f;
constexpr float C2 = 0.125f * LOG2E;

constexpr size_t MiB = 1u << 20;
constexpr size_t WS_BIAS = 0;
constexpr size_t WS_PW = 64 * 1024;
constexpr size_t WS_BB = 1 * MiB;
constexpr size_t WS_KT = 1536 * 1024;
constexpr size_t WS_RS0 = 2560 * 1024;
constexpr size_t WS_SSQA = 3 * MiB;
constexpr size_t WS_SSQS = 4608 * 1024;
constexpr size_t WS_SSQ1 = 6 * MiB;
constexpr size_t WS_SSQ2 = 9 * MiB;
constexpr size_t WS_SSQ3 = 12 * MiB;
constexpr size_t WS_AM = 15 * MiB;
constexpr size_t WS_AL = WS_AM + 1536 * 1024;
constexpr size_t WS_WGT = 18 * MiB, WS_WPT = 20 * MiB;
constexpr size_t WS_CTL = 20 * MiB + 512 * 1024;
constexpr size_t WS_HB = 32 * MiB;
constexpr size_t WS_QB = 128 * MiB, WS_KB = 176 * MiB, WS_VB = 224 * MiB;
constexpr size_t WS_UH = 272 * MiB;
constexpr size_t WS_MIX = 368 * MiB;
constexpr size_t WS_GB = 464 * MiB;
constexpr size_t WS_HID = 128 * MiB;
constexpr size_t WS_PP = 128 * MiB;
constexpr size_t WS_H3F = 224 * MiB;
constexpr size_t WS_END = 512 * MiB;
static_assert(WS_KB - WS_QB == (size_t)NT * AW * 2 && WS_VB - WS_KB == (size_t)NT * AW * 2, "QB | KB | VB contiguous");
constexpr size_t DO_XB = 0;
constexpr size_t WS_SB = 32 * MiB;
constexpr size_t DO_W1T = 96 * MiB, DO_W2T = 104 * MiB, DO_WINT = 112 * MiB, DO_WOUTT = 116 * MiB, DO_WGLUT = 118 * MiB, DO_WST = 119 * MiB, DO_WYT = 123 * MiB, DO_PB = 131 * MiB;

__device__ __forceinline__ unsigned f2bf(float f) { unsigned u = __builtin_bit_cast(unsigned, f); return (u + 0x7fffu + ((u >> 16) & 1u)) >> 16; }
__device__ __forceinline__ unsigned pk2(float lo, float hi) { return f2bf(lo) | (f2bf(hi) << 16); }
__device__ __forceinline__ float bf2f(unsigned short b) { return __builtin_bit_cast(float, (unsigned)b << 16); }
__device__ __forceinline__ float bflo(unsigned w) { return __builtin_bit_cast(float, w << 16); }
__device__ __forceinline__ float bfhi(unsigned w) { return __builtin_bit_cast(float, w & 0xffff0000u); }
__device__ __forceinline__ float sumsq4(f32x4 v) { return (v.x * v.x + v.y * v.y) + (v.z * v.z + v.w * v.w); }
__device__ __forceinline__ float wave_sum(float v) {
#pragma unroll
    for (int o = 1; o < 64; o <<= 1) v += __shfl_xor(v, o);
    return v;
}
__device__ __forceinline__ const float* xrow(const float* xp, const float* xs, int tok, int width) {
    return tok < NPROMPT ? xp + (size_t)tok * width : xs + (size_t)(tok - NPROMPT) * width;
}


constexpr int NTHR = 512;
#define PG8_LAS __attribute__((address_space(3)))
__device__ __forceinline__ int tid_fresh() { int t = threadIdx.x; asm volatile("" : "+v"(t)); return t; }
__device__ __forceinline__ size_t gtid_fresh() { return (size_t)blockIdx.x * NTHR + tid_fresh(); }
#define GTID gtid_fresh()
#define GSIZE ((size_t)gridDim.x * NTHR)

__device__ __forceinline__ void ph_prep_wt(PG8_LAS unsigned char* lds, const float* __restrict__ W, int K, int N, const float* __restrict__ g1, const float* __restrict__ g2, int ksplit,
                                           bf16_t* __restrict__ out, int ldo, int nscale, float sc) {
    const int tid = tid_fresh(), lane = tid & 63, wave = tid >> 6;
    PG8_LAS float* scr = (PG8_LAS float*)(lds + wave * 8448);
    const int nblk = N / 32, nitems = (K / 64) * nblk;
    for (int item = blockIdx.x * 8 + wave; item < nitems; item += gridDim.x * 8) {
        const int kb = item / nblk, nb = item % nblk, k0 = 64 * kb, n0 = 32 * nb;
#pragma unroll 8
        for (int i = 0; i < 32; ++i) { const int kk = 2 * i + (lane >> 5), k = k0 + kk; float gv = 1.f; if (g1) { const float* gp = (k < ksplit) ? (g1 + k) : (g2 + (k - ksplit)); gv = *gp; }
            scr[kk * 33 + (lane & 31)] = W[(size_t)k * N + n0 + (lane & 31)] * gv; }
        asm volatile("s_waitcnt lgkmcnt(0)" ::: "memory");
        const int c = lane & 7;
#pragma unroll
        for (int j = 0; j < 4; ++j) { const int n = (lane >> 3) + 8 * j; const PG8_LAS float* sp = scr + (8 * c) * 33 + n; const float cs = (n0 + n) < nscale ? sc : 1.f;
            u32x4 o; o.x = pk2(sp[0 * 33] * cs, sp[1 * 33] * cs); o.y = pk2(sp[2 * 33] * cs, sp[3 * 33] * cs); o.z = pk2(sp[4 * 33] * cs, sp[5 * 33] * cs); o.w = pk2(sp[6 * 33] * cs, sp[7 * 33] * cs);
            *(u32x4*)(out + (size_t)(n0 + n) * ldo + k0 + 8 * c) = o; }
        asm volatile("s_waitcnt lgkmcnt(0)" ::: "memory");
    }
}
__device__ __forceinline__ int t5_bucket(int rel) {
    int n = -rel; int ret = n < 0 ? 16 : 0; n = n < 0 ? -n : n;
    if (n < 8) return ret + n;
    int large = 8 + (int)(log((double)n / 8.0) / log(128.0) * 8.0);
    large = large < 15 ? large : 15;
    return ret + large;
}
__device__ __forceinline__ void ph_prep_bias(const float* __restrict__ rel_bias, float* __restrict__ bias) {
    for (size_t i = GTID; i < 3 * 8 * 129; i += GSIZE) {
        const int o = (int)(i % 129), h = (int)((i / 129) % 8), b = (int)(i / (129 * 8));
        const int dil = b == 0 ? 1 : (b == 1 ? 4 : 16);
        bias[i] = rel_bias[t5_bucket((o - 64) * dil) * NH + h] * LOG2E;
    }
}
__device__ __forceinline__ void ph_rows_x(const float* __restrict__ xp, const float* __restrict__ xs, bf16_t* __restrict__ XB, float* __restrict__ RS0) {
    const int tidf = tid_fresh(), lane = tidf & 63;
    for (int row0 = (blockIdx.x * 8 + (tidf >> 6)) * 4; row0 < NT; row0 += gridDim.x * 32) {
        f32x4 v[4][4];
#pragma unroll
        for (int r = 0; r < 4; ++r) { const f32x4* xr = (const f32x4*)xrow(xp, xs, row0 + r, D) + lane;
#pragma unroll
            for (int j = 0; j < 4; ++j) v[r][j] = xr[64 * j]; }
#pragma unroll
        for (int r = 0; r < 4; ++r) { float s = 0.f;
#pragma unroll
            for (int j = 0; j < 4; ++j) s += sumsq4(v[r][j]);
            s = wave_sum(s);
            u32x2* o = (u32x2*)(XB + (size_t)(row0 + r) * D) + lane;
#pragma unroll
            for (int j = 0; j < 4; ++j) { u32x2 w; w.x = pk2(v[r][j].x, v[r][j].y); w.y = pk2(v[r][j].z, v[r][j].w); o[64 * j] = w; }
            if (lane == 0) RS0[row0 + r] = 1.0f / sqrtf(s * (1.0f / D) + EPS); }
    }
}
__device__ __forceinline__ void ph_cvt_p(const float* __restrict__ pp, const float* __restrict__ ps, bf16_t* __restrict__ PB) {
    for (size_t i = GTID; i < (size_t)NT * PLE / 4; i += GSIZE) {
        const int tok = (int)(i / (PLE / 4)), c4 = (int)(i % (PLE / 4));
        const f32x4 v = *((const f32x4*)xrow(pp, ps, tok, PLE) + c4);
        u32x2 w; w.x = pk2(v.x, v.y); w.y = pk2(v.z, v.w);
        *((u32x2*)(PB + (size_t)tok * PLE) + c4) = w;
    }
}
__device__ __forceinline__ void ph_ssm_tab(const float* __restrict__ a_re, const float* __restrict__ a_im, const float* __restrict__ log_dt,
                          const float* __restrict__ b_re, const float* __restrict__ b_im, float* __restrict__ PW, float* __restrict__ BB) {
    for (size_t ii = GTID; ii < (size_t)NG * 2 * NS * 17; ii += GSIZE) {
        const int i = (int)(ii / 17), e = (int)(ii % 17);
        const int n = i % NS, dir = (i / NS) % 2, g = i / (2 * NS);
        const int pi = (dir * NG + g) * NS + n;
        const double ar = a_re[pi], ai = a_im[pi], dt = exp((double)log_dt[dir * NG + g]);
        const double mag = exp(ar * dt * e), ang = ai * dt * e;
        float* pw = PW + ((size_t)((g * 2 + dir) * NS + n) * 17 + e) * 2;
        pw[0] = (float)(mag * cos(ang)); pw[1] = (float)(mag * sin(ang));
    }
    for (size_t ii = GTID; ii < (size_t)NG * 2 * NS; ii += GSIZE) {
        const int i = (int)ii;
        const int n = i % NS, dir = (i / NS) % 2, g = i / (2 * NS);
        const int pi = (dir * NG + g) * NS + n;
        const double ar = a_re[pi], ai = a_im[pi], dt = exp((double)log_dt[dir * NG + g]);
        const double abr = exp(ar * dt) * cos(ai * dt), abi = exp(ar * dt) * sin(ai * dt), inv = 1.0 / (ar * ar + ai * ai);
        const double fr = ((abr - 1.0) * ar + abi * ai) * inv, fi = (abi * ar - (abr - 1.0) * ai) * inv;
        float* bb = BB + (size_t)((g * 2 + dir) * NS + n) * GC * 2;
        for (int h = 0; h < GC; ++h) { const double br = b_re[(size_t)pi * GC + h], bi = b_im[(size_t)pi * GC + h]; bb[2 * h] = (float)(fr * br - fi * bi); bb[2 * h + 1] = (float)(fr * bi + fi * br); }
    }
}
__device__ __forceinline__ void ph_ssm_kt(const float* __restrict__ PW, const float* __restrict__ BB, const float* __restrict__ c_re, const float* __restrict__ c_im, float* __restrict__ KT) {
    for (size_t ii = GTID; ii < (size_t)NG * 2 * 16 * GC; ii += GSIZE) {
        const int i = (int)ii, h = i % GC, e = (i / GC) % 16, dir = (i / (GC * 16)) % 2, g = i / (GC * 16 * 2);
        float acc[GC];
#pragma unroll
        for (int hp = 0; hp < GC; ++hp) acc[hp] = 0.f;
        for (int n = 0; n < NS; ++n) {
            const float* pw = PW + ((size_t)((g * 2 + dir) * NS + n) * 17 + e) * 2; const size_t ci = ((size_t)(dir * NG + g) * GC + h) * NS + n;
            const float cr = c_re[ci], cim = c_im[ci], tr = cr * pw[0] - cim * pw[1], ti = cr * pw[1] + cim * pw[0];
            const f32x4* bb = (const f32x4*)(BB + (size_t)((g * 2 + dir) * NS + n) * GC * 2);
#pragma unroll
            for (int q4 = 0; q4 < 8; ++q4) { const f32x4 b4 = bb[q4]; acc[2 * q4] += tr * b4.x - ti * b4.y; acc[2 * q4 + 1] += tr * b4.z - ti * b4.w; }
        }
        f32x4* o = (f32x4*)(KT + (size_t)i * GC);
#pragma unroll
        for (int q4 = 0; q4 < 4; ++q4) o[q4] = (f32x4){acc[4 * q4], acc[4 * q4 + 1], acc[4 * q4 + 2], acc[4 * q4 + 3]};
    }
}
__device__ __forceinline__ void ph_ssm_ws(const float* __restrict__ PW, const float* __restrict__ BB, bf16_t* __restrict__ WST) {
    for (size_t ii = GTID; ii < (size_t)NG * 256 * 32; ii += GSIZE) {
        const int i = (int)ii, ko = i % 32, col = (i / 32) % 256, g = i / 8192;
        const int j = ko >> 1, hp0 = (ko & 1) * 8, dir = col / 128, n = (col % 128) / 2, ri = col & 1;
        const int e = dir == 0 ? 15 - j : j;
        const float* pw = PW + ((size_t)((g * 2 + dir) * NS + n) * 17 + e) * 2; const float* bb = BB + ((size_t)((g * 2 + dir) * NS + n) * GC + hp0) * 2;
        const float pr = pw[0], pi = pw[1]; float v[8];
#pragma unroll
        for (int t = 0; t < 8; ++t) v[t] = ri ? (pr * bb[2 * t + 1] + pi * bb[2 * t]) : (pr * bb[2 * t] - pi * bb[2 * t + 1]);
        u32x4 o; o.x = pk2(v[0], v[1]); o.y = pk2(v[2], v[3]); o.z = pk2(v[4], v[5]); o.w = pk2(v[6], v[7]);
        *(u32x4*)(WST + (size_t)(g * 256 + col) * 256 + ko * 8) = o;
    }
}
__device__ __forceinline__ void ph_ssm_wy_carry(const float* __restrict__ PW, const float* __restrict__ c_re, const float* __restrict__ c_im, bf16_t* __restrict__ WYT) {
    for (size_t ii = GTID; ii < (size_t)NG * 256 * 32; ii += GSIZE) {
        const int i = (int)ii, ko = i % 32, jh = (i / 32) % 256, g = i / 8192;
        const int j = jh / 16, h = jh % 16, dir = ko / 16, n0 = (ko % 16) * 4;
        const int e = dir == 0 ? j + 1 : 16 - j; float v[8];
#pragma unroll
        for (int t = 0; t < 4; ++t) { const int n = n0 + t; const float* pw = PW + ((size_t)((g * 2 + dir) * NS + n) * 17 + e) * 2; const size_t ci = ((size_t)(dir * NG + g) * GC + h) * NS + n;
            const float cr = c_re[ci], cim = c_im[ci]; v[2 * t] = cr * pw[0] - cim * pw[1]; v[2 * t + 1] = -(cr * pw[1] + cim * pw[0]); }
        u32x4 o; o.x = pk2(v[0], v[1]); o.y = pk2(v[2], v[3]); o.z = pk2(v[4], v[5]); o.w = pk2(v[6], v[7]);
        *(u32x4*)(WYT + (size_t)(g * 256 + jh) * 512 + 256 + ko * 8) = o;
    }
}
__device__ __forceinline__ void ph_ssm_wy_fill(const float* __restrict__ KT, const float* __restrict__ dd, bf16_t* __restrict__ WYT) {
    for (size_t ii = GTID; ii < (size_t)NG * 256 * 32; ii += GSIZE) {
        const int i = (int)ii, ko = i % 32, jh = (i / 32) % 256, g = i / 8192;
        const int j = jh / 16, h = jh % 16, jp = ko >> 1, hp0 = (ko & 1) * 8;
        float v[8];
#pragma unroll
        for (int t = 0; t < 8; ++t) v[t] = 0.f;
        if (j >= jp) { const float* kt = KT + ((size_t)((g * 2 + 0) * 16 + (j - jp)) * GC + h) * GC + hp0;
#pragma unroll
            for (int t = 0; t < 8; ++t) v[t] += kt[t]; }
        if (jp >= j) { const float* kt = KT + ((size_t)((g * 2 + 1) * 16 + (jp - j)) * GC + h) * GC + hp0;
#pragma unroll
            for (int t = 0; t < 8; ++t) v[t] += kt[t]; }
        if (jp == j) { const float dv = dd[g * GC + h];
#pragma unroll
            for (int t = 0; t < 8; ++t) if (hp0 + t == h) v[t] += dv; }
        u32x4 o; o.x = pk2(v[0], v[1]); o.y = pk2(v[2], v[3]); o.z = pk2(v[4], v[5]); o.w = pk2(v[6], v[7]);
        *(u32x4*)(WYT + (size_t)(g * 256 + jh) * 512 + ko * 8) = o;
    }
}

__device__ __forceinline__ void st_bf4(bf16_t* p, f32x4 v) { u32x2 w; w.x = pk2(v.x, v.y); w.y = pk2(v.z, v.w); *(u32x2*)p = w; }
__device__ __forceinline__ f32x4 ld_bf4(const bf16_t* p) { const u32x2 w = *(const u32x2*)p; return (f32x4){bflo(w.x), bfhi(w.x), bflo(w.y), bfhi(w.y)}; }
namespace pg8 {
constexpr int BM = 256, BK = 64, HALF = 128, HTB = HALF * BK * 2  , STAGE_BYTES = 8 * HTB, NXCD = 8, WGM = 8;

__host__ __device__ __forceinline__ int lds_byte(int r, int c) { const int st = (r >> 4) * 2 + (c >> 5), rr = r & 15, cc = c & 31, ob = rr * 64 + cc * 2; return st * 1024 + (ob ^ (((ob >> 9) & 1) << 5)); }
__host__ __device__ __forceinline__ void stage_rc(int b, int& R, int& C) { const int st = b / 1024, sb = b % 1024, swz = sb ^ (((sb >> 9) & 1) << 5); R = (st >> 1) * 16 + swz / 64; C = (st & 1) * 32 + (swz % 64) / 2; }
__host__ __device__ __forceinline__ int perm32(int rho) { const int n = rho >> 4, i = rho & 15; return 8 * (i >> 2) + 4 * n + (i & 3); }
struct Unit { int pm, pn, kh; };
struct Gemm { const bf16_t* A; const bf16_t* Bt; int lda, ldb, K, khb; };
struct Order {
    int nM, nN, nwg, G, c, split, bdiv;
    __device__ void init(int M, int N, int G_, int c_, int split_ = 0, int bdiv_ = 0) { nM = M / BM; nN = N / BM; nwg = nM * nN; G = G_; c = c_; split = split_; bdiv = bdiv_; }
    __device__ bool next(int i, Unit& u) const {
        const int ti = split ? (i >> 1) : i;
        const long L = (long)ti * G + c; if (L >= nwg) return false;
        int wgid = (int)L; { const int q = nwg / NXCD, r = nwg % NXCD, xcd = wgid % NXCD, off = wgid / NXCD; wgid = (xcd < r ? xcd * (q + 1) : r * (q + 1) + (xcd - r) * q) + off; }
        const int nig = WGM * nN, gid = wgid / nig, fm = gid * WGM, gsz = (nM - fm) < WGM ? (nM - fm) : WGM;
        u.pm = fm + ((wgid % nig) % gsz); u.pn = (wgid % nig) / gsz; u.kh = split ? (i & 1) : 0;
        if (bdiv) u.pn = u.pm / bdiv;
        return true;
    }
    __device__ __forceinline__ void a_ready(const Unit&) const {}
    __device__ __forceinline__ void done(const Unit&) const {}
};
__device__ __forceinline__ unsigned cvt_pk_bf16(float lo, float hi) { unsigned r; asm volatile("v_cvt_pk_bf16_f32 %0, %1, %2" : "=v"(r) : "v"(lo), "v"(hi)); return r; }
template <class Epi, class Sched, bool ALIGN_EPI = false, bool SP2 = false>
__device__ __forceinline__ void gemm_phase(PG8_LAS unsigned char* lds, const Gemm g, const Sched& S, const Epi& E) {
    const int tid = tid_fresh(), wid = __builtin_amdgcn_readfirstlane(tid >> 6), lane = tid & 63, wr = wid >> 2, wc = wid & 3, fr = lane & 15, fq = lane >> 4;
    const int K = g.K, nt = K / BK;
    unsigned voffA[2], voffB[2];
#pragma unroll
    for (int i = 0; i < 2; ++i) { int R, C; stage_rc(tid * 16 + i * 8192, R, C); const int Rb = Epi::PERM ? ((R & ~31) + perm32(R & 31)) : R;
        voffA[i] = (unsigned)(R * g.lda + C) * 2u; voffB[i] = (unsigned)(Rb * g.ldb + C) * 2u; }
    const size_t kstep = (size_t)(BK * 2);
    const size_t hstepA = (size_t)HALF * g.lda * 2, hstepB = (size_t)HALF * g.ldb * 2;
    const size_t tstepA = 2 * hstepA, tstepB = 2 * hstepB;
    const unsigned ldsw = (unsigned)wid * 1024u;
    const int aoff = lds_byte(wr * 64 + fr, fq * 8), boff = lds_byte(wc * 32 + fr, fq * 8);
#define PG8_SA(b, h) (((b) * 2 + (h)) * HTB)
#define PG8_SB(b, h) ((4 + (b) * 2 + (h)) * HTB)
#define PG8_STAGE(bufoff, gbase, voff) do { _Pragma("unroll") for (int _i = 0; _i < 2; ++_i) \
        __builtin_amdgcn_global_load_lds((const unsigned*)((const char*)(gbase) + (voff)[_i]), (PG8_LAS unsigned*)(lds + (bufoff) + ldsw + _i * 8192), 16, 0, 0); } while (0)
#define PG8_LDA(dst, b, h) do { _Pragma("unroll") for (int m = 0; m < 4; ++m) _Pragma("unroll") for (int k = 0; k < 2; ++k) dst[m][k] = *(const PG8_LAS bf16x8*)(lds + PG8_SA(b, h) + aoff + m * 2048 + k * 1024); } while (0)
#define PG8_LDB(dst, b, h) do { _Pragma("unroll") for (int n = 0; n < 2; ++n) _Pragma("unroll") for (int k = 0; k < 2; ++k) dst[n][k] = *(const PG8_LAS bf16x8*)(lds + PG8_SB(b, h) + boff + n * 2048 + k * 1024); } while (0)
#define PG8_MMA(ai, bj, At, Bt) do { __builtin_amdgcn_s_setprio(1); _Pragma("unroll") for (int m = 0; m < 4; ++m) _Pragma("unroll") for (int n = 0; n < 2; ++n) _Pragma("unroll") for (int k = 0; k < 2; ++k) \
        acc[ai][bj][m][n] = __builtin_amdgcn_mfma_f32_16x16x32_bf16(Bt[n][k], At[m][k], acc[ai][bj][m][n], 0, 0, 0); __builtin_amdgcn_s_setprio(0); } while (0)
#define PG8_WAIT_V(n) asm volatile("s_waitcnt vmcnt(" #n ")" ::: "memory")
#define PG8_WAIT_L(n) asm volatile("s_waitcnt lgkmcnt(" #n ")" ::: "memory")
#define PG8_BAR __builtin_amdgcn_s_barrier()
#define PG8_SCHED __builtin_amdgcn_sched_barrier(0)
    Unit cur, nxt; int ui = 0;
    if (!S.next(0, cur)) return;
    f32x4 acc[2][2][4][2];
#pragma unroll
    for (int a = 0; a < 2; ++a)
#pragma unroll
        for (int b = 0; b < 2; ++b)
#pragma unroll
            for (int m = 0; m < 4; ++m)
#pragma unroll
                for (int n = 0; n < 2; ++n) acc[a][b][m][n] = (f32x4){0.f, 0.f, 0.f, 0.f};
    bf16x8 At[4][2], B0[2][2], B1[2][2];
    const char* cA = (const char*)g.A + (size_t)cur.pm * tstepA + (size_t)cur.kh * g.khb; const char* cB = (const char*)g.Bt + (size_t)cur.pn * tstepB + (size_t)cur.kh * g.khb;
    S.a_ready(cur);
    if constexpr (SP2) {
        PG8_STAGE(PG8_SB(0, 0), cB, voffB); PG8_STAGE(PG8_SB(0, 1), cB + hstepB, voffB); PG8_STAGE(PG8_SA(0, 0), cA, voffA); PG8_STAGE(PG8_SA(0, 1), cA + hstepA, voffA);
        if (wr == 1) PG8_BAR;
        PG8_WAIT_V(2); PG8_BAR;
        PG8_STAGE(PG8_SB(1, 0), cB + kstep, voffB); PG8_STAGE(PG8_SA(1, 0), cA + kstep, voffA); PG8_STAGE(PG8_SB(1, 1), cB + hstepB + kstep, voffB);
        PG8_WAIT_V(6); PG8_BAR;
    } else {
        PG8_STAGE(PG8_SB(0, 0), cB, voffB); PG8_STAGE(PG8_SA(0, 0), cA, voffA); PG8_STAGE(PG8_SB(0, 1), cB + hstepB, voffB); PG8_STAGE(PG8_SA(0, 1), cA + hstepA, voffA);
        if (wr == 1) PG8_BAR;
        PG8_WAIT_V(4); PG8_BAR;
        PG8_STAGE(PG8_SB(1, 0), cB + kstep, voffB); PG8_STAGE(PG8_SA(1, 0), cA + kstep, voffA); PG8_STAGE(PG8_SB(1, 1), cB + hstepB + kstep, voffB);
        PG8_WAIT_V(6); PG8_BAR;
    }
    for (;;) {
        const bool has_next = S.next(ui + 1, nxt);
        const char* nA = has_next ? (const char*)g.A + (size_t)nxt.pm * tstepA + (size_t)nxt.kh * g.khb : cA; const char* nB = has_next ? (const char*)g.Bt + (size_t)nxt.pn * tstepB + (size_t)nxt.kh * g.khb : cB;
#pragma nounroll
        for (int t = 0; t < nt; t += 2) {
            const bool last = (t == nt - 2);
            const char* a1 = cA + (size_t)(t + 1) * kstep;
            const char* a2 = last ? nA : cA + (size_t)(t + 2) * kstep; const char* b2 = last ? nB : cB + (size_t)(t + 2) * kstep;
            const char* a3 = a2 + kstep; const char* b3 = b2 + kstep;
            if (last && has_next) S.a_ready(nxt);
            if constexpr (SP2) {
            PG8_LDB(B0, 0, 0); PG8_LDB(B1, 0, 1); PG8_SCHED; PG8_LDA(At, 0, 0); PG8_STAGE(PG8_SA(1, 1), a1 + hstepA, voffA);
            PG8_WAIT_V(8); PG8_WAIT_L(0); PG8_BAR; PG8_MMA(0, 0, At, B0); PG8_MMA(0, 1, At, B1); PG8_BAR; PG8_SCHED;
            PG8_LDA(At, 0, 1); PG8_STAGE(PG8_SB(0, 0), b2, voffB); PG8_STAGE(PG8_SB(0, 1), b2 + hstepB, voffB); PG8_STAGE(PG8_SA(0, 0), a2, voffA);
            PG8_WAIT_V(8); PG8_WAIT_L(0); PG8_BAR; PG8_MMA(1, 0, At, B0); PG8_MMA(1, 1, At, B1); PG8_BAR; PG8_SCHED;
            PG8_LDB(B0, 1, 0); PG8_LDB(B1, 1, 1); PG8_SCHED; PG8_LDA(At, 1, 0); PG8_STAGE(PG8_SA(0, 1), a2 + hstepA, voffA);
            PG8_WAIT_V(8); PG8_WAIT_L(0); PG8_BAR; PG8_MMA(0, 0, At, B0); PG8_MMA(0, 1, At, B1); PG8_BAR; PG8_SCHED;
            PG8_LDA(At, 1, 1); PG8_STAGE(PG8_SB(1, 0), b3, voffB); PG8_STAGE(PG8_SB(1, 1), b3 + hstepB, voffB); PG8_STAGE(PG8_SA(1, 0), a3, voffA);
            PG8_WAIT_V(8); PG8_WAIT_L(0); PG8_BAR; PG8_MMA(1, 0, At, B0); PG8_MMA(1, 1, At, B1); PG8_BAR; PG8_SCHED;
            } else {
            PG8_LDB(B0, 0, 0); PG8_SCHED; PG8_LDA(At, 0, 0); PG8_STAGE(PG8_SA(1, 1), a1 + hstepA, voffA);
            PG8_WAIT_L(8); PG8_BAR; PG8_WAIT_L(0); PG8_MMA(0, 0, At, B0); PG8_BAR; PG8_SCHED;
            PG8_LDB(B1, 0, 1); PG8_STAGE(PG8_SB(0, 0), b2, voffB);
            PG8_BAR; PG8_WAIT_L(0); PG8_MMA(0, 1, At, B1); PG8_BAR;
            PG8_LDA(At, 0, 1); PG8_STAGE(PG8_SA(0, 0), a2, voffA);
            PG8_BAR; PG8_WAIT_L(0); PG8_MMA(1, 0, At, B0); PG8_BAR; PG8_SCHED;
            PG8_STAGE(PG8_SB(0, 1), b2 + hstepB, voffB);
            PG8_WAIT_V(6); PG8_BAR; PG8_MMA(1, 1, At, B1); PG8_BAR;
            PG8_LDB(B0, 1, 0); PG8_SCHED; PG8_LDA(At, 1, 0); PG8_STAGE(PG8_SA(0, 1), a2 + hstepA, voffA);
            PG8_WAIT_L(8); PG8_BAR; PG8_WAIT_L(0); PG8_MMA(0, 0, At, B0); PG8_BAR; PG8_SCHED;
            PG8_LDB(B1, 1, 1); PG8_STAGE(PG8_SB(1, 0), b3, voffB);
            PG8_BAR; PG8_WAIT_L(0); PG8_MMA(0, 1, At, B1); PG8_BAR;
            PG8_LDA(At, 1, 1); PG8_STAGE(PG8_SA(1, 0), a3, voffA);
            PG8_BAR; PG8_WAIT_L(0); PG8_MMA(1, 0, At, B0); PG8_BAR; PG8_SCHED;
            PG8_STAGE(PG8_SB(1, 1), b3 + hstepB, voffB);
            PG8_WAIT_V(6); PG8_BAR; PG8_MMA(1, 1, At, B1); PG8_BAR;
            }
        }
        if constexpr (ALIGN_EPI) { if (wr == 0) PG8_BAR; }
        if constexpr (!Epi::AFTER_DRAIN) { E(acc, cur, wr, wc, fr, fq); S.done(cur); }
        if (!has_next) break;
        if (Epi::zero_after(cur)) {
#pragma unroll
        for (int a = 0; a < 2; ++a)
#pragma unroll
            for (int b = 0; b < 2; ++b)
#pragma unroll
                for (int m = 0; m < 4; ++m)
#pragma unroll
                    for (int n = 0; n < 2; ++n) acc[a][b][m][n] = (f32x4){0.f, 0.f, 0.f, 0.f};
        }
        cur = nxt; cA = nA; cB = nB; ++ui;
        if constexpr (ALIGN_EPI) { if (wr == 1) PG8_BAR; }
    }
    PG8_WAIT_V(0);
    if constexpr (!ALIGN_EPI) { if (wr == 0) PG8_BAR; }
    PG8_BAR;
    if constexpr (Epi::AFTER_DRAIN) { E.fused(acc, cur, wr, wc, fr, fq, lds, wid, lane); S.done(cur); }
#undef PG8_SA
#undef PG8_SB
#undef PG8_STAGE
#undef PG8_LDA
#undef PG8_LDB
#undef PG8_MMA
#undef PG8_WAIT_V
#undef PG8_WAIT_L
#undef PG8_BAR
#undef PG8_SCHED
}
}

typedef f32x4 AccT[2][2][4][2];
__device__ __forceinline__ float sigm(float x) { return 1.0f / (1.0f + __expf(-x)); }
__device__ __forceinline__ float gelu_tanh(float x) { const float u = 0.7978845608028654f * (x + 0.044715f * x * x * x); return 0.5f * x * (1.0f + tanhf(u)); }
__device__ __forceinline__ u32x4 pack8(f32x4 a, f32x4 b) { u32x4 w; w.x = pg8::cvt_pk_bf16(a.x, a.y); w.y = pg8::cvt_pk_bf16(a.z, a.w); w.z = pg8::cvt_pk_bf16(b.x, b.y); w.w = pg8::cvt_pk_bf16(b.z, b.w); return w; }
__device__ __forceinline__ void unpack8(u32x4 w, f32x4& a, f32x4& b) { a = (f32x4){bflo(w.x), bfhi(w.x), bflo(w.y), bfhi(w.y)}; b = (f32x4){bflo(w.z), bfhi(w.z), bflo(w.w), bfhi(w.w)}; }
__device__ __forceinline__ float sum8f(const float* p) { const f32x4 a = *(const f32x4*)p, b = *(const f32x4*)(p + 4); return ((a.x + a.y) + (a.z + a.w)) + ((b.x + b.y) + (b.z + b.w)); }
__device__ __forceinline__ float sum16f(const float* p) { return sum8f(p) + sum8f(p + 8); }
__device__ __forceinline__ float red_fq(float s) { s += __shfl_xor(s, 16); s += __shfl_xor(s, 32); return s; }
#define EPI_ROWS(...) _Pragma("unroll") for (int ai = 0; ai < 2; ++ai) _Pragma("unroll") for (int m = 0; m < 4; ++m) { const int row = u.pm * 256 + ai * 128 + wr * 64 + m * 16 + fr; __VA_ARGS__ }
#define EPI_COLS(...) _Pragma("unroll") for (int bj = 0; bj < 2; ++bj) { const int col = u.pn * 256 + bj * 128 + wc * 32 + 8 * fq; f32x4& v0 = acc[ai][bj][m][0]; f32x4& v1 = acc[ai][bj][m][1]; __VA_ARGS__ }

struct EpiIn {
    static constexpr bool PERM = true, AFTER_DRAIN = false; __device__ static bool zero_after(const pg8::Unit&) { return true; }
    const float* RS0; bf16_t *QB, *KB, *VB, *UH;
    __device__ __forceinline__ void operator()(AccT& acc, const pg8::Unit& u, int wr, int wc, int fr, int fq) const {
        EPI_ROWS( const float rs = RS0[row];
            EPI_COLS( const u32x4 w = pack8(v0 * rs, v1 * rs);
                if (u.pn < 6) { bf16_t* dst = QB + (size_t)(u.pn >> 1) * ((size_t)NT * AW); *(u32x4*)(dst + (size_t)row * AW + (col & (AW - 1))) = w; }
                else { const int c = col - 3 * AW, g = c >> 4, ch = c & 15; *(u32x4*)(UH + ((size_t)(g * NCHT + (row >> 4))) * 512 + (row & 15) * 16 + ch) = w; } ) )
    }
};
struct EpiS {
    static constexpr bool PERM = true, AFTER_DRAIN = false; __device__ static bool zero_after(const pg8::Unit&) { return true; }
    bf16_t* SB;
    __device__ __forceinline__ void operator()(AccT& acc, const pg8::Unit& u, int wr, int wc, int fr, int fq) const {
        EPI_ROWS( EPI_COLS( *(u32x4*)(SB + (size_t)row * 256 + (col - u.pn * 256)) = pack8(v0, v1); ) )
    }
};
struct EpiY {
    static constexpr bool PERM = true, AFTER_DRAIN = false; __device__ static bool zero_after(const pg8::Unit&) { return true; }
    bf16_t* GB;
    __device__ __forceinline__ void operator()(AccT& acc, const pg8::Unit& u, int wr, int wc, int fr, int fq) const {
        const int g = u.pn;
        EPI_ROWS( const int chunk = row - g * NCHT;
            EPI_COLS( const int cl = col - u.pn * 256, j = cl >> 4, h = cl & 15; const size_t tok = (size_t)chunk * 16 + j;
                f32x4 a, b; a.x = gelu_tanh(v0.x); a.y = gelu_tanh(v0.y); a.z = gelu_tanh(v0.z); a.w = gelu_tanh(v0.w); b.x = gelu_tanh(v1.x); b.y = gelu_tanh(v1.y); b.z = gelu_tanh(v1.z); b.w = gelu_tanh(v1.w);
                *(u32x4*)(GB + tok * SW + g * 16 + h) = pack8(a, b); ) )
    }
};
struct EpiGlu {
    static constexpr bool PERM = true, AFTER_DRAIN = false; __device__ static bool zero_after(const pg8::Unit&) { return true; }
    const bf16_t* GB; const float* bglu; bf16_t* MIX; float* SSQS;
    __device__ __forceinline__ void operator()(AccT& acc, const pg8::Unit& u, int wr, int wc, int fr, int fq) const {
        EPI_ROWS( float sq = 0.f;
            EPI_COLS( f32x4 g0, g1; unpack8(*(const u32x4*)(GB + (size_t)row * SW + col), g0, g1); const f32x4 b0 = *(const f32x4*)(bglu + col), b1 = *(const f32x4*)(bglu + col + 4);
                f32x4 o0, o1; o0.x = g0.x * sigm(v0.x + b0.x); o0.y = g0.y * sigm(v0.y + b0.y); o0.z = g0.z * sigm(v0.z + b0.z); o0.w = g0.w * sigm(v0.w + b0.w);
                o1.x = g1.x * sigm(v1.x + b1.x); o1.y = g1.y * sigm(v1.y + b1.y); o1.z = g1.z * sigm(v1.z + b1.z); o1.w = g1.w * sigm(v1.w + b1.w);
                sq += sumsq4(o0) + sumsq4(o1); *(u32x4*)(MIX + (size_t)row * D + AW + col) = pack8(o0, o1); )
            sq = red_fq(sq); if (fq == 0) SSQS[(size_t)row * 8 + u.pn * 4 + wc] = sq; )
    }
};
struct EpiOut {
    static constexpr bool PERM = true, AFTER_DRAIN = false; __device__ static bool zero_after(const pg8::Unit& u) { return u.kh != 0; }
    const bf16_t* XB; const float *SSQA, *SSQS; bf16_t* H1B; float* SSQ1;
    __device__ __forceinline__ void operator()(AccT& acc, const pg8::Unit& u, int wr, int wc, int fr, int fq) const {
        if (u.kh == 0) {
            EPI_ROWS( const float rsa = 1.0f / sqrtf(sum8f(SSQA + (size_t)row * 8) * (1.0f / AW) + EPS), rss = 1.0f / sqrtf(sum8f(SSQS + (size_t)row * 8) * (1.0f / SW) + EPS); const float r = rsa / rss;
                EPI_COLS( v0 = v0 * r; v1 = v1 * r; ) )
        } else {
            EPI_ROWS( const float rss = 1.0f / sqrtf(sum8f(SSQS + (size_t)row * 8) * (1.0f / SW) + EPS); float sq = 0.f;
                EPI_COLS( f32x4 x0, x1; unpack8(*(const u32x4*)(XB + (size_t)row * D + col), x0, x1); const f32x4 o0 = x0 + v0 * rss, o1 = x1 + v1 * rss;
                    sq += sumsq4(o0) + sumsq4(o1); *(u32x4*)(H1B + (size_t)row * D + col) = pack8(o0, o1); )
                sq = red_fq(sq); if (fq == 0) SSQ1[(size_t)row * 16 + u.pn * 4 + wc] = sq; )
        }
    }
};
struct EpiMlp1 {
    static constexpr bool PERM = true, AFTER_DRAIN = false; __device__ static bool zero_after(const pg8::Unit&) { return true; }
    const float* SSQ1; bf16_t* HID;
    __device__ __forceinline__ void operator()(AccT& acc, const pg8::Unit& u, int wr, int wc, int fr, int fq) const {
        EPI_ROWS( const float rs = 1.0f / sqrtf(sum16f(SSQ1 + (size_t)row * 16) * (1.0f / D) + EPS);
            EPI_COLS( f32x4 a = v0 * rs, b = v1 * rs; a.x = fmaxf(a.x, 0.f); a.y = fmaxf(a.y, 0.f); a.z = fmaxf(a.z, 0.f); a.w = fmaxf(a.w, 0.f); b.x = fmaxf(b.x, 0.f); b.y = fmaxf(b.y, 0.f); b.z = fmaxf(b.z, 0.f); b.w = fmaxf(b.w, 0.f);
                *(u32x4*)(HID + (size_t)row * DFF + col) = pack8(a * a, b * b); ) )
    }
};
struct EpiMlp2 {
    static constexpr bool PERM = true, AFTER_DRAIN = false; __device__ static bool zero_after(const pg8::Unit&) { return true; }
    const bf16_t* H1B; bf16_t* H2B; float* SSQ2;
    __device__ __forceinline__ void operator()(AccT& acc, const pg8::Unit& u, int wr, int wc, int fr, int fq) const {
        EPI_ROWS( float sq = 0.f;
            EPI_COLS( f32x4 h0, h1; unpack8(*(const u32x4*)(H1B + (size_t)row * D + col), h0, h1); const f32x4 o0 = h0 + v0, o1 = h1 + v1;
                sq += sumsq4(o0) + sumsq4(o1); *(u32x4*)(H2B + (size_t)row * D + col) = pack8(o0, o1); )
            sq = red_fq(sq); if (fq == 0) SSQ2[(size_t)row * 16 + u.pn * 4 + wc] = sq; )
    }
};
struct EpiPP {
    static constexpr bool PERM = true, AFTER_DRAIN = false; __device__ static bool zero_after(const pg8::Unit&) { return true; }
    bf16_t* PP;
    __device__ __forceinline__ void operator()(AccT& acc, const pg8::Unit& u, int wr, int wc, int fr, int fq) const {
        EPI_ROWS( EPI_COLS( *(u32x4*)(PP + (size_t)row * D + col) = pack8(v0, v1); ) )
    }
};
struct EpiGate {
    static constexpr bool PERM = true, AFTER_DRAIN = false; __device__ static bool zero_after(const pg8::Unit&) { return true; }
    const float* SSQ2; const bf16_t* H2B; const bf16_t* PP; float* H3F;
    __device__ __forceinline__ void operator()(AccT& acc, const pg8::Unit& u, int wr, int wc, int fr, int fq) const {
        EPI_ROWS( const float rs = 1.0f / sqrtf(sum16f(SSQ2 + (size_t)row * 16) * (1.0f / D) + EPS);
            EPI_COLS( f32x4 h0, h1, p0, p1; unpack8(*(const u32x4*)(H2B + (size_t)row * D + col), h0, h1); unpack8(*(const u32x4*)(PP + (size_t)row * D + col), p0, p1);
                f32x4 o0, o1; o0.x = h0.x + sigm(v0.x * rs) * p0.x; o0.y = h0.y + sigm(v0.y * rs) * p0.y; o0.z = h0.z + sigm(v0.z * rs) * p0.z; o0.w = h0.w + sigm(v0.w * rs) * p0.w;
                o1.x = h1.x + sigm(v1.x * rs) * p1.x; o1.y = h1.y + sigm(v1.y * rs) * p1.y; o1.z = h1.z + sigm(v1.z * rs) * p1.z; o1.w = h1.w + sigm(v1.w * rs) * p1.w;
                *(f32x4*)(H3F + (size_t)row * D + col) = o0; *(f32x4*)(H3F + (size_t)row * D + col + 4) = o1; ) )
    }
};

__device__ __forceinline__ void ph_final(const float* __restrict__ H3F, const float* __restrict__ gf, float* __restrict__ out) {
    const int tidf = tid_fresh(), lane = tidf & 63;
    const f32x4* g4 = (const f32x4*)gf + lane;
    for (int row0 = (blockIdx.x * 8 + (tidf >> 6)) * 4; row0 < NT; row0 += gridDim.x * 32) {
        f32x4 v[4][4];
#pragma unroll
        for (int r = 0; r < 4; ++r) { const f32x4* xr = (const f32x4*)(H3F + (size_t)(row0 + r) * D) + lane;
#pragma unroll
            for (int j = 0; j < 4; ++j) v[r][j] = xr[64 * j]; }
#pragma unroll
        for (int r = 0; r < 4; ++r) { float s = 0.f;
#pragma unroll
            for (int j = 0; j < 4; ++j) s += sumsq4(v[r][j]);
            s = wave_sum(s); const float rs = 1.0f / sqrtf(s * (1.0f / D) + EPS);
            f32x4* o = (f32x4*)(out + (size_t)(row0 + r) * D) + lane;
#pragma unroll
            for (int j = 0; j < 4; ++j) o[64 * j] = v[r][j] * rs * g4[64 * j]; }
    }
}

typedef float f32x16 __attribute__((ext_vector_type(16)));
typedef short v4i16_t __attribute__((ext_vector_type(4)));
typedef float f32x2_t __attribute__((ext_vector_type(2))); typedef __bf16 bf16x2_t __attribute__((ext_vector_type(2)));
__device__ __forceinline__ unsigned cvtpk_s(float lo, float hi) { f32x2_t v = {lo, hi}; bf16x2_t b = __builtin_convertvector(v, bf16x2_t); return __builtin_bit_cast(unsigned, b); }
constexpr int ATT_CT_BYTES = 3 * 5 * 4 * 64 * 16;
constexpr int ATT_KV_OFF = ATT_CT_BYTES, ATT_KV_BYTES = 8192, ATT_LDS = ATT_KV_OFF + 8 * ATT_KV_BYTES;
static_assert(ATT_LDS <= 131072, "attention LDS fits the stage ring region");
template <int MODE>
__device__ __forceinline__ void ph_attn(PG8_LAS unsigned char* lds, const bf16_t* __restrict__ QB, const bf16_t* __restrict__ KB, const bf16_t* __restrict__ VB, const float* __restrict__ bias,
                                        bf16_t* MIX, float* AM, float* AL, float* __restrict__ SSQA) {
    const int tid = tid_fresh(), lane = tid & 63, wid = __builtin_amdgcn_readfirstlane(tid >> 6), q = lane & 31, hi = lane >> 5;
    PG8_LAS unsigned char* ktile = lds + ATT_KV_OFF + wid * ATT_KV_BYTES;
    PG8_LAS unsigned char* vt = ktile + 4096;
    const int vrow = lane >> 3, vch = lane & 7;
    PG8_LAS unsigned char* kwr = ktile + vrow * 128 + ((vch ^ vrow) * 16);
    PG8_LAS unsigned char* vwr = vt + (vch >> 2) * 2048 + vrow * 64 + (vch & 3) * 16;
    const PG8_LAS unsigned char* krd = ktile + q * 128;
    const int kx = q & 7;
    PG8_LAS unsigned char* vrd = vt + (4 * hi + ((lane & 15) >> 2)) * 64 + (16 * ((lane >> 4) & 1) + 4 * (lane & 3)) * 2;
    int last_h = -1;
    for (int it = blockIdx.x; it < NH * NSEQ * 32; it += gridDim.x) {
        const int h = it & 7, sw = it >> 3, sq_ = sw >> 5, w = (MODE == 0) ? (sw & 31) : ((sw & 31) >> 1), half = sw & 1;
        if (h != last_h) {
            __syncthreads();
            for (int e = tid; e < 3 * 5 * 4 * 64 * 4; e += NTHR) {
                const int el = e & 3, ln = (e >> 2) & 63, rq = (e >> 8) & 3, tb = e >> 10, ti = tb % 5, b = tb / 5;
                const int r16 = 4 * rq + el, kv = (r16 & 3) + 8 * (r16 >> 2) + 4 * (ln >> 5), off = 32 * (ti - 2) + kv - (ln & 31);
                ((PG8_LAS float*)lds)[e] = (off >= -64 && off <= 64) ? bias[(b * NH + h) * 129 + off + 64] : -1e30f;
            }
            __syncthreads(); last_h = h;
        }
        const int p0 = (MODE == 0) ? w * 256 : w * 512; const size_t seqbase = (size_t)sq_ * SEQ;
#pragma unroll 1
        for (int b = (MODE == 0 ? 0 : 2); b < (MODE == 0 ? 2 : 3); ++b) {
            const int dsh = 2 * b, L = SEQ >> dsh;
            const PG8_LAS unsigned char* ctb = lds + b * (5 * 4096) + lane * 16;
            {
                int r, m0;
                if (b == 0) { r = 0; m0 = p0 + 32 * wid; } else if (b == 1) { r = wid & 3; m0 = (p0 >> 2) + 32 * (wid >> 2); } else { r = 8 * half + wid; m0 = p0 >> 4; }
                const size_t qtok = seqbase + ((size_t)(m0 + q) << dsh) + r;
                bf16x8 qf[4];
#pragma unroll
                for (int s4 = 0; s4 < 4; ++s4) qf[s4] = *(const bf16x8*)(QB + qtok * AW + h * HD + 16 * s4 + 8 * hi);
                float m_run = -1e30f, l_part = 0.f; f32x16 o0, o1;
#pragma unroll
                for (int e = 0; e < 16; ++e) { o0[e] = 0.f; o1[e] = 0.f; }
                u32x4 kr[2][4], vr[2][4];
                const size_t rstep = ((size_t)8 << dsh) * AW;
#define ATT_ISSUE(KT, SET) do { const int mk0_ = m0 + 32 * (KT); const int mkc_ = (mk0_ >= 0 && mk0_ < L) ? mk0_ : m0; \
                    const size_t rb_ = (seqbase + ((size_t)(mkc_ + vrow) << dsh) + r) * AW + h * HD + 8 * vch; \
                    _Pragma("unroll") for (int j4 = 0; j4 < 4; ++j4) { kr[SET][j4] = *(const u32x4*)(KB + rb_ + j4 * rstep); vr[SET][j4] = *(const u32x4*)(VB + rb_ + j4 * rstep); } } while (0)
#define ATT_VTR(off) __builtin_amdgcn_ds_read_tr16_b64_v4i16((PG8_LAS v4i16_t*)(vrd + (off)))
#define ATT_VF(lo4, hi4) (bf16x8){lo4[0], lo4[1], lo4[2], lo4[3], hi4[0], hi4[1], hi4[2], hi4[3]}
#define ATT_STEP(I, KT, NEXTKT, HASNEXT) do { \
                    if (HASNEXT) ATT_ISSUE(NEXTKT, ((I) + 1) & 1); \
                    const int mk0 = m0 + 32 * (KT); const bool valid = (mk0 >= 0) && (mk0 < L); \
                    _Pragma("unroll") for (int j4 = 0; j4 < 4; ++j4) { *(PG8_LAS u32x4*)(kwr + j4 * 1024) = kr[(I) & 1][j4]; *(PG8_LAS u32x4*)(vwr + j4 * 512) = vr[(I) & 1][j4]; } \
                    f32x16 acc; \
                    { const PG8_LAS f32x4* cp = (const PG8_LAS f32x4*)(ctb + ((KT) + 2) * 4096); \
                      _Pragma("unroll") for (int rq = 0; rq < 4; ++rq) { const f32x4 c4 = cp[rq * 64]; acc[4 * rq] = c4.x; acc[4 * rq + 1] = c4.y; acc[4 * rq + 2] = c4.z; acc[4 * rq + 3] = c4.w; } } \
                    asm volatile("s_waitcnt lgkmcnt(0)" ::: "memory"); \
                    { bf16x8 kf[4]; \
                      _Pragma("unroll") for (int s4 = 0; s4 < 4; ++s4) kf[s4] = *(const PG8_LAS bf16x8*)(krd + (((2 * s4 + hi) ^ kx) * 16)); \
                      _Pragma("unroll") for (int s4 = 0; s4 < 4; ++s4) acc = __builtin_amdgcn_mfma_f32_32x32x16_bf16(kf[s4], qf[s4], acc, 0, 0, 0); } \
                    if (!valid) { _Pragma("unroll") for (int e = 0; e < 16; ++e) acc[e] = -1e30f; } \
                    float tm = fmaxf(acc[0], acc[1]); \
                    _Pragma("unroll") for (int e = 2; e < 16; ++e) tm = fmaxf(tm, acc[e]); \
                    tm = fmaxf(tm, __shfl_xor(tm, 32)); \
                    const float mn = fmaxf(m_run, tm), sc = __builtin_amdgcn_exp2f(m_run - mn); m_run = mn; \
                    float rs = 0.f; \
                    _Pragma("unroll") for (int e = 0; e < 16; ++e) { acc[e] = __builtin_amdgcn_exp2f(acc[e] - mn); rs += acc[e]; } \
                    l_part = l_part * sc + rs; \
                    _Pragma("unroll") for (int e = 0; e < 16; ++e) { o0[e] *= sc; o1[e] *= sc; } \
                    u32x4 pw0, pw1; \
                    pw0.x = cvtpk_s(acc[0], acc[1]); pw0.y = cvtpk_s(acc[2], acc[3]); pw0.z = cvtpk_s(acc[4], acc[5]); pw0.w = cvtpk_s(acc[6], acc[7]); \
                    pw1.x = cvtpk_s(acc[8], acc[9]); pw1.y = cvtpk_s(acc[10], acc[11]); pw1.z = cvtpk_s(acc[12], acc[13]); pw1.w = cvtpk_s(acc[14], acc[15]); \
                    const bf16x8 pb0 = __builtin_bit_cast(bf16x8, pw0), pb1 = __builtin_bit_cast(bf16x8, pw1); \
                    { const v4i16_t a0 = ATT_VTR(0), a1 = ATT_VTR(512), a2 = ATT_VTR(1024), a3 = ATT_VTR(1536); \
                      const v4i16_t c0 = ATT_VTR(2048), c1 = ATT_VTR(2048 + 512), c2 = ATT_VTR(2048 + 1024), c3 = ATT_VTR(2048 + 1536); \
                      o0 = __builtin_amdgcn_mfma_f32_32x32x16_bf16(ATT_VF(a0, a1), pb0, o0, 0, 0, 0); \
                      o0 = __builtin_amdgcn_mfma_f32_32x32x16_bf16(ATT_VF(a2, a3), pb1, o0, 0, 0, 0); \
                      o1 = __builtin_amdgcn_mfma_f32_32x32x16_bf16(ATT_VF(c0, c1), pb0, o1, 0, 0, 0); \
                      o1 = __builtin_amdgcn_mfma_f32_32x32x16_bf16(ATT_VF(c2, c3), pb1, o1, 0, 0, 0); } \
                    asm volatile("s_waitcnt lgkmcnt(0)" ::: "memory"); \
                } while (0)
                ATT_ISSUE(0, 0);
                ATT_STEP(0, 0, -1, true);
                ATT_STEP(1, -1, 1, true);
                ATT_STEP(2, 1, -2, true);
                ATT_STEP(3, -2, 2, true);
                ATT_STEP(4, 2, 0, false);
                const float l_b = l_part + __shfl_xor(l_part, 32);
                float fa = 0.f, fc, mm = m_run, ln = l_b;
                if (b > 0) { const float pm = AM[qtok * NH + h], pl = AL[qtok * NH + h]; mm = fmaxf(pm, m_run); fa = pl * __builtin_amdgcn_exp2f(pm - mm); fc = __builtin_amdgcn_exp2f(m_run - mm); ln = fa + l_b * fc; }
                else fc = 1.f;
                const float inv = 1.0f / ln; fa *= inv; fc *= inv;
                bf16_t* op = MIX + qtok * D + h * HD + 4 * hi;
                float ssq = 0.f;
#pragma unroll
                for (int dt = 0; dt < 2; ++dt)
#pragma unroll
                    for (int rq = 0; rq < 4; ++rq) {
                        f32x4 v;
                        if (dt == 0) v = (f32x4){o0[4 * rq], o0[4 * rq + 1], o0[4 * rq + 2], o0[4 * rq + 3]}; else v = (f32x4){o1[4 * rq], o1[4 * rq + 1], o1[4 * rq + 2], o1[4 * rq + 3]};
                        v = v * fc;
                        bf16_t* pp_ = op + 32 * dt + 8 * rq;
                        if (b > 0) { const u32x2 pw = *(const u32x2*)pp_; v = v + (f32x4){bflo(pw.x), bfhi(pw.x), bflo(pw.y), bfhi(pw.y)} * fa; }
                        ssq += sumsq4(v);
                        u32x2 w2; w2.x = cvtpk_s(v.x, v.y); w2.y = cvtpk_s(v.z, v.w); *(u32x2*)pp_ = w2;
                    }
                if (b < 2) { if (hi == 0) { AM[qtok * NH + h] = mm; AL[qtok * NH + h] = ln; } }
                else { ssq += __shfl_xor(ssq, 32); if (hi == 0) SSQA[qtok * NH + h] = ssq; }
            }
            __syncthreads();
        }
    }
#undef ATT_ISSUE
#undef ATT_STEP
#undef ATT_VTR
#undef ATT_VF
}

__device__ __forceinline__ void ph_scan(PG8_LAS unsigned char* lds, const bf16_t* __restrict__ SB, const float* __restrict__ PW, bf16_t* __restrict__ UH) {
    const int tid = tid_fresh(), seg = tid >> 5, nl = tid & 31;
    PG8_LAS float* ex = (PG8_LAS float*)lds;
    for (int it = blockIdx.x; it < NSEQ * NG * 2 * 2; it += gridDim.x) {
        const int nh = it & 1, dir = (it >> 1) & 1, g = (it >> 2) % NG, s = it / (4 * NG), n = nh * 32 + nl;
        const float* pw = PW + ((size_t)((g * 2 + dir) * NS + n) * 17 + 16) * 2;
        const float ar = pw[0], ai = pw[1];
        const size_t base = (size_t)g * NCHT + (size_t)s * NCHS; const int colo = dir * 128 + 2 * n;
        const int t0 = seg * 32;
        const int c0 = dir == 0 ? t0 : NCHS - 1 - t0; const long cstep = dir == 0 ? 1 : -1;
        const bf16_t* sp = SB + (base + c0) * 256 + colo; const long sstride = cstep * 256;
        float hr = 0.f, hi = 0.f;
#pragma unroll 8
        for (int i = 0; i < 32; ++i) { const unsigned wv = *(const unsigned*)sp; sp += sstride; const float sr = bflo(wv), si = bfhi(wv); const float nr = ar * hr - ai * hi + sr, ni = ar * hi + ai * hr + si; hr = nr; hi = ni; }
        __syncthreads();
        ex[(seg * 32 + nl) * 2] = hr; ex[(seg * 32 + nl) * 2 + 1] = hi;
        float sr_ = ar, si_ = ai;
#pragma unroll
        for (int i = 0; i < 5; ++i) { const float tr = sr_ * sr_ - si_ * si_, ti = 2.f * sr_ * si_; sr_ = tr; si_ = ti; }
        __syncthreads();
        float cr = 0.f, ci = 0.f;
        for (int j = 0; j < seg; ++j) { const float er = ex[(j * 32 + nl) * 2], ei = ex[(j * 32 + nl) * 2 + 1]; const float nr = sr_ * cr - si_ * ci + er, ni = sr_ * ci + si_ * cr + ei; cr = nr; ci = ni; }
        hr = cr; hi = ci;
        sp = SB + (base + c0) * 256 + colo; bf16_t* up = UH + (base + c0) * 512 + 256 + colo; const long ustride = cstep * 512;
#pragma unroll 8
        for (int i = 0; i < 32; ++i) { const unsigned wv = *(const unsigned*)sp; sp += sstride;
            *(unsigned*)up = pk2(hr, hi); up += ustride;
            const float sr = bflo(wv), si = bfhi(wv); const float nr = ar * hr - ai * hi + sr, ni = ar * hi + ai * hr + si; hr = nr; hi = ni; }
    }
    __syncthreads();
}


#define LAS __attribute__((address_space(3)))
#define XB_TMO      128
#define XB_XCNT(j)  (256  + 64 * (j))
#define XB_XSUB(j)  (1280 + 64 * (j))
#define XB_XGEN(j)  (2304 + 64 * (j))
#define XB_TOP      3328
#define XB_TOPGEN   3392
#define XCD_BAR_WORDS 3456
#define XB_SPIN_CAP (1u << 18)

__device__ __forceinline__ unsigned xb_ld(unsigned* p)              { return __hip_atomic_load(p, __ATOMIC_RELAXED, __HIP_MEMORY_SCOPE_AGENT); }
__device__ __forceinline__ unsigned xb_add(unsigned* p, unsigned v) { return __hip_atomic_fetch_add(p, v, __ATOMIC_RELAXED, __HIP_MEMORY_SCOPE_AGENT); }
__device__ __forceinline__ unsigned xb_xcc_id() { return (unsigned)__builtin_amdgcn_s_getreg((3 << 11) | 20) & 0xFu; }
#define XB_SPIN(cond, bar) do { unsigned _sp = 0; while (cond) { __builtin_amdgcn_s_sleep(1); \
    if ((++_sp & 255u) == 0u) { if (xb_ld(&(bar)[XB_TMO])) break; if (_sp > XB_SPIN_CAP) { atomicAdd(&(bar)[XB_TMO], 1u); break; } } } } while (0)

struct XcdBarrier {
    unsigned* bar; unsigned x;
    volatile LAS unsigned* st;
};

__device__ __forceinline__ XcdBarrier xcd_barrier_post(unsigned* bar, volatile LAS unsigned* st) {
    XcdBarrier b; b.bar = bar; b.x = xb_xcc_id(); b.st = st;
    if (threadIdx.x == 0) (void)xb_add(&bar[XB_XCNT(b.x)], 1u);
    return b;
}
__device__ __forceinline__ void xcd_barrier_complete(unsigned* bar, unsigned x, unsigned& nloc, unsigned& nx) {
    const unsigned G = gridDim.x * gridDim.y * gridDim.z;
    unsigned sum, cnt, mine, sp = 0u;
    for (;;) {
        sum = 0u; cnt = 0u; mine = 0u;
#pragma unroll
        for (unsigned j = 0; j < 16; ++j) { const unsigned c = xb_ld(&bar[XB_XCNT(j)]); sum += c; cnt += (c > 0u) ? 1u : 0u; mine = (j == x) ? c : mine; }
        if (sum == G) break;
        __builtin_amdgcn_s_sleep(1);
        if ((++sp & 255u) == 0u) { if (xb_ld(&bar[XB_TMO])) break; if (sp > XB_SPIN_CAP) { atomicAdd(&bar[XB_TMO], 1u); break; } }
    }
    nloc = mine > 0u ? mine : 1u; nx = cnt > 0u ? cnt : 1u;
}

__device__ __forceinline__ void xcd_barrier(const XcdBarrier& b) {
    asm volatile("s_waitcnt vmcnt(0)" ::: "memory");
    __syncthreads();
    if (threadIdx.x == 0) {
        unsigned* bar = b.bar;
        __builtin_amdgcn_s_waitcnt(0);
        unsigned nloc = b.st[0], nx = b.st[1];
        if (nloc == 0u) { xcd_barrier_complete(bar, b.x, nloc, nx); b.st[0] = nloc; b.st[1] = nx; }
        const unsigned old = xb_add(&bar[XB_XSUB(b.x)], 1u);
        const unsigned gen = old / nloc;
        if (old + 1u == (gen + 1u) * nloc) {
            __builtin_amdgcn_fence(__ATOMIC_RELEASE, "agent");
            asm volatile("s_waitcnt vmcnt(0)" ::: "memory");
            const unsigned og = xb_add(&bar[XB_TOP], 1u);
            const unsigned tg = og / nx;
            if (og + 1u == (tg + 1u) * nx) xb_add(&bar[XB_TOPGEN], 1u);
            else XB_SPIN(xb_ld(&bar[XB_TOPGEN]) == tg, bar);
            __builtin_amdgcn_fence(__ATOMIC_ACQUIRE, "agent");
            xb_add(&bar[XB_XGEN(b.x)], 1u);
            asm volatile("s_waitcnt vmcnt(0)" ::: "memory");
        } else {
            XB_SPIN(xb_ld(&bar[XB_XGEN(b.x)]) == gen, bar);
            __builtin_amdgcn_fence(__ATOMIC_ACQUIRE, "agent");
            asm volatile("s_waitcnt vmcnt(0)" ::: "memory");
        }
    }
    __syncthreads();
}
constexpr int LDS_BYTES = 147456;
struct Args { const float* in[27]; float* out; unsigned char* ws; };
template <class Epi>
__device__ __forceinline__ void run_gemm(PG8_LAS unsigned char* lds, const bf16_t* A, int lda, const bf16_t* Bt, int ldb, int M, int N, int K, int khb, int split, int bdiv, const Epi& E) {
    pg8::Gemm g{A, Bt, lda, ldb, K, khb}; pg8::Order S; S.init(M, N, (int)gridDim.x, (int)blockIdx.x, split, bdiv);
    pg8::gemm_phase<Epi, pg8::Order, true, true>(lds, g, S, E);
}
__global__ void __launch_bounds__(NTHR, 2) mega(Args a) {
    extern __shared__ __attribute__((aligned(16))) unsigned char lds_raw[];
    PG8_LAS unsigned char* lds = (PG8_LAS unsigned char*)lds_raw;
    cg::grid_group grid = cg::this_grid();
    unsigned* xbar = (unsigned*)(a.ws + WS_CTL);
    volatile LAS unsigned* xst = (volatile LAS unsigned*)(lds + 131072);
    if (threadIdx.x < 2) xst[threadIdx.x] = 0u;
    if (blockIdx.x == 0) for (int i_ = threadIdx.x; i_ < XCD_BAR_WORDS; i_ += NTHR) xbar[i_] = 0u;
    __syncthreads();
    const float *xp = a.in[0], *xs = a.in[1], *pp = a.in[2], *ps = a.in[3], *rel_bias = a.in[4], *g_mix = a.in[5], *w_in = a.in[6];
    const float *a_re = a.in[7], *a_im = a.in[8], *log_dt = a.in[9], *b_re = a.in[10], *b_im = a.in[11], *c_re = a.in[12], *c_im = a.in[13], *ssm_d = a.in[14];
    const float *w_glu = a.in[15], *b_glu = a.in[16], *g_att = a.in[17], *g_ssm = a.in[18], *w_out = a.in[19], *g_mlp = a.in[20], *w_mlp1 = a.in[21], *w_mlp2 = a.in[22];
    const float *g_ple = a.in[23], *w_gate = a.in[24], *w_proj = a.in[25], *g_final = a.in[26];
    unsigned char* ws = a.ws; unsigned char* dob = (unsigned char*)a.out;
    float* BIAS = (float*)(ws + WS_BIAS); float* PW = (float*)(ws + WS_PW); float* BBt = (float*)(ws + WS_BB); float* KT = (float*)(ws + WS_KT);
    float *RS0 = (float*)(ws + WS_RS0), *SSQA = (float*)(ws + WS_SSQA), *SSQS = (float*)(ws + WS_SSQS), *SSQ1 = (float*)(ws + WS_SSQ1), *SSQ2 = (float*)(ws + WS_SSQ2);
    bf16_t *WGT = (bf16_t*)(ws + WS_WGT), *WPT = (bf16_t*)(ws + WS_WPT);
    bf16_t *W1T = (bf16_t*)(dob + DO_W1T), *W2T = (bf16_t*)(dob + DO_W2T), *PB = (bf16_t*)(dob + DO_PB);
    bf16_t *WINT = (bf16_t*)(dob + DO_WINT), *WOUTT = (bf16_t*)(dob + DO_WOUTT), *WGLUT = (bf16_t*)(dob + DO_WGLUT), *WST = (bf16_t*)(dob + DO_WST), *WYT = (bf16_t*)(dob + DO_WYT);
    bf16_t *SB = (bf16_t*)(ws + WS_SB), *QB = (bf16_t*)(ws + WS_QB), *KB = (bf16_t*)(ws + WS_KB), *VB = (bf16_t*)(ws + WS_VB), *UH = (bf16_t*)(ws + WS_UH);
    bf16_t *MIX = (bf16_t*)(ws + WS_MIX), *GB = (bf16_t*)(ws + WS_GB), *HID = (bf16_t*)(ws + WS_HID), *PP = (bf16_t*)(ws + WS_PP);
    float* H3F = (float*)(ws + WS_H3F);
    bf16_t *XB = (bf16_t*)(dob + DO_XB), *H1B = (bf16_t*)(ws + WS_HB), *H2B = (bf16_t*)(ws + WS_HB);
#ifndef PROBE_MASK
#define PROBE_MASK 0
#endif
#define PHASE(id) _Pragma("unroll 1") for (int rep_ = 0; rep_ < (((PROBE_MASK) >> (id)) & 1) + 1; ++rep_)
    PHASE(0) {
        ph_prep_wt(lds, w_in, D, INC, g_mix, g_mix, D, WINT, D, AW, C2);
        ph_prep_wt(lds, w_glu, SW, SW, nullptr, nullptr, SW, WGLUT, SW, 0, 1.f);
        ph_prep_wt(lds, w_out, D, D, g_att, g_ssm, AW, WOUTT, D, 0, 1.f);
        ph_prep_wt(lds, w_mlp1, D, DFF, g_mlp, g_mlp, D, W1T, D, 0, 1.f);
        ph_prep_wt(lds, w_mlp2, DFF, D, nullptr, nullptr, DFF, W2T, DFF, 0, 1.f);
        ph_prep_wt(lds, w_gate, D, D, g_ple, g_ple, D, WGT, D, 0, 1.f);
        ph_prep_wt(lds, w_proj, PLE, D, nullptr, nullptr, PLE, WPT, PLE, 0, 1.f);
        ph_prep_bias(rel_bias, BIAS);
        ph_ssm_tab(a_re, a_im, log_dt, b_re, b_im, PW, BBt);
        ph_rows_x(xp, xs, XB, RS0);
        ph_cvt_p(pp, ps, PB);
        grid.sync();
    }
    const XcdBarrier xb = xcd_barrier_post(xbar, xst);
    PHASE(1) {
        ph_ssm_ws(PW, BBt, WST);
        ph_ssm_kt(PW, BBt, c_re, c_im, KT);
        ph_ssm_wy_carry(PW, c_re, c_im, WYT);
        run_gemm(lds, XB, D, WINT, D, NT, INC, D, 0, 0, 0, EpiIn{RS0, QB, KB, VB, UH});
        xcd_barrier(xb);
    }
    PHASE(2) {
        ph_ssm_wy_fill(KT, ssm_d, WYT);
        ph_attn<0>(lds, QB, KB, VB, BIAS, MIX, (float*)(ws + WS_AM), (float*)(ws + WS_AL), SSQA);
    }
    PHASE(3) {
        run_gemm(lds, UH, 512, WST, 256, NG * NCHT, 256, 256, 0, 0, NCHT / 256, EpiS{SB});
        xcd_barrier(xb);
    }
    PHASE(4) {
        ph_scan(lds, SB, PW, UH);
    }
    ph_attn<1>(lds, QB, KB, VB, BIAS, MIX, (float*)(ws + WS_AM), (float*)(ws + WS_AL), SSQA);
    xcd_barrier(xb);
    PHASE(5) {
        run_gemm(lds, UH, 512, WYT, 512, NG * NCHT, 256, 512, 0, 0, NCHT / 256, EpiY{GB});
        xcd_barrier(xb);
    }
    PHASE(6) {
        run_gemm(lds, GB, SW, WGLUT, SW, NT, SW, SW, 0, 0, 0, EpiGlu{GB, b_glu, MIX, SSQS});
        xcd_barrier(xb);
    }
    PHASE(7) {
        run_gemm(lds, MIX, D, WOUTT, D, NT, D, AW, AW * 2, 1, 0, EpiOut{XB, SSQA, SSQS, H1B, SSQ1});
        xcd_barrier(xb);
    }
    PHASE(8) {
        run_gemm(lds, H1B, D, W1T, D, NT, DFF, D, 0, 0, 0, EpiMlp1{SSQ1, HID});
        xcd_barrier(xb);
    }
    PHASE(9) {
        run_gemm(lds, HID, DFF, W2T, DFF, NT, D, DFF, 0, 0, 0, EpiMlp2{H1B, H2B, SSQ2});
        xcd_barrier(xb);
    }
    PHASE(10) {
        run_gemm(lds, PB, PLE, WPT, PLE, NT, D, PLE, 0, 0, 0, EpiPP{PP});
        xcd_barrier(xb);
    }
    PHASE(11) {
        run_gemm(lds, H2B, D, WGT, D, NT, D, D, 0, 0, 0, EpiGate{SSQ2, H2B, PP, H3F});
        xcd_barrier(xb);
    }
    PHASE(12) {
        ph_final(H3F, g_final, a.out);
    }
}

extern "C" void kernel_launch(void* const* d_in, const int* in_sizes, int n_in, void* d_out, int out_size, void* d_ws, size_t ws_size, hipStream_t stream) {
    static int grid_blocks = 0;
    if (n_in != 27 || ws_size < WS_END || out_size != NT * D) { fprintf(stderr, "kernel_launch: unexpected sizes n_in %d ws %zu out %d\n", n_in, ws_size, out_size); return; }
    if (!grid_blocks) {
        int dev = 0, cus = 0, per_cu = 0;
        (void)hipGetDevice(&dev);
        (void)hipDeviceGetAttribute(&cus, hipDeviceAttributeMultiprocessorCount, dev);
        if (hipFuncSetAttribute((const void*)mega, hipFuncAttributeMaxDynamicSharedMemorySize, LDS_BYTES) != hipSuccess) { fprintf(stderr, "kernel_launch: hipFuncSetAttribute failed\n"); return; }
        (void)hipOccupancyMaxActiveBlocksPerMultiprocessor(&per_cu, mega, NTHR, LDS_BYTES);
        if (per_cu < 1) { fprintf(stderr, "kernel_launch: occupancy query says %d blocks per CU\n", per_cu); return; }
        grid_blocks = cus;
    }
    Args a{};
    for (int i = 0; i < 27; ++i) a.in[i] = (const float*)d_in[i];
    a.out = (float*)d_out; a.ws = (unsigned char*)d_ws;
    void* args[] = {&a};
    hipError_t e = hipLaunchCooperativeKernel((void*)mega, dim3(grid_blocks), dim3(NTHR), args, LDS_BYTES, stream);
    if (e != hipSuccess) fprintf(stderr, "cooperative launch failed: %s (grid %d)\n", hipGetErrorString(e), grid_blocks);
}
```

```cpp
#include <hip/hip_runtime.h>
#include <hip/hip_cooperative_groups.h>
namespace cg = cooperative_groups;
#include <cstdio>
#include <cstdint>
#include <cmath>

typedef unsigned short bf16_t;
typedef short bf16x8 __attribute__((ext_vector_type(8)));
typedef float f32x4 __attribute__((ext_vector_type(4)));
typedef unsigned u32x2 __attribute__((ext_vector_type(2)));
typedef unsigned u32x4 __attribute__((ext_vector_type(4)));

constexpr int NT = 49152, SEQ = 8192, NSEQ = 6, NPROMPT = 16384;
constexpr int D = 1024, DFF = 4096, PLE = 256, INC = 2048, AW = 512, SW = 512;
constexpr int NH = 8, HD = 64, NG = 32, GC = 16, NS = 64;
constexpr int TCH = 16, NCHT = NT / TCH  , NCHS = SEQ / TCH  ;
constexpr float EPS = 1e-6f;
constexpr float LOG2E = 1.4426950408889634f;
constexpr float C2 = 0.125f * LOG2E;

constexpr size_t MiB = 1u << 20;
constexpr size_t WS_BIAS = 0;
constexpr size_t WS_PW = 64 * 1024;
constexpr size_t WS_BB = 1 * MiB;
constexpr size_t WS_KT = 1536 * 1024;
constexpr size_t WS_RS0 = 2560 * 1024;
constexpr size_t WS_SSQA = 3 * MiB;
constexpr size_t WS_SSQS = 4608 * 1024;
constexpr size_t WS_SSQ1 = 6 * MiB;
constexpr size_t WS_SSQ2 = 9 * MiB;
constexpr size_t WS_SSQ3 = 12 * MiB;
constexpr size_t WS_AM = 15 * MiB;
constexpr size_t WS_AL = WS_AM + 1536 * 1024;
constexpr size_t WS_WGT = 18 * MiB, WS_WPT = 20 * MiB;
constexpr size_t WS_CTL = 20 * MiB + 512 * 1024;
constexpr size_t WS_HB = 32 * MiB;
constexpr size_t WS_QB = 128 * MiB, WS_KB = 176 * MiB, WS_VB = 224 * MiB;
constexpr size_t WS_UH = 272 * MiB;
constexpr size_t WS_MIX = 368 * MiB;
constexpr size_t WS_GB = 464 * MiB;
constexpr size_t WS_HID = 128 * MiB;
constexpr size_t WS_PP = 128 * MiB;
constexpr size_t WS_H3F = 224 * MiB;
constexpr size_t WS_END = 512 * MiB;
static_assert(WS_KB - WS_QB == (size_t)NT * AW * 2 && WS_VB - WS_KB == (size_t)NT * AW * 2, "QB | KB | VB contiguous");
constexpr size_t DO_XB = 0;
constexpr size_t WS_SB = 32 * MiB;
constexpr size_t DO_W1T = 96 * MiB, DO_W2T = 104 * MiB, DO_WINT = 112 * MiB, DO_WOUTT = 116 * MiB, DO_WGLUT = 118 * MiB, DO_WST = 119 * MiB, DO_WYT = 123 * MiB, DO_PB = 131 * MiB;

__device__ __forceinline__ unsigned f2bf(float f) { unsigned u = __builtin_bit_cast(unsigned, f); return (u + 0x7fffu + ((u >> 16) & 1u)) >> 16; }
__device__ __forceinline__ unsigned pk2(float lo, float hi) { return f2bf(lo) | (f2bf(hi) << 16); }
__device__ __forceinline__ float bf2f(unsigned short b) { return __builtin_bit_cast(float, (unsigned)b << 16); }
__device__ __forceinline__ float bflo(unsigned w) { return __builtin_bit_cast(float, w << 16); }
__device__ __forceinline__ float bfhi(unsigned w) { return __builtin_bit_cast(float, w & 0xffff0000u); }
__device__ __forceinline__ float sumsq4(f32x4 v) { return (v.x * v.x + v.y * v.y) + (v.z * v.z + v.w * v.w); }
__device__ __forceinline__ float wave_sum(float v) {
#pragma unroll
    for (int o = 1; o < 64; o <<= 1) v += __shfl_xor(v, o);
    return v;
}
__device__ __forceinline__ const float* xrow(const float* xp, const float* xs, int tok, int width) {
    return tok < NPROMPT ? xp + (size_t)tok * width : xs + (size_t)(tok - NPROMPT) * width;
}


constexpr int NTHR = 512;
#define PG8_LAS __attribute__((address_space(3)))
__device__ __forceinline__ int tid_fresh() { int t = threadIdx.x; asm volatile("" : "+v"(t)); return t; }
__device__ __forceinline__ size_t gtid_fresh() { return (size_t)blockIdx.x * NTHR + tid_fresh(); }
#define GTID gtid_fresh()
#define GSIZE ((size_t)gridDim.x * NTHR)

__device__ __forceinline__ void ph_prep_wt(PG8_LAS unsigned char* lds, const float* __restrict__ W, int K, int N, const float* __restrict__ g1, const float* __restrict__ g2, int ksplit,
                                           bf16_t* __restrict__ out, int ldo, int nscale, float sc) {
    const int tid = tid_fresh(), lane = tid & 63, wave = tid >> 6;
    PG8_LAS float* scr = (PG8_LAS float*)(lds + wave * 8448);
    const int nblk = N / 32, nitems = (K / 64) * nblk;
    for (int item = blockIdx.x * 8 + wave; item < nitems; item += gridDim.x * 8) {
        const int kb = item / nblk, nb = item % nblk, k0 = 64 * kb, n0 = 32 * nb;
#pragma unroll 8
        for (int i = 0; i < 32; ++i) { const int kk = 2 * i + (lane >> 5), k = k0 + kk; float gv = 1.f; if (g1) { const float* gp = (k < ksplit) ? (g1 + k) : (g2 + (k - ksplit)); gv = *gp; }
            scr[kk * 33 + (lane & 31)] = W[(size_t)k * N + n0 + (lane & 31)] * gv; }
        asm volatile("s_waitcnt lgkmcnt(0)" ::: "memory");
        const int c = lane & 7;
#pragma unroll
        for (int j = 0; j < 4; ++j) { const int n = (lane >> 3) + 8 * j; const PG8_LAS float* sp = scr + (8 * c) * 33 + n; const float cs = (n0 + n) < nscale ? sc : 1.f;
            u32x4 o; o.x = pk2(sp[0 * 33] * cs, sp[1 * 33] * cs); o.y = pk2(sp[2 * 33] * cs, sp[3 * 33] * cs); o.z = pk2(sp[4 * 33] * cs, sp[5 * 33] * cs); o.w = pk2(sp[6 * 33] * cs, sp[7 * 33] * cs);
            *(u32x4*)(out + (size_t)(n0 + n) * ldo + k0 + 8 * c) = o; }
        asm volatile("s_waitcnt lgkmcnt(0)" ::: "memory");
    }
}
__device__ __forceinline__ int t5_bucket(int rel) {
    int n = -rel; int ret = n < 0 ? 16 : 0; n = n < 0 ? -n : n;
    if (n < 8) return ret + n;
    int large = 8 + (int)(log((double)n / 8.0) / log(128.0) * 8.0);
    large = large < 15 ? large : 15;
    return ret + large;
}
__device__ __forceinline__ void ph_prep_bias(const float* __restrict__ rel_bias, float* __restrict__ bias) {
    for (size_t i = GTID; i < 3 * 8 * 129; i += GSIZE) {
        const int o = (int)(i % 129), h = (int)((i / 129) % 8), b = (int)(i / (129 * 8));
        const int dil = b == 0 ? 1 : (b == 1 ? 4 : 16);
        bias[i] = rel_bias[t5_bucket((o - 64) * dil) * NH + h] * LOG2E;
    }
}
__device__ __forceinline__ void ph_rows_x(const float* __restrict__ xp, const float* __restrict__ xs, bf16_t* __restrict__ XB, float* __restrict__ RS0) {
    const int tidf = tid_fresh(), lane = tidf & 63;
    for (int row0 = (blockIdx.x * 8 + (tidf >> 6)) * 4; row0 < NT; row0 += gridDim.x * 32) {
        f32x4 v[4][4];
#pragma unroll
        for (int r = 0; r < 4; ++r) { const f32x4* xr = (const f32x4*)xrow(xp, xs, row0 + r, D) + lane;
#pragma unroll
            for (int j = 0; j < 4; ++j) v[r][j] = xr[64 * j]; }
#pragma unroll
        for (int r = 0; r < 4; ++r) { float s = 0.f;
#pragma unroll
            for (int j = 0; j < 4; ++j) s += sumsq4(v[r][j]);
            s = wave_sum(s);
            u32x2* o = (u32x2*)(XB + (size_t)(row0 + r) * D) + lane;
#pragma unroll
            for (int j = 0; j < 4; ++j) { u32x2 w; w.x = pk2(v[r][j].x, v[r][j].y); w.y = pk2(v[r][j].z, v[r][j].w); o[64 * j] = w; }
            if (lane == 0) RS0[row0 + r] = 1.0f / sqrtf(s * (1.0f / D) + EPS); }
    }
}
__device__ __forceinline__ void ph_cvt_p(const float* __restrict__ pp, const float* __restrict__ ps, bf16_t* __restrict__ PB) {
    for (size_t i = GTID; i < (size_t)NT * PLE / 4; i += GSIZE) {
        const int tok = (int)(i / (PLE / 4)), c4 = (int)(i % (PLE / 4));
        const f32x4 v = *((const f32x4*)xrow(pp, ps, tok, PLE) + c4);
        u32x2 w; w.x = pk2(v.x, v.y); w.y = pk2(v.z, v.w);
        *((u32x2*)(PB + (size_t)tok * PLE) + c4) = w;
    }
}
__device__ __forceinline__ void ph_ssm_tab(const float* __restrict__ a_re, const float* __restrict__ a_im, const float* __restrict__ log_dt,
                          const float* __restrict__ b_re, const float* __restrict__ b_im, float* __restrict__ PW, float* __restrict__ BB) {
    for (size_t ii = GTID; ii < (size_t)NG * 2 * NS * 17; ii += GSIZE) {
        const int i = (int)(ii / 17), e = (int)(ii % 17);
        const int n = i % NS, dir = (i / NS) % 2, g = i / (2 * NS);
        const int pi = (dir * NG + g) * NS + n;
        const double ar = a_re[pi], ai = a_im[pi], dt = exp((double)log_dt[dir * NG + g]);
        const double mag = exp(ar * dt * e), ang = ai * dt * e;
        float* pw = PW + ((size_t)((g * 2 + dir) * NS + n) * 17 + e) * 2;
        pw[0] = (float)(mag * cos(ang)); pw[1] = (float)(mag * sin(ang));
    }
    for (size_t ii = GTID; ii < (size_t)NG * 2 * NS; ii += GSIZE) {
        const int i = (int)ii;
        const int n = i % NS, dir = (i / NS) % 2, g = i / (2 * NS);
        const int pi = (dir * NG + g) * NS + n;
        const double ar = a_re[pi], ai = a_im[pi], dt = exp((double)log_dt[dir * NG + g]);
        const double abr = exp(ar * dt) * cos(ai * dt), abi = exp(ar * dt) * sin(ai * dt), inv = 1.0 / (ar * ar + ai * ai);
        const double fr = ((abr - 1.0) * ar + abi * ai) * inv, fi = (abi * ar - (abr - 1.0) * ai) * inv;
        float* bb = BB + (size_t)((g * 2 + dir) * NS + n) * GC * 2;
        for (int h = 0; h < GC; ++h) { const double br = b_re[(size_t)pi * GC + h], bi = b_im[(size_t)pi * GC + h]; bb[2 * h] = (float)(fr * br - fi * bi); bb[2 * h + 1] = (float)(fr * bi + fi * br); }
    }
}
__device__ __forceinline__ void ph_ssm_kt(const float* __restrict__ PW, const float* __restrict__ BB, const float* __restrict__ c_re, const float* __restrict__ c_im, float* __restrict__ KT) {
    for (size_t ii = GTID; ii < (size_t)NG * 2 * 16 * GC; ii += GSIZE) {
        const int i = (int)ii, h = i % GC, e = (i / GC) % 16, dir = (i / (GC * 16)) % 2, g = i / (GC * 16 * 2);
        float acc[GC];
#pragma unroll
        for (int hp = 0; hp < GC; ++hp) acc[hp] = 0.f;
        for (int n = 0; n < NS; ++n) {
            const float* pw = PW + ((size_t)((g * 2 + dir) * NS + n) * 17 + e) * 2; const size_t ci = ((size_t)(dir * NG + g) * GC + h) * NS + n;
            const float cr = c_re[ci], cim = c_im[ci], tr = cr * pw[0] - cim * pw[1], ti = cr * pw[1] + cim * pw[0];
            const f32x4* bb = (const f32x4*)(BB + (size_t)((g * 2 + dir) * NS + n) * GC * 2);
#pragma unroll
            for (int q4 = 0; q4 < 8; ++q4) { const f32x4 b4 = bb[q4]; acc[2 * q4] += tr * b4.x - ti * b4.y; acc[2 * q4 + 1] += tr * b4.z - ti * b4.w; }
        }
        f32x4* o = (f32x4*)(KT + (size_t)i * GC);
#pragma unroll
        for (int q4 = 0; q4 < 4; ++q4) o[q4] = (f32x4){acc[4 * q4], acc[4 * q4 + 1], acc[4 * q4 + 2], acc[4 * q4 + 3]};
    }
}
__device__ __forceinline__ void ph_ssm_ws(const float* __restrict__ PW, const float* __restrict__ BB, bf16_t* __restrict__ WST) {
    for (size_t ii = GTID; ii < (size_t)NG * 256 * 32; ii += GSIZE) {
        const int i = (int)ii, ko = i % 32, col = (i / 32) % 256, g = i / 8192;
        const int j = ko >> 1, hp0 = (ko & 1) * 8, dir = col / 128, n = (col % 128) / 2, ri = col & 1;
        const int e = dir == 0 ? 15 - j : j;
        const float* pw = PW + ((size_t)((g * 2 + dir) * NS + n) * 17 + e) * 2; const float* bb = BB + ((size_t)((g * 2 + dir) * NS + n) * GC + hp0) * 2;
        const float pr = pw[0], pi = pw[1]; float v[8];
#pragma unroll
        for (int t = 0; t < 8; ++t) v[t] = ri ? (pr * bb[2 * t + 1] + pi * bb[2 * t]) : (pr * bb[2 * t] - pi * bb[2 * t + 1]);
        u32x4 o; o.x = pk2(v[0], v[1]); o.y = pk2(v[2], v[3]); o.z = pk2(v[4], v[5]); o.w = pk2(v[6], v[7]);
        *(u32x4*)(WST + (size_t)(g * 256 + col) * 256 + ko * 8) = o;
    }
}
__device__ __forceinline__ void ph_ssm_wy_carry(const float* __restrict__ PW, const float* __restrict__ c_re, const float* __restrict__ c_im, bf16_t* __restrict__ WYT) {
    for (size_t ii = GTID; ii < (size_t)NG * 256 * 32; ii += GSIZE) {
        const int i = (int)ii, ko = i % 32, jh = (i / 32) % 256, g = i / 8192;
        const int j = jh / 16, h = jh % 16, dir = ko / 16, n0 = (ko % 16) * 4;
        const int e = dir == 0 ? j + 1 : 16 - j; float v[8];
#pragma unroll
        for (int t = 0; t < 4; ++t) { const int n = n0 + t; const float* pw = PW + ((size_t)((g * 2 + dir) * NS + n) * 17 + e) * 2; const size_t ci = ((size_t)(dir * NG + g) * GC + h) * NS + n;
            const float cr = c_re[ci], cim = c_im[ci]; v[2 * t] = cr * pw[0] - cim * pw[1]; v[2 * t + 1] = -(cr * pw[1] + cim * pw[0]); }
        u32x4 o; o.x = pk2(v[0], v[1]); o.y = pk2(v[2], v[3]); o.z = pk2(v[4], v[5]); o.w = pk2(v[6], v[7]);
        *(u32x4*)(WYT + (size_t)(g * 256 + jh) * 512 + 256 + ko * 8) = o;
    }
}
__device__ __forceinline__ void ph_ssm_wy_fill(const float* __restrict__ KT, const float* __restrict__ dd, bf16_t* __restrict__ WYT) {
    for (size_t ii = GTID; ii < (size_t)NG * 256 * 32; ii += GSIZE) {
        const int i = (int)ii, ko = i % 32, jh = (i / 32) % 256, g = i / 8192;
        const int j = jh / 16, h = jh % 16, jp = ko >> 1, hp0 = (ko & 1) * 8;
        float v[8];
#pragma unroll
        for (int t = 0; t < 8; ++t) v[t] = 0.f;
        if (j >= jp) { const float* kt = KT + ((size_t)((g * 2 + 0) * 16 + (j - jp)) * GC + h) * GC + hp0;
#pragma unroll
            for (int t = 0; t < 8; ++t) v[t] += kt[t]; }
        if (jp >= j) { const float* kt = KT + ((size_t)((g * 2 + 1) * 16 + (jp - j)) * GC + h) * GC + hp0;
#pragma unroll
            for (int t = 0; t < 8; ++t) v[t] += kt[t]; }
        if (jp == j) { const float dv = dd[g * GC + h];
#pragma unroll
            for (int t = 0; t < 8; ++t) if (hp0 + t == h) v[t] += dv; }
        u32x4 o; o.x = pk2(v[0], v[1]); o.y = pk2(v[2], v[3]); o.z = pk2(v[4], v[5]); o.w = pk2(v[6], v[7]);
        *(u32x4*)(WYT + (size_t)(g * 256 + jh) * 512 + ko * 8) = o;
    }
}

__device__ __forceinline__ void st_bf4(bf16_t* p, f32x4 v) { u32x2 w; w.x = pk2(v.x, v.y); w.y = pk2(v.z, v.w); *(u32x2*)p = w; }
__device__ __forceinline__ f32x4 ld_bf4(const bf16_t* p) { const u32x2 w = *(const u32x2*)p; return (f32x4){bflo(w.x), bfhi(w.x), bflo(w.y), bfhi(w.y)}; }
namespace pg8 {
constexpr int BM = 256, BK = 64, HALF = 128, HTB = HALF * BK * 2  , STAGE_BYTES = 8 * HTB, NXCD = 8, WGM = 8;

__host__ __device__ __forceinline__ int lds_byte(int r, int c) { const int st = (r >> 4) * 2 + (c >> 5), rr = r & 15, cc = c & 31, ob = rr * 64 + cc * 2; return st * 1024 + (ob ^ (((ob >> 9) & 1) << 5)); }
__host__ __device__ __forceinline__ void stage_rc(int b, int& R, int& C) { const int st = b / 1024, sb = b % 1024, swz = sb ^ (((sb >> 9) & 1) << 5); R = (st >> 1) * 16 + swz / 64; C = (st & 1) * 32 + (swz % 64) / 2; }
__host__ __device__ __forceinline__ int perm32(int rho) { const int n = rho >> 4, i = rho & 15; return 8 * (i >> 2) + 4 * n + (i & 3); }
struct Unit { int pm, pn, kh; };
struct Gemm { const bf16_t* A; const bf16_t* Bt; int lda, ldb, K, khb; };
struct Order {
    int nM, nN, nwg, G, c, split, bdiv;
    __device__ void init(int M, int N, int G_, int c_, int split_ = 0, int bdiv_ = 0) { nM = M / BM; nN = N / BM; nwg = nM * nN; G = G_; c = c_; split = split_; bdiv = bdiv_; }
    __device__ bool next(int i, Unit& u) const {
        const int ti = split ? (i >> 1) : i;
        const long L = (long)ti * G + c; if (L >= nwg) return false;
        int wgid = (int)L; { const int q = nwg / NXCD, r = nwg % NXCD, xcd = wgid % NXCD, off = wgid / NXCD; wgid = (xcd < r ? xcd * (q + 1) : r * (q + 1) + (xcd - r) * q) + off; }
        const int nig = WGM * nN, gid = wgid / nig, fm = gid * WGM, gsz = (nM - fm) < WGM ? (nM - fm) : WGM;
        u.pm = fm + ((wgid % nig) % gsz); u.pn = (wgid % nig) / gsz; u.kh = split ? (i & 1) : 0;
        if (bdiv) u.pn = u.pm / bdiv;
        return true;
    }
    __device__ __forceinline__ void a_ready(const Unit&) const {}
    __device__ __forceinline__ void done(const Unit&) const {}
};
__device__ __forceinline__ unsigned cvt_pk_bf16(float lo, float hi) { unsigned r; asm volatile("v_cvt_pk_bf16_f32 %0, %1, %2" : "=v"(r) : "v"(lo), "v"(hi)); return r; }
template <class Epi, class Sched, bool ALIGN_EPI = false, bool SP2 = false>
__device__ __forceinline__ void gemm_phase(PG8_LAS unsigned char* lds, const Gemm g, const Sched& S, const Epi& E) {
    const int tid = tid_fresh(), wid = __builtin_amdgcn_readfirstlane(tid >> 6), lane = tid & 63, wr = wid >> 2, wc = wid & 3, fr = lane & 15, fq = lane >> 4;
    const int K = g.K, nt = K / BK;
    unsigned voffA[2], voffB[2];
#pragma unroll
    for (int i = 0; i < 2; ++i) { int R, C; stage_rc(tid * 16 + i * 8192, R, C); const int Rb = Epi::PERM ? ((R & ~31) + perm32(R & 31)) : R;
        voffA[i] = (unsigned)(R * g.lda + C) * 2u; voffB[i] = (unsigned)(Rb * g.ldb + C) * 2u; }
    const size_t kstep = (size_t)(BK * 2);
    const size_t hstepA = (size_t)HALF * g.lda * 2, hstepB = (size_t)HALF * g.ldb * 2;
    const size_t tstepA = 2 * hstepA, tstepB = 2 * hstepB;
    const unsigned ldsw = (unsigned)wid * 1024u;
    const int aoff = lds_byte(wr * 64 + fr, fq * 8), boff = lds_byte(wc * 32 + fr, fq * 8);
#define PG8_SA(b, h) (((b) * 2 + (h)) * HTB)
#define PG8_SB(b, h) ((4 + (b) * 2 + (h)) * HTB)
#define PG8_STAGE(bufoff, gbase, voff) do { _Pragma("unroll") for (int _i = 0; _i < 2; ++_i) \
        __builtin_amdgcn_global_load_lds((const unsigned*)((const char*)(gbase) + (voff)[_i]), (PG8_LAS unsigned*)(lds + (bufoff) + ldsw + _i * 8192), 16, 0, 0); } while (0)
#define PG8_LDA(dst, b, h) do { _Pragma("unroll") for (int m = 0; m < 4; ++m) _Pragma("unroll") for (int k = 0; k < 2; ++k) dst[m][k] = *(const PG8_LAS bf16x8*)(lds + PG8_SA(b, h) + aoff + m * 2048 + k * 1024); } while (0)
#define PG8_LDB(dst, b, h) do { _Pragma("unroll") for (int n = 0; n < 2; ++n) _Pragma("unroll") for (int k = 0; k < 2; ++k) dst[n][k] = *(const PG8_LAS bf16x8*)(lds + PG8_SB(b, h) + boff + n * 2048 + k * 1024); } while (0)
#define PG8_MMA(ai, bj, At, Bt) do { __builtin_amdgcn_s_setprio(1); _Pragma("unroll") for (int m = 0; m < 4; ++m) _Pragma("unroll") for (int n = 0; n < 2; ++n) _Pragma("unroll") for (int k = 0; k < 2; ++k) \
        acc[ai][bj][m][n] = __builtin_amdgcn_mfma_f32_16x16x32_bf16(Bt[n][k], At[m][k], acc[ai][bj][m][n], 0, 0, 0); __builtin_amdgcn_s_setprio(0); } while (0)
#define PG8_WAIT_V(n) asm volatile("s_waitcnt vmcnt(" #n ")" ::: "memory")
#define PG8_WAIT_L(n) asm volatile("s_waitcnt lgkmcnt(" #n ")" ::: "memory")
#define PG8_BAR __builtin_amdgcn_s_barrier()
#define PG8_SCHED __builtin_amdgcn_sched_barrier(0)
    Unit cur, nxt; int ui = 0;
    if (!S.next(0, cur)) return;
    f32x4 acc[2][2][4][2];
#pragma unroll
    for (int a = 0; a < 2; ++a)
#pragma unroll
        for (int b = 0; b < 2; ++b)
#pragma unroll
            for (int m = 0; m < 4; ++m)
#pragma unroll
                for (int n = 0; n < 2; ++n) acc[a][b][m][n] = (f32x4){0.f, 0.f, 0.f, 0.f};
    bf16x8 At[4][2], B0[2][2], B1[2][2];
    const char* cA = (const char*)g.A + (size_t)cur.pm * tstepA + (size_t)cur.kh * g.khb; const char* cB = (const char*)g.Bt + (size_t)cur.pn * tstepB + (size_t)cur.kh * g.khb;
    S.a_ready(cur);
    if constexpr (SP2) {
        PG8_STAGE(PG8_SB(0, 0), cB, voffB); PG8_STAGE(PG8_SB(0, 1), cB + hstepB, voffB); PG8_STAGE(PG8_SA(0, 0), cA, voffA); PG8_STAGE(PG8_SA(0, 1), cA + hstepA, voffA);
        if (wr == 1) PG8_BAR;
        PG8_WAIT_V(2); PG8_BAR;
        PG8_STAGE(PG8_SB(1, 0), cB + kstep, voffB); PG8_STAGE(PG8_SA(1, 0), cA + kstep, voffA); PG8_STAGE(PG8_SB(1, 1), cB + hstepB + kstep, voffB);
        PG8_WAIT_V(6); PG8_BAR;
    } else {
        PG8_STAGE(PG8_SB(0, 0), cB, voffB); PG8_STAGE(PG8_SA(0, 0), cA, voffA); PG8_STAGE(PG8_SB(0, 1), cB + hstepB, voffB); PG8_STAGE(PG8_SA(0, 1), cA + hstepA, voffA);
        if (wr == 1) PG8_BAR;
        PG8_WAIT_V(4); PG8_BAR;
        PG8_STAGE(PG8_SB(1, 0), cB + kstep, voffB); PG8_STAGE(PG8_SA(1, 0), cA + kstep, voffA); PG8_STAGE(PG8_SB(1, 1), cB + hstepB + kstep, voffB);
        PG8_WAIT_V(6); PG8_BAR;
    }
    for (;;) {
        const bool has_next = S.next(ui + 1, nxt);
        const char* nA = has_next ? (const char*)g.A + (size_t)nxt.pm * tstepA + (size_t)nxt.kh * g.khb : cA; const char* nB = has_next ? (const char*)g.Bt + (size_t)nxt.pn * tstepB + (size_t)nxt.kh * g.khb : cB;
#pragma nounroll
        for (int t = 0; t < nt; t += 2) {
            const bool last = (t == nt - 2);
            const char* a1 = cA + (size_t)(t + 1) * kstep;
            const char* a2 = last ? nA : cA + (size_t)(t + 2) * kstep; const char* b2 = last ? nB : cB + (size_t)(t + 2) * kstep;
            const char* a3 = a2 + kstep; const char* b3 = b2 + kstep;
            if (last && has_next) S.a_ready(nxt);
            if constexpr (SP2) {
            PG8_LDB(B0, 0, 0); PG8_LDB(B1, 0, 1); PG8_SCHED; PG8_LDA(At, 0, 0); PG8_STAGE(PG8_SA(1, 1), a1 + hstepA, voffA);
            PG8_WAIT_V(8); PG8_WAIT_L(0); PG8_BAR; PG8_MMA(0, 0, At, B0); PG8_MMA(0, 1, At, B1); PG8_BAR; PG8_SCHED;
            PG8_LDA(At, 0, 1); PG8_STAGE(PG8_SB(0, 0), b2, voffB); PG8_STAGE(PG8_SB(0, 1), b2 + hstepB, voffB); PG8_STAGE(PG8_SA(0, 0), a2, voffA);
            PG8_WAIT_V(8); PG8_WAIT_L(0); PG8_BAR; PG8_MMA(1, 0, At, B0); PG8_MMA(1, 1, At, B1); PG8_BAR; PG8_SCHED;
            PG8_LDB(B0, 1, 0); PG8_LDB(B1, 1, 1); PG8_SCHED; PG8_LDA(At, 1, 0); PG8_STAGE(PG8_SA(0, 1), a2 + hstepA, voffA);
            PG8_WAIT_V(8); PG8_WAIT_L(0); PG8_BAR; PG8_MMA(0, 0, At, B0); PG8_MMA(0, 1, At, B1); PG8_BAR; PG8_SCHED;
            PG8_LDA(At, 1, 1); PG8_STAGE(PG8_SB(1, 0), b3, voffB); PG8_STAGE(PG8_SB(1, 1), b3 + hstepB, voffB); PG8_STAGE(PG8_SA(1, 0), a3, voffA);
            PG8_WAIT_V(8); PG8_WAIT_L(0); PG8_BAR; PG8_MMA(1, 0, At, B0); PG8_MMA(1, 1, At, B1); PG8_BAR; PG8_SCHED;
            } else {
            PG8_LDB(B0, 0, 0); PG8_SCHED; PG8_LDA(At, 0, 0); PG8_STAGE(PG8_SA(1, 1), a1 + hstepA, voffA);
            PG8_WAIT_L(8); PG8_BAR; PG8_WAIT_L(0); PG8_MMA(0, 0, At, B0); PG8_BAR; PG8_SCHED;
            PG8_LDB(B1, 0, 1); PG8_STAGE(PG8_SB(0, 0), b2, voffB);
            PG8_BAR; PG8_WAIT_L(0); PG8_MMA(0, 1, At, B1); PG8_BAR;
            PG8_LDA(At, 0, 1); PG8_STAGE(PG8_SA(0, 0), a2, voffA);
            PG8_BAR; PG8_WAIT_L(0); PG8_MMA(1, 0, At, B0); PG8_BAR; PG8_SCHED;
            PG8_STAGE(PG8_SB(0, 1), b2 + hstepB, voffB);
            PG8_WAIT_V(6); PG8_BAR; PG8_MMA(1, 1, At, B1); PG8_BAR;
            PG8_LDB(B0, 1, 0); PG8_SCHED; PG8_LDA(At, 1, 0); PG8_STAGE(PG8_SA(0, 1), a2 + hstepA, voffA);
            PG8_WAIT_L(8); PG8_BAR; PG8_WAIT_L(0); PG8_MMA(0, 0, At, B0); PG8_BAR; PG8_SCHED;
            PG8_LDB(B1, 1, 1); PG8_STAGE(PG8_SB(1, 0), b3, voffB);
            PG8_BAR; PG8_WAIT_L(0); PG8_MMA(0, 1, At, B1); PG8_BAR;
            PG8_LDA(At, 1, 1); PG8_STAGE(PG8_SA(1, 0), a3, voffA);
            PG8_BAR; PG8_WAIT_L(0); PG8_MMA(1, 0, At, B0); PG8_BAR; PG8_SCHED;
            PG8_STAGE(PG8_SB(1, 1), b3 + hstepB, voffB);
            PG8_WAIT_V(6); PG8_BAR; PG8_MMA(1, 1, At, B1); PG8_BAR;
            }
        }
        if constexpr (ALIGN_EPI) { if (wr == 0) PG8_BAR; }
        if constexpr (!Epi::AFTER_DRAIN) { E(acc, cur, wr, wc, fr, fq); S.done(cur); }
        if (!has_next) break;
        if (Epi::zero_after(cur)) {
#pragma unroll
        for (int a = 0; a < 2; ++a)
#pragma unroll
            for (int b = 0; b < 2; ++b)
#pragma unroll
                for (int m = 0; m < 4; ++m)
#pragma unroll
                    for (int n = 0; n < 2; ++n) acc[a][b][m][n] = (f32x4){0.f, 0.f, 0.f, 0.f};
        }
        cur = nxt; cA = nA; cB = nB; ++ui;
        if constexpr (ALIGN_EPI) { if (wr == 1) PG8_BAR; }
    }
    PG8_WAIT_V(0);
    if constexpr (!ALIGN_EPI) { if (wr == 0) PG8_BAR; }
    PG8_BAR;
    if constexpr (Epi::AFTER_DRAIN) { E.fused(acc, cur, wr, wc, fr, fq, lds, wid, lane); S.done(cur); }
#undef PG8_SA
#undef PG8_SB
#undef PG8_STAGE
#undef PG8_LDA
#undef PG8_LDB
#undef PG8_MMA
#undef PG8_WAIT_V
#undef PG8_WAIT_L
#undef PG8_BAR
#undef PG8_SCHED
}
}

typedef f32x4 AccT[2][2][4][2];
__device__ __forceinline__ float sigm(float x) { return 1.0f / (1.0f + __expf(-x)); }
__device__ __forceinline__ float gelu_tanh(float x) { const float u = 0.7978845608028654f * (x + 0.044715f * x * x * x); return 0.5f * x * (1.0f + tanhf(u)); }
__device__ __forceinline__ u32x4 pack8(f32x4 a, f32x4 b) { u32x4 w; w.x = pg8::cvt_pk_bf16(a.x, a.y); w.y = pg8::cvt_pk_bf16(a.z, a.w); w.z = pg8::cvt_pk_bf16(b.x, b.y); w.w = pg8::cvt_pk_bf16(b.z, b.w); return w; }
__device__ __forceinline__ void unpack8(u32x4 w, f32x4& a, f32x4& b) { a = (f32x4){bflo(w.x), bfhi(w.x), bflo(w.y), bfhi(w.y)}; b = (f32x4){bflo(w.z), bfhi(w.z), bflo(w.w), bfhi(w.w)}; }
__device__ __forceinline__ float sum8f(const float* p) { const f32x4 a = *(const f32x4*)p, b = *(const f32x4*)(p + 4); return ((a.x + a.y) + (a.z + a.w)) + ((b.x + b.y) + (b.z + b.w)); }
__device__ __forceinline__ float sum16f(const float* p) { return sum8f(p) + sum8f(p + 8); }
__device__ __forceinline__ float red_fq(float s) { s += __shfl_xor(s, 16); s += __shfl_xor(s, 32); return s; }
#define EPI_ROWS(...) _Pragma("unroll") for (int ai = 0; ai < 2; ++ai) _Pragma("unroll") for (int m = 0; m < 4; ++m) { const int row = u.pm * 256 + ai * 128 + wr * 64 + m * 16 + fr; __VA_ARGS__ }
#define EPI_COLS(...) _Pragma("unroll") for (int bj = 0; bj < 2; ++bj) { const int col = u.pn * 256 + bj * 128 + wc * 32 + 8 * fq; f32x4& v0 = acc[ai][bj][m][0]; f32x4& v1 = acc[ai][bj][m][1]; __VA_ARGS__ }

struct EpiIn {
    static constexpr bool PERM = true, AFTER_DRAIN = false; __device__ static bool zero_after(const pg8::Unit&) { return true; }
    const float* RS0; bf16_t *QB, *KB, *VB, *UH;
    __device__ __forceinline__ void operator()(AccT& acc, const pg8::Unit& u, int wr, int wc, int fr, int fq) const {
        EPI_ROWS( const float rs = RS0[row];
            EPI_COLS( const u32x4 w = pack8(v0 * rs, v1 * rs);
                if (u.pn < 6) { bf16_t* dst = QB + (size_t)(u.pn >> 1) * ((size_t)NT * AW); *(u32x4*)(dst + (size_t)row * AW + (col & (AW - 1))) = w; }
                else { const int c = col - 3 * AW, g = c >> 4, ch = c & 15; *(u32x4*)(UH + ((size_t)(g * NCHT + (row >> 4))) * 512 + (row & 15) * 16 + ch) = w; } ) )
    }
};
struct EpiS {
    static constexpr bool PERM = true, AFTER_DRAIN = false; __device__ static bool zero_after(const pg8::Unit&) { return true; }
    bf16_t* SB;
    __device__ __forceinline__ void operator()(AccT& acc, const pg8::Unit& u, int wr, int wc, int fr, int fq) const {
        EPI_ROWS( EPI_COLS( *(u32x4*)(SB + (size_t)row * 256 + (col - u.pn * 256)) = pack8(v0, v1); ) )
    }
};
struct EpiY {
    static constexpr bool PERM = true, AFTER_DRAIN = false; __device__ static bool zero_after(const pg8::Unit&) { return true; }
    bf16_t* GB;
    __device__ __forceinline__ void operator()(AccT& acc, const pg8::Unit& u, int wr, int wc, int fr, int fq) const {
        const int g = u.pn;
        EPI_ROWS( const int chunk = row - g * NCHT;
            EPI_COLS( const int cl = col - u.pn * 256, j = cl >> 4, h = cl & 15; const size_t tok = (size_t)chunk * 16 + j;
                f32x4 a, b; a.x = gelu_tanh(v0.x); a.y = gelu_tanh(v0.y); a.z = gelu_tanh(v0.z); a.w = gelu_tanh(v0.w); b.x = gelu_tanh(v1.x); b.y = gelu_tanh(v1.y); b.z = gelu_tanh(v1.z); b.w = gelu_tanh(v1.w);
                *(u32x4*)(GB + tok * SW + g * 16 + h) = pack8(a, b); ) )
    }
};
struct EpiGlu {
    static constexpr bool PERM = true, AFTER_DRAIN = false; __device__ static bool zero_after(const pg8::Unit&) { return true; }
    const bf16_t* GB; const float* bglu; bf16_t* MIX; float* SSQS;
    __device__ __forceinline__ void operator()(AccT& acc, const pg8::Unit& u, int wr, int wc, int fr, int fq) const {
        EPI_ROWS( float sq = 0.f;
            EPI_COLS( f32x4 g0, g1; unpack8(*(const u32x4*)(GB + (size_t)row * SW + col), g0, g1); const f32x4 b0 = *(const f32x4*)(bglu + col), b1 = *(const f32x4*)(bglu + col + 4);
                f32x4 o0, o1; o0.x = g0.x * sigm(v0.x + b0.x); o0.y = g0.y * sigm(v0.y + b0.y); o0.z = g0.z * sigm(v0.z + b0.z); o0.w = g0.w * sigm(v0.w + b0.w);
                o1.x = g1.x * sigm(v1.x + b1.x); o1.y = g1.y * sigm(v1.y + b1.y); o1.z = g1.z * sigm(v1.z + b1.z); o1.w = g1.w * sigm(v1.w + b1.w);
                sq += sumsq4(o0) + sumsq4(o1); *(u32x4*)(MIX + (size_t)row * D + AW + col) = pack8(o0, o1); )
            sq = red_fq(sq); if (fq == 0) SSQS[(size_t)row * 8 + u.pn * 4 + wc] = sq; )
    }
};
struct EpiOut {
    static constexpr bool PERM = true, AFTER_DRAIN = false; __device__ static bool zero_after(const pg8::Unit& u) { return u.kh != 0; }
    const bf16_t* XB; const float *SSQA, *SSQS; bf16_t* H1B; float* SSQ1;
    __device__ __forceinline__ void operator()(AccT& acc, const pg8::Unit& u, int wr, int wc, int fr, int fq) const {
        if (u.kh == 0) {
            EPI_ROWS( const float rsa = 1.0f / sqrtf(sum8f(SSQA + (size_t)row * 8) * (1.0f / AW) + EPS), rss = 1.0f / sqrtf(sum8f(SSQS + (size_t)row * 8) * (1.0f / SW) + EPS); const float r = rsa / rss;
                EPI_COLS( v0 = v0 * r; v1 = v1 * r; ) )
        } else {
            EPI_ROWS( const float rss = 1.0f / sqrtf(sum8f(SSQS + (size_t)row * 8) * (1.0f / SW) + EPS); float sq = 0.f;
                EPI_COLS( f32x4 x0, x1; unpack8(*(const u32x4*)(XB + (size_t)row * D + col), x0, x1); const f32x4 o0 = x0 + v0 * rss, o1 = x1 + v1 * rss;
                    sq += sumsq4(o0) + sumsq4(o1); *(u32x4*)(H1B + (size_t)row * D + col) = pack8(o0, o1); )
                sq = red_fq(sq); if (fq == 0) SSQ1[(size_t)row * 16 + u.pn * 4 + wc] = sq; )
        }
    }
};
struct EpiMlp1 {
    static constexpr bool PERM = true, AFTER_DRAIN = false; __device__ static bool zero_after(const pg8::Unit&) { return true; }
    const float* SSQ1; bf16_t* HID;
    __device__ __forceinline__ void operator()(AccT& acc, const pg8::Unit& u, int wr, int wc, int fr, int fq) const {
        EPI_ROWS( const float rs = 1.0f / sqrtf(sum16f(SSQ1 + (size_t)row * 16) * (1.0f / D) + EPS);
            EPI_COLS( f32x4 a = v0 * rs, b = v1 * rs; a.x = fmaxf(a.x, 0.f); a.y = fmaxf(a.y, 0.f); a.z = fmaxf(a.z, 0.f); a.w = fmaxf(a.w, 0.f); b.x = fmaxf(b.x, 0.f); b.y = fmaxf(b.y, 0.f); b.z = fmaxf(b.z, 0.f); b.w = fmaxf(b.w, 0.f);
                *(u32x4*)(HID + (size_t)row * DFF + col) = pack8(a * a, b * b); ) )
    }
};
struct EpiMlp2 {
    static constexpr bool PERM = true, AFTER_DRAIN = false; __device__ static bool zero_after(const pg8::Unit&) { return true; }
    const bf16_t* H1B; bf16_t* H2B; float* SSQ2;
    __device__ __forceinline__ void operator()(AccT& acc, const pg8::Unit& u, int wr, int wc, int fr, int fq) const {
        EPI_ROWS( float sq = 0.f;
            EPI_COLS( f32x4 h0, h1; unpack8(*(const u32x4*)(H1B + (size_t)row * D + col), h0, h1); const f32x4 o0 = h0 + v0, o1 = h1 + v1;
                sq += sumsq4(o0) + sumsq4(o1); *(u32x4*)(H2B + (size_t)row * D + col) = pack8(o0, o1); )
            sq = red_fq(sq); if (fq == 0) SSQ2[(size_t)row * 16 + u.pn * 4 + wc] = sq; )
    }
};
struct EpiPP {
    static constexpr bool PERM = true, AFTER_DRAIN = false; __device__ static bool zero_after(const pg8::Unit&) { return true; }
    bf16_t* PP;
    __device__ __forceinline__ void operator()(AccT& acc, const pg8::Unit& u, int wr, int wc, int fr, int fq) const {
        EPI_ROWS( EPI_COLS( *(u32x4*)(PP + (size_t)row * D + col) = pack8(v0, v1); ) )
    }
};
struct EpiGate {
    static constexpr bool PERM = true, AFTER_DRAIN = false; __device__ static bool zero_after(const pg8::Unit&) { return true; }
    const float* SSQ2; const bf16_t* H2B; const bf16_t* PP; float* H3F;
    __device__ __forceinline__ void operator()(AccT& acc, const pg8::Unit& u, int wr, int wc, int fr, int fq) const {
        EPI_ROWS( const float rs = 1.0f / sqrtf(sum16f(SSQ2 + (size_t)row * 16) * (1.0f / D) + EPS);
            EPI_COLS( f32x4 h0, h1, p0, p1; unpack8(*(const u32x4*)(H2B + (size_t)row * D + col), h0, h1); unpack8(*(const u32x4*)(PP + (size_t)row * D + col), p0, p1);
                f32x4 o0, o1; o0.x = h0.x + sigm(v0.x * rs) * p0.x; o0.y = h0.y + sigm(v0.y * rs) * p0.y; o0.z = h0.z + sigm(v0.z * rs) * p0.z; o0.w = h0.w + sigm(v0.w * rs) * p0.w;
                o1.x = h1.x + sigm(v1.x * rs) * p1.x; o1.y = h1.y + sigm(v1.y * rs) * p1.y; o1.z = h1.z + sigm(v1.z * rs) * p1.z; o1.w = h1.w + sigm(v1.w * rs) * p1.w;
                *(f32x4*)(H3F + (size_t)row * D + col) = o0; *(f32x4*)(H3F + (size_t)row * D + col + 4) = o1; ) )
    }
};

__device__ __forceinline__ void ph_final(const float* __restrict__ H3F, const float* __restrict__ gf, float* __restrict__ out) {
    const int tidf = tid_fresh(), lane = tidf & 63;
    const f32x4* g4 = (const f32x4*)gf + lane;
    for (int row0 = (blockIdx.x * 8 + (tidf >> 6)) * 4; row0 < NT; row0 += gridDim.x * 32) {
        f32x4 v[4][4];
#pragma unroll
        for (int r = 0; r < 4; ++r) { const f32x4* xr = (const f32x4*)(H3F + (size_t)(row0 + r) * D) + lane;
#pragma unroll
            for (int j = 0; j < 4; ++j) v[r][j] = xr[64 * j]; }
#pragma unroll
        for (int r = 0; r < 4; ++r) { float s = 0.f;
#pragma unroll
            for (int j = 0; j < 4; ++j) s += sumsq4(v[r][j]);
            s = wave_sum(s); const float rs = 1.0f / sqrtf(s * (1.0f / D) + EPS);
            f32x4* o = (f32x4*)(out + (size_t)(row0 + r) * D) + lane;
#pragma unroll
            for (int j = 0; j < 4; ++j) o[64 * j] = v[r][j] * rs * g4[64 * j]; }
    }
}

typedef float f32x16 __attribute__((ext_vector_type(16)));
typedef short v4i16_t __attribute__((ext_vector_type(4)));
typedef float f32x2_t __attribute__((ext_vector_type(2))); typedef __bf16 bf16x2_t __attribute__((ext_vector_type(2)));
__device__ __forceinline__ unsigned cvtpk_s(float lo, float hi) { f32x2_t v = {lo, hi}; bf16x2_t b = __builtin_convertvector(v, bf16x2_t); return __builtin_bit_cast(unsigned, b); }
__device__ __forceinline__ float xhalf_max(float v) { auto rr = __builtin_amdgcn_permlane32_swap(__float_as_uint(v), __float_as_uint(v), false, false); return fmaxf(__uint_as_float(rr[0]), __uint_as_float(rr[1])); }
__device__ __forceinline__ float xhalf_sum(float v) { auto rr = __builtin_amdgcn_permlane32_swap(__float_as_uint(v), __float_as_uint(v), false, false); return __uint_as_float(rr[0]) + __uint_as_float(rr[1]); }
constexpr int ATT_TB_BYTES = 4096;
constexpr int ATT_KV_OFF = ATT_TB_BYTES, ATT_KV_BYTES = 8192, ATT_WAVE_BYTES = 2 * ATT_KV_BYTES, ATT_LDS = ATT_KV_OFF + 8 * ATT_WAVE_BYTES;
static_assert(ATT_LDS <= 147456 - 64, "attention LDS below the grid barrier's two words");
template <int MODE>
__device__ __forceinline__ void ph_attn(PG8_LAS unsigned char* lds, const bf16_t* __restrict__ QB, const bf16_t* __restrict__ KB, const bf16_t* __restrict__ VB, const float* __restrict__ bias,
                                        bf16_t* MIX, float* AM, float* AL, float* __restrict__ SSQA) {
    const int tid = tid_fresh(), lane = tid & 63, wid = __builtin_amdgcn_readfirstlane(tid >> 6), q = lane & 31, hi = lane >> 5;
    PG8_LAS unsigned char* wbuf = lds + ATT_KV_OFF + wid * ATT_WAVE_BYTES;
    const int krow = lane >> 3, kch = (lane & 7) ^ (lane >> 3), vrow16 = lane >> 2, vch = lane & 3;
    const PG8_LAS unsigned char* krd = wbuf + q * 128;
    const int kx = q & 7;
    const PG8_LAS unsigned char* vrd = wbuf + 4096 + (4 * hi + ((lane & 15) >> 2)) * 64 + (16 * ((lane >> 4) & 1) + 4 * (lane & 3)) * 2;
    const PG8_LAS float* tbl = (const PG8_LAS float*)lds + (4 * hi - q + 31);
    int last_h = -1;
    constexpr int NITEM = NH * NSEQ * 16;
    for (int it = blockIdx.x; it < NITEM; it += gridDim.x) {
        const int h = it & 7, sw = it >> 3, sq_ = sw >> 4, w = (MODE == 0) ? (sw & 15) : ((sw & 15) >> 1), half = sw & 1;
        if (h != last_h) {
            __syncthreads();
            for (int e = tid; e < 3 * 256; e += NTHR) { const int b = e >> 8, off = (e & 255) - 127; ((PG8_LAS float*)lds)[e] = (off >= -64 && off <= 64) ? bias[(b * NH + h) * 129 + off + 64] : -1e30f; }
            __syncthreads(); last_h = h;
        }
        const int p0 = (MODE == 0) ? w * 512 : w * 1024; const size_t seqbase = (size_t)sq_ * SEQ;
#pragma unroll 1
        for (int b = (MODE == 0 ? 0 : 2); b < (MODE == 0 ? 2 : 3); ++b) {
            const int dsh = 2 * b, L = SEQ >> dsh;
            const PG8_LAS float* tb = tbl + b * 256;
            {
                int r, m0;
                if (b == 0) { r = 0; m0 = p0 + 64 * wid; } else if (b == 1) { r = wid & 3; m0 = (p0 >> 2) + 64 * (wid >> 2); } else { r = 8 * half + wid; m0 = p0 >> 4; }
                const size_t qtokA = seqbase + ((size_t)(m0 + q) << dsh) + r, qtokB = qtokA + ((size_t)32 << dsh);
                bf16x8 qfA[4], qfB[4];
#pragma unroll
                for (int s4 = 0; s4 < 4; ++s4) { qfA[s4] = *(const bf16x8*)(QB + qtokA * AW + h * HD + 16 * s4 + 8 * hi); qfB[s4] = *(const bf16x8*)(QB + qtokB * AW + h * HD + 16 * s4 + 8 * hi); }
                float mA = -1e30f, lA = 0.f, mB = -1e30f, lB = 0.f; f32x16 oA0, oA1, oB0, oB1;
#pragma unroll
                for (int e = 0; e < 16; ++e) { oA0[e] = 0.f; oA1[e] = 0.f; oB0[e] = 0.f; oB1[e] = 0.f; }
                const size_t kstep8 = ((size_t)8 << dsh) * AW, vstep16 = ((size_t)16 << dsh) * AW;
#define ATT_DMA(KT, BUF) do { int kto_ = (KT); asm volatile("" : "+s"(kto_));     \
                    const int mk0_ = m0 + 32 * kto_; const int mkc_ = (mk0_ >= 0 && mk0_ < L) ? mk0_ : m0; \
                    const bf16_t* kp_ = KB + (seqbase + ((size_t)(mkc_ + krow) << dsh) + r) * AW + h * HD + 8 * kch; \
                    const bf16_t* vp_ = VB + (seqbase + ((size_t)(mkc_ + vrow16) << dsh) + r) * AW + h * HD + 8 * vch; \
                    _Pragma("unroll") for (int j4 = 0; j4 < 4; ++j4) __builtin_amdgcn_global_load_lds((const unsigned*)(kp_ + j4 * kstep8), (PG8_LAS unsigned*)(wbuf + (BUF) * ATT_KV_BYTES + j4 * 1024), 16, 0, 0); \
                    _Pragma("unroll") for (int j4 = 0; j4 < 4; ++j4) __builtin_amdgcn_global_load_lds((const unsigned*)(vp_ + (j4 & 1) * vstep16 + (j4 >> 1) * 32), (PG8_LAS unsigned*)(wbuf + (BUF) * ATT_KV_BYTES + 4096 + j4 * 1024), 16, 0, 0); \
                } while (0)
#define ATT_VTR(off) __builtin_amdgcn_ds_read_tr16_b64_v4i16((PG8_LAS v4i16_t*)(vrd + (off)))
#define ATT_VF(lo4, hi4) (bf16x8){lo4[0], lo4[1], lo4[2], lo4[3], hi4[0], hi4[1], hi4[2], hi4[3]}
#define ATT_QK(ACC, QF, REL, BUF) do { \
                    _Pragma("unroll") for (int e = 0; e < 16; ++e) ACC[e] = tb[32 * (REL) + 96 + (e & 3) + 8 * (e >> 2)]; \
                    { bf16x8 kf[4]; \
                      _Pragma("unroll") for (int s4 = 0; s4 < 4; ++s4) kf[s4] = *(const PG8_LAS bf16x8*)(krd + (BUF) * ATT_KV_BYTES + (((2 * s4 + hi) ^ kx) * 16)); \
                      _Pragma("unroll") for (int s4 = 0; s4 < 4; ++s4) ACC = __builtin_amdgcn_mfma_f32_32x32x16_bf16(kf[s4], QF[s4], ACC, 0, 0, 0); } \
                } while (0)
#define ATT_SM(ACC, PW0, PW1, O0, O1, MR, LP) do { \
                    if (!valid) { _Pragma("unroll") for (int e = 0; e < 16; ++e) ACC[e] = -1e30f; } \
                    float tm = fmaxf(ACC[0], ACC[1]); \
                    _Pragma("unroll") for (int e = 2; e < 16; ++e) tm = fmaxf(tm, ACC[e]); \
                    tm = xhalf_max(tm); \
                    const float mn = fmaxf(MR, tm), sc = __builtin_amdgcn_exp2f(MR - mn); MR = mn; \
                    float rs = 0.f; \
                    _Pragma("unroll") for (int e = 0; e < 16; ++e) { ACC[e] = __builtin_amdgcn_exp2f(ACC[e] - mn); rs += ACC[e]; } \
                    LP = LP * sc + rs; asm volatile("" : "+v"(LP), "+v"(MR));     \
                    _Pragma("unroll") for (int e = 0; e < 16; ++e) { O0[e] *= sc; O1[e] *= sc; } \
                    PW0.x = cvtpk_s(ACC[0], ACC[1]); PW0.y = cvtpk_s(ACC[2], ACC[3]); PW0.z = cvtpk_s(ACC[4], ACC[5]); PW0.w = cvtpk_s(ACC[6], ACC[7]); \
                    PW1.x = cvtpk_s(ACC[8], ACC[9]); PW1.y = cvtpk_s(ACC[10], ACC[11]); PW1.z = cvtpk_s(ACC[12], ACC[13]); PW1.w = cvtpk_s(ACC[14], ACC[15]); \
                } while (0)
#define ATT_PV(PW0, PW1, O0, O1, BUF) do { \
                    const bf16x8 pb0 = __builtin_bit_cast(bf16x8, PW0), pb1 = __builtin_bit_cast(bf16x8, PW1); \
                    { const v4i16_t a0 = ATT_VTR((BUF) * ATT_KV_BYTES), a1 = ATT_VTR((BUF) * ATT_KV_BYTES + 512), a2 = ATT_VTR((BUF) * ATT_KV_BYTES + 1024), a3 = ATT_VTR((BUF) * ATT_KV_BYTES + 1536); \
                      O0 = __builtin_amdgcn_mfma_f32_32x32x16_bf16(ATT_VF(a0, a1), pb0, O0, 0, 0, 0); \
                      O0 = __builtin_amdgcn_mfma_f32_32x32x16_bf16(ATT_VF(a2, a3), pb1, O0, 0, 0, 0); } \
                    { const v4i16_t c0 = ATT_VTR((BUF) * ATT_KV_BYTES + 2048), c1 = ATT_VTR((BUF) * ATT_KV_BYTES + 2048 + 512), c2 = ATT_VTR((BUF) * ATT_KV_BYTES + 2048 + 1024), c3 = ATT_VTR((BUF) * ATT_KV_BYTES + 2048 + 1536); \
                      O1 = __builtin_amdgcn_mfma_f32_32x32x16_bf16(ATT_VF(c0, c1), pb0, O1, 0, 0, 0); \
                      O1 = __builtin_amdgcn_mfma_f32_32x32x16_bf16(ATT_VF(c2, c3), pb1, O1, 0, 0, 0); } \
                } while (0)
#define ATT_STEP(I, KT, NEXTKT, HASNEXT, DOA, DOB) do { \
                    const int mk0 = m0 + 32 * (KT); const bool valid = (mk0 >= 0) && (mk0 < L); \
                    if (HASNEXT) { ATT_DMA(NEXTKT, ((I) + 1) & 1); asm volatile("s_waitcnt vmcnt(8)" ::: "memory"); } else { asm volatile("s_waitcnt vmcnt(0)" ::: "memory"); } \
                    f32x16 accA, accB; u32x4 pA0, pA1, pB0, pB1; \
                    if (DOA) ATT_QK(accA, qfA, (KT), (I) & 1); \
                    if (DOB) ATT_QK(accB, qfB, (KT) - 1, (I) & 1); \
                    if (DOA) ATT_SM(accA, pA0, pA1, oA0, oA1, mA, lA); \
                    if (DOB) ATT_SM(accB, pB0, pB1, oB0, oB1, mB, lB); \
                    if (DOA) ATT_PV(pA0, pA1, oA0, oA1, (I) & 1); \
                    if (DOB) ATT_PV(pB0, pB1, oB0, oB1, (I) & 1); \
                    asm volatile("s_waitcnt lgkmcnt(0)" ::: "memory"); \
                } while (0)
                ATT_DMA(0, 0);
                ATT_STEP(0, 0, 1, true, true, true);
                ATT_STEP(1, 1, -1, true, true, true);
                ATT_STEP(2, -1, 2, true, true, true);
                ATT_STEP(3, 2, -2, true, true, true);
                ATT_STEP(4, -2, 3, true, true, false);
                ATT_STEP(5, 3, 0, false, false, true);
#define ATT_FINISH(QTOK, BLK, O0, O1, MR, LP) do { \
                    const float l_b = xhalf_sum(LP); \
                    float fa = 0.f, fc, mm = MR, ln = l_b; \
                    if (b > 0) { const float pm = AM[(QTOK) * NH + h], pl = AL[(QTOK) * NH + h]; mm = fmaxf(pm, MR); fa = pl * __builtin_amdgcn_exp2f(pm - mm); fc = __builtin_amdgcn_exp2f(MR - mm); ln = fa + l_b * fc; } \
                    else fc = 1.f; \
                    const float inv = 1.0f / ln; fa *= inv; fc *= inv; \
                    if (b < 2) { if (hi == 0) { AM[(QTOK) * NH + h] = mm; AL[(QTOK) * NH + h] = ln; } } \
                    PG8_LAS unsigned char* stg = wbuf; \
                    _Pragma("unroll") for (int dt = 0; dt < 2; ++dt) \
                    _Pragma("unroll") for (int rq = 0; rq < 4; ++rq) { \
                        f32x4 v; \
                        if (dt == 0) v = (f32x4){O0[4 * rq], O0[4 * rq + 1], O0[4 * rq + 2], O0[4 * rq + 3]}; else v = (f32x4){O1[4 * rq], O1[4 * rq + 1], O1[4 * rq + 2], O1[4 * rq + 3]}; \
                        *(PG8_LAS f32x4*)(stg + q * 272 + (32 * dt + 8 * rq + 4 * hi) * 4) = v * fc; } \
                    if (hi == 0) *(PG8_LAS float*)(stg + 8704 + q * 4) = fa; \
                    asm volatile("s_waitcnt lgkmcnt(0)" ::: "memory"); \
                    _Pragma("unroll") for (int j4 = 0; j4 < 4; ++j4) { \
                        const int row = 8 * j4 + (lane >> 3), c8 = lane & 7; \
                        f32x4 v0 = *(const PG8_LAS f32x4*)(stg + row * 272 + c8 * 32), v1 = *(const PG8_LAS f32x4*)(stg + row * 272 + c8 * 32 + 16); \
                        const size_t tok = seqbase + ((size_t)(m0 + 32 * (BLK) + row) << dsh) + r; \
                        bf16_t* mp = MIX + tok * D + h * HD + 8 * c8; \
                        if (b > 0) { const float far = *(const PG8_LAS float*)(stg + 8704 + row * 4); f32x4 p0, p1; unpack8(*(const u32x4*)mp, p0, p1); v0 = v0 + p0 * far; v1 = v1 + p1 * far; } \
                        if (b == 2) { float ssq = sumsq4(v0) + sumsq4(v1); ssq += __shfl_xor(ssq, 1); ssq += __shfl_xor(ssq, 2); ssq += __shfl_xor(ssq, 4); if (c8 == 0) SSQA[tok * NH + h] = ssq; } \
                        u32x4 w4; w4.x = cvtpk_s(v0.x, v0.y); w4.y = cvtpk_s(v0.z, v0.w); w4.z = cvtpk_s(v1.x, v1.y); w4.w = cvtpk_s(v1.z, v1.w); *(u32x4*)mp = w4; } \
                    asm volatile("s_waitcnt lgkmcnt(0)" ::: "memory"); \
                } while (0)
                ATT_FINISH(qtokA, 0, oA0, oA1, mA, lA);
                ATT_FINISH(qtokB, 1, oB0, oB1, mB, lB);
            }
            __syncthreads();
        }
    }
#undef ATT_DMA
#undef ATT_STEP
#undef ATT_QK
#undef ATT_SM
#undef ATT_PV
#undef ATT_FINISH
#undef ATT_VTR
#undef ATT_VF
}

__device__ __forceinline__ void ph_scan(PG8_LAS unsigned char* lds, const bf16_t* __restrict__ SB, const float* __restrict__ PW, bf16_t* __restrict__ UH) {
    const int tid = tid_fresh(), seg = tid >> 5, nl = tid & 31;
    PG8_LAS float* ex = (PG8_LAS float*)lds;
    for (int it = blockIdx.x; it < NSEQ * NG * 2 * 2; it += gridDim.x) {
        const int nh = it & 1, dir = (it >> 1) & 1, g = (it >> 2) % NG, s = it / (4 * NG), n = nh * 32 + nl;
        const float* pw = PW + ((size_t)((g * 2 + dir) * NS + n) * 17 + 16) * 2;
        const float ar = pw[0], ai = pw[1];
        const size_t base = (size_t)g * NCHT + (size_t)s * NCHS; const int colo = dir * 128 + 2 * n;
        const int t0 = seg * 32;
        const int c0 = dir == 0 ? t0 : NCHS - 1 - t0; const long cstep = dir == 0 ? 1 : -1;
        const bf16_t* sp = SB + (base + c0) * 256 + colo; const long sstride = cstep * 256;
        float hr = 0.f, hi = 0.f;
#pragma unroll 8
        for (int i = 0; i < 32; ++i) { const unsigned wv = *(const unsigned*)sp; sp += sstride; const float sr = bflo(wv), si = bfhi(wv); const float nr = ar * hr - ai * hi + sr, ni = ar * hi + ai * hr + si; hr = nr; hi = ni; }
        __syncthreads();
        ex[(seg * 32 + nl) * 2] = hr; ex[(seg * 32 + nl) * 2 + 1] = hi;
        float sr_ = ar, si_ = ai;
#pragma unroll
        for (int i = 0; i < 5; ++i) { const float tr = sr_ * sr_ - si_ * si_, ti = 2.f * sr_ * si_; sr_ = tr; si_ = ti; }
        __syncthreads();
        float cr = 0.f, ci = 0.f;
        for (int j = 0; j < seg; ++j) { const float er = ex[(j * 32 + nl) * 2], ei = ex[(j * 32 + nl) * 2 + 1]; const float nr = sr_ * cr - si_ * ci + er, ni = sr_ * ci + si_ * cr + ei; cr = nr; ci = ni; }
        hr = cr; hi = ci;
        sp = SB + (base + c0) * 256 + colo; bf16_t* up = UH + (base + c0) * 512 + 256 + colo; const long ustride = cstep * 512;
#pragma unroll 8
        for (int i = 0; i < 32; ++i) { const unsigned wv = *(const unsigned*)sp; sp += sstride;
            *(unsigned*)up = pk2(hr, hi); up += ustride;
            const float sr = bflo(wv), si = bfhi(wv); const float nr = ar * hr - ai * hi + sr, ni = ar * hi + ai * hr + si; hr = nr; hi = ni; }
    }
    __syncthreads();
}


#define LAS __attribute__((address_space(3)))
#define XB_TMO      128
#define XB_XCNT(j)  (256  + 64 * (j))
#define XB_XSUB(j)  (1280 + 64 * (j))
#define XB_XGEN(j)  (2304 + 64 * (j))
#define XB_TOP      3328
#define XB_TOPGEN   3392
#define XCD_BAR_WORDS 3456
#define XB_SPIN_CAP (1u << 18)

__device__ __forceinline__ unsigned xb_ld(unsigned* p)              { return __hip_atomic_load(p, __ATOMIC_RELAXED, __HIP_MEMORY_SCOPE_AGENT); }
__device__ __forceinline__ unsigned xb_add(unsigned* p, unsigned v) { return __hip_atomic_fetch_add(p, v, __ATOMIC_RELAXED, __HIP_MEMORY_SCOPE_AGENT); }
__device__ __forceinline__ unsigned xb_xcc_id() { return (unsigned)__builtin_amdgcn_s_getreg((3 << 11) | 20) & 0xFu; }
#define XB_SPIN(cond, bar) do { unsigned _sp = 0; while (cond) { __builtin_amdgcn_s_sleep(1); \
    if ((++_sp & 255u) == 0u) { if (xb_ld(&(bar)[XB_TMO])) break; if (_sp > XB_SPIN_CAP) { atomicAdd(&(bar)[XB_TMO], 1u); break; } } } } while (0)

struct XcdBarrier {
    unsigned* bar; unsigned x;
    volatile LAS unsigned* st;
};

__device__ __forceinline__ XcdBarrier xcd_barrier_post(unsigned* bar, volatile LAS unsigned* st) {
    XcdBarrier b; b.bar = bar; b.x = xb_xcc_id(); b.st = st;
    if (threadIdx.x == 0) (void)xb_add(&bar[XB_XCNT(b.x)], 1u);
    return b;
}
__device__ __forceinline__ void xcd_barrier_complete(unsigned* bar, unsigned x, unsigned& nloc, unsigned& nx) {
    const unsigned G = gridDim.x * gridDim.y * gridDim.z;
    unsigned sum, cnt, mine, sp = 0u;
    for (;;) {
        sum = 0u; cnt = 0u; mine = 0u;
#pragma unroll
        for (unsigned j = 0; j < 16; ++j) { const unsigned c = xb_ld(&bar[XB_XCNT(j)]); sum += c; cnt += (c > 0u) ? 1u : 0u; mine = (j == x) ? c : mine; }
        if (sum == G) break;
        __builtin_amdgcn_s_sleep(1);
        if ((++sp & 255u) == 0u) { if (xb_ld(&bar[XB_TMO])) break; if (sp > XB_SPIN_CAP) { atomicAdd(&bar[XB_TMO], 1u); break; } }
    }
    nloc = mine > 0u ? mine : 1u; nx = cnt > 0u ? cnt : 1u;
}

__device__ __forceinline__ void xcd_barrier(const XcdBarrier& b) {
    asm volatile("s_waitcnt vmcnt(0)" ::: "memory");
    __syncthreads();
    if (threadIdx.x == 0) {
        unsigned* bar = b.bar;
        __builtin_amdgcn_s_waitcnt(0);
        unsigned nloc = b.st[0], nx = b.st[1];
        if (nloc == 0u) { xcd_barrier_complete(bar, b.x, nloc, nx); b.st[0] = nloc; b.st[1] = nx; }
        const unsigned old = xb_add(&bar[XB_XSUB(b.x)], 1u);
        const unsigned gen = old / nloc;
        if (old + 1u == (gen + 1u) * nloc) {
            __builtin_amdgcn_fence(__ATOMIC_RELEASE, "agent");
            asm volatile("s_waitcnt vmcnt(0)" ::: "memory");
            const unsigned og = xb_add(&bar[XB_TOP], 1u);
            const unsigned tg = og / nx;
            if (og + 1u == (tg + 1u) * nx) xb_add(&bar[XB_TOPGEN], 1u);
            else XB_SPIN(xb_ld(&bar[XB_TOPGEN]) == tg, bar);
            __builtin_amdgcn_fence(__ATOMIC_ACQUIRE, "agent");
            xb_add(&bar[XB_XGEN(b.x)], 1u);
            asm volatile("s_waitcnt vmcnt(0)" ::: "memory");
        } else {
            XB_SPIN(xb_ld(&bar[XB_XGEN(b.x)]) == gen, bar);
            __builtin_amdgcn_fence(__ATOMIC_ACQUIRE, "agent");
            asm volatile("s_waitcnt vmcnt(0)" ::: "memory");
        }
    }
    __syncthreads();
}
constexpr int LDS_BYTES = 147456;
struct Args { const float* in[27]; float* out; unsigned char* ws; };
template <class Epi>
__device__ __forceinline__ void run_gemm(PG8_LAS unsigned char* lds, const bf16_t* A, int lda, const bf16_t* Bt, int ldb, int M, int N, int K, int khb, int split, int bdiv, const Epi& E) {
    pg8::Gemm g{A, Bt, lda, ldb, K, khb}; pg8::Order S; S.init(M, N, (int)gridDim.x, (int)blockIdx.x, split, bdiv);
    pg8::gemm_phase<Epi, pg8::Order, true, true>(lds, g, S, E);
}
__global__ void __launch_bounds__(NTHR, 2) mega(Args a) {
    extern __shared__ __attribute__((aligned(16))) unsigned char lds_raw[];
    PG8_LAS unsigned char* lds = (PG8_LAS unsigned char*)lds_raw;
    cg::grid_group grid = cg::this_grid();
    unsigned* xbar = (unsigned*)(a.ws + WS_CTL);
    volatile LAS unsigned* xst = (volatile LAS unsigned*)(lds + LDS_BYTES - 64);
    if (threadIdx.x < 2) xst[threadIdx.x] = 0u;
    if (blockIdx.x == 0) for (int i_ = threadIdx.x; i_ < XCD_BAR_WORDS; i_ += NTHR) xbar[i_] = 0u;
    __syncthreads();
    const float *xp = a.in[0], *xs = a.in[1], *pp = a.in[2], *ps = a.in[3], *rel_bias = a.in[4], *g_mix = a.in[5], *w_in = a.in[6];
    const float *a_re = a.in[7], *a_im = a.in[8], *log_dt = a.in[9], *b_re = a.in[10], *b_im = a.in[11], *c_re = a.in[12], *c_im = a.in[13], *ssm_d = a.in[14];
    const float *w_glu = a.in[15], *b_glu = a.in[16], *g_att = a.in[17], *g_ssm = a.in[18], *w_out = a.in[19], *g_mlp = a.in[20], *w_mlp1 = a.in[21], *w_mlp2 = a.in[22];
    const float *g_ple = a.in[23], *w_gate = a.in[24], *w_proj = a.in[25], *g_final = a.in[26];
    unsigned char* ws = a.ws; unsigned char* dob = (unsigned char*)a.out;
    float* BIAS = (float*)(ws + WS_BIAS); float* PW = (float*)(ws + WS_PW); float* BBt = (float*)(ws + WS_BB); float* KT = (float*)(ws + WS_KT);
    float *RS0 = (float*)(ws + WS_RS0), *SSQA = (float*)(ws + WS_SSQA), *SSQS = (float*)(ws + WS_SSQS), *SSQ1 = (float*)(ws + WS_SSQ1), *SSQ2 = (float*)(ws + WS_SSQ2);
    bf16_t *WGT = (bf16_t*)(ws + WS_WGT), *WPT = (bf16_t*)(ws + WS_WPT);
    bf16_t *W1T = (bf16_t*)(dob + DO_W1T), *W2T = (bf16_t*)(dob + DO_W2T), *PB = (bf16_t*)(dob + DO_PB);
    bf16_t *WINT = (bf16_t*)(dob + DO_WINT), *WOUTT = (bf16_t*)(dob + DO_WOUTT), *WGLUT = (bf16_t*)(dob + DO_WGLUT), *WST = (bf16_t*)(dob + DO_WST), *WYT = (bf16_t*)(dob + DO_WYT);
    bf16_t *SB = (bf16_t*)(ws + WS_SB), *QB = (bf16_t*)(ws + WS_QB), *KB = (bf16_t*)(ws + WS_KB), *VB = (bf16_t*)(ws + WS_VB), *UH = (bf16_t*)(ws + WS_UH);
    bf16_t *MIX = (bf16_t*)(ws + WS_MIX), *GB = (bf16_t*)(ws + WS_GB), *HID = (bf16_t*)(ws + WS_HID), *PP = (bf16_t*)(ws + WS_PP);
    float* H3F = (float*)(ws + WS_H3F);
    bf16_t *XB = (bf16_t*)(dob + DO_XB), *H1B = (bf16_t*)(ws + WS_HB), *H2B = (bf16_t*)(ws + WS_HB);
#ifndef PROBE_MASK
#define PROBE_MASK 0
#endif
#define PHASE(id) _Pragma("unroll 1") for (int rep_ = 0; rep_ < (((PROBE_MASK) >> (id)) & 1) + 1; ++rep_)
    PHASE(0) {
        ph_prep_wt(lds, w_in, D, INC, g_mix, g_mix, D, WINT, D, AW, C2);
        ph_prep_wt(lds, w_glu, SW, SW, nullptr, nullptr, SW, WGLUT, SW, 0, 1.f);
        ph_prep_wt(lds, w_out, D, D, g_att, g_ssm, AW, WOUTT, D, 0, 1.f);
        ph_prep_wt(lds, w_mlp1, D, DFF, g_mlp, g_mlp, D, W1T, D, 0, 1.f);
        ph_prep_wt(lds, w_mlp2, DFF, D, nullptr, nullptr, DFF, W2T, DFF, 0, 1.f);
        ph_prep_wt(lds, w_gate, D, D, g_ple, g_ple, D, WGT, D, 0, 1.f);
        ph_prep_wt(lds, w_proj, PLE, D, nullptr, nullptr, PLE, WPT, PLE, 0, 1.f);
        ph_prep_bias(rel_bias, BIAS);
        ph_ssm_tab(a_re, a_im, log_dt, b_re, b_im, PW, BBt);
        ph_rows_x(xp, xs, XB, RS0);
        ph_cvt_p(pp, ps, PB);
        grid.sync();
    }
    const XcdBarrier xb = xcd_barrier_post(xbar, xst);
    PHASE(1) {
        ph_ssm_ws(PW, BBt, WST);
        ph_ssm_kt(PW, BBt, c_re, c_im, KT);
        ph_ssm_wy_carry(PW, c_re, c_im, WYT);
        run_gemm(lds, XB, D, WINT, D, NT, INC, D, 0, 0, 0, EpiIn{RS0, QB, KB, VB, UH});
        xcd_barrier(xb);
    }
    PHASE(2) {
        ph_ssm_wy_fill(KT, ssm_d, WYT);
        ph_attn<0>(lds, QB, KB, VB, BIAS, MIX, (float*)(ws + WS_AM), (float*)(ws + WS_AL), SSQA);
    }
    PHASE(3) {
        run_gemm(lds, UH, 512, WST, 256, NG * NCHT, 256, 256, 0, 0, NCHT / 256, EpiS{SB});
        xcd_barrier(xb);
    }
    PHASE(4) {
        ph_scan(lds, SB, PW, UH);
    }
    ph_attn<1>(lds, QB, KB, VB, BIAS, MIX, (float*)(ws + WS_AM), (float*)(ws + WS_AL), SSQA);
    xcd_barrier(xb);
    PHASE(5) {
        run_gemm(lds, UH, 512, WYT, 512, NG * NCHT, 256, 512, 0, 0, NCHT / 256, EpiY{GB});
        xcd_barrier(xb);
    }
    PHASE(6) {
        run_gemm(lds, GB, SW, WGLUT, SW, NT, SW, SW, 0, 0, 0, EpiGlu{GB, b_glu, MIX, SSQS});
        xcd_barrier(xb);
    }
    PHASE(7) {
        run_gemm(lds, MIX, D, WOUTT, D, NT, D, AW, AW * 2, 1, 0, EpiOut{XB, SSQA, SSQS, H1B, SSQ1});
        xcd_barrier(xb);
    }
    PHASE(8) {
        run_gemm(lds, H1B, D, W1T, D, NT, DFF, D, 0, 0, 0, EpiMlp1{SSQ1, HID});
        xcd_barrier(xb);
    }
    PHASE(9) {
        run_gemm(lds, HID, DFF, W2T, DFF, NT, D, DFF, 0, 0, 0, EpiMlp2{H1B, H2B, SSQ2});
        xcd_barrier(xb);
    }
    PHASE(10) {
        run_gemm(lds, PB, PLE, WPT, PLE, NT, D, PLE, 0, 0, 0, EpiPP{PP});
        xcd_barrier(xb);
    }
    PHASE(11) {
        run_gemm(lds, H2B, D, WGT, D, NT, D, D, 0, 0, 0, EpiGate{SSQ2, H2B, PP, H3F});
        xcd_barrier(xb);
    }
    PHASE(12) {
        ph_final(H3F, g_final, a.out);
    }
}

extern "C" void kernel_launch(void* const* d_in, const int* in_sizes, int n_in, void* d_out, int out_size, void* d_ws, size_t ws_size, hipStream_t stream) {
    static int grid_blocks = 0;
    if (n_in != 27 || ws_size < WS_END || out_size != NT * D) { fprintf(stderr, "kernel_launch: unexpected sizes n_in %d ws %zu out %d\n", n_in, ws_size, out_size); return; }
    if (!grid_blocks) {
        int dev = 0, cus = 0, per_cu = 0;
        (void)hipGetDevice(&dev);
        (void)hipDeviceGetAttribute(&cus, hipDeviceAttributeMultiprocessorCount, dev);
        if (hipFuncSetAttribute((const void*)mega, hipFuncAttributeMaxDynamicSharedMemorySize, LDS_BYTES) != hipSuccess) { fprintf(stderr, "kernel_launch: hipFuncSetAttribute failed\n"); return; }
        (void)hipOccupancyMaxActiveBlocksPerMultiprocessor(&per_cu, mega, NTHR, LDS_BYTES);
        if (per_cu < 1) { fprintf(stderr, "kernel_launch: occupancy query says %d blocks per CU\n", per_cu); return; }
        grid_blocks = cus;
    }
    Args a{};
    for (int i = 0; i < 27; ++i) a.in[i] = (const float*)d_in[i];
    a.out = (float*)d_out; a.ws = (unsigned char*)d_ws;
    void* args[] = {&a};
    hipError_t e = hipLaunchCooperativeKernel((void*)mega, dim3(grid_blocks), dim3(NTHR), args, LDS_BYTES, stream);
    if (e != hipSuccess) fprintf(stderr, "cooperative launch failed: %s (grid %d)\n", hipGetErrorString(e), grid_blocks);
}
```
